# Optimizing an MI355X kernel written in HIP

```python
import math
import jax, jax.numpy as jnp
from jax import lax
import numpy as np

D_MODEL = 2048
BATCH = 2
SEQ = 16384
DEPTH = 2
DEC_BATCH = 8
DEC_SEQ = 64
PAST_LEN = 2048

CHUNK = 64
Q_BLOCK = 128
CONV_WIDTH = 31
D_CONV = 512
N_DIFF = 8
DIFF_HD = 64
DIFF_VD = 2 * DIFF_HD
N_RET = 4
RET_HD = 128
D_FF = 5632
N_BUCKETS = 32
MAX_DISTANCE = 128
LN_EPS = 1e-5
ROPE_BASE = 10000.0
ALPHA = (2 * DEPTH) ** 0.25
BETA = (8 * DEPTH) ** -0.25
D_MIX = D_CONV + N_DIFF * DIFF_VD + N_RET * RET_HD
_SIZES = (D_CONV, D_CONV,
          N_DIFF * 2 * DIFF_HD, N_DIFF * 2 * DIFF_HD, N_DIFF * DIFF_VD,
          N_RET * RET_HD, N_RET * RET_HD, N_RET * RET_HD, N_RET * RET_HD)
D_IN = sum(_SIZES)
SPLIT_POINTS = tuple(int(s) for s in np.cumsum(_SIZES)[:-1])

kernel_name = "hybrid_conv_diffattn_retention_stream_step"


def _layer_norm(x, g, b):
    xf = x.astype(jnp.float32)
    mu = jnp.mean(xf, axis=-1, keepdims=True)
    var = jnp.mean(jnp.square(xf - mu), axis=-1, keepdims=True)
    return ((xf - mu) * lax.rsqrt(var + LN_EPS) * g.astype(jnp.float32) + b.astype(jnp.float32)).astype(x.dtype)


def _swiglu(x, wg, wu, wd):
    return (jax.nn.silu(x @ wg) * (x @ wu)) @ wd


def _rel_bucket(rel):
    half = N_BUCKETS // 2
    max_exact = half // 2
    ret = jnp.where(rel > 0, half, 0)
    n = jnp.abs(rel)
    nf = jnp.maximum(n, 1).astype(jnp.float32)
    large = max_exact + (jnp.log(nf / max_exact) / math.log(MAX_DISTANCE / max_exact)
                         * (half - max_exact)).astype(jnp.int32)
    large = jnp.minimum(large, half - 1)
    return ret + jnp.where(n < max_exact, n, large)


def _diff_attn_block(q, qpos, k, v, kpos, lam, rel_bias):
    B, Lk = k.shape[0], k.shape[1]
    k2 = k.reshape(B, Lk, N_DIFF, 2, DIFF_HD)
    s = jnp.einsum('bqhmd,bkhmd->bmhqk', q, k2).astype(jnp.float32) * (DIFF_HD ** -0.5)
    bias = rel_bias[_rel_bucket(kpos[None, :] - qpos[:, None])]
    bias = jnp.transpose(bias, (2, 0, 1)).astype(jnp.float32)
    allowed = (kpos[None, :] // CHUNK) <= (qpos[:, None] // CHUNK)
    s = jnp.where(allowed, s + bias, -jnp.inf)
    p = jax.nn.softmax(s, axis=-1)
    a = p[:, 0] - lam * p[:, 1]
    return jnp.einsum('bhqk,bkhe->bqhe', a.astype(v.dtype), v)


def _diff_attention(q, k, v, q_pos, k_pos, lam, lam_init, sub_g, rel_bias):
    B, Lq = q.shape[0], q.shape[1]
    if Lq <= Q_BLOCK:
        o = _diff_attn_block(q, q_pos, k, v, k_pos, lam, rel_bias)
    else:
        nb = Lq // Q_BLOCK
        qb = jnp.swapaxes(q.reshape(B, nb, Q_BLOCK, N_DIFF, 2, DIFF_HD), 0, 1)
        pb = q_pos.reshape(nb, Q_BLOCK)
        o = lax.map(lambda a: _diff_attn_block(a[0], a[1], k, v, k_pos, lam, rel_bias), (qb, pb))
        o = jnp.swapaxes(o, 0, 1).reshape(B, Lq, N_DIFF, DIFF_VD)
    of = o.astype(jnp.float32)
    of = of * lax.rsqrt(jnp.mean(jnp.square(of), axis=-1, keepdims=True) + LN_EPS) * sub_g.astype(jnp.float32)
    return (of * (1.0 - lam_init)).astype(q.dtype).reshape(B, Lq, N_DIFF * DIFF_VD)


def _rope(x, pos):
    half = x.shape[-1] // 2
    inv = 1.0 / (ROPE_BASE ** (jnp.arange(half, dtype=jnp.float32) / half))
    ang = pos.astype(jnp.float32)[:, None] * inv[None, :]
    cos = jnp.cos(ang)[None, :, None, :]
    sin = jnp.sin(ang)[None, :, None, :]
    x1, x2 = x[..., :half], x[..., half:]
    return jnp.concatenate([x1 * cos - x2 * sin, x1 * sin + x2 * cos], axis=-1)


def _retention(q, k, v, s0, L):
    B, T, H, D = q.shape
    n = T // L
    log_g = jnp.log1p(-jnp.exp2(-5.0 - jnp.arange(H, dtype=jnp.float32)))
    idx = jnp.arange(L, dtype=jnp.float32)
    rel = idx[:, None] - idx[None, :]
    decay = jnp.where(rel >= 0, jnp.exp(jnp.maximum(rel, 0.0)[None] * log_g[:, None, None]), 0.0)
    qc = q.reshape(B, n, L, H, D)
    kc = k.reshape(B, n, L, H, D)
    vc = v.reshape(B, n, L, H, D)
    inner = jnp.einsum('bnihd,bnjhd->bnhij', qc, kc) * decay
    o_inner = jnp.einsum('bnhij,bnjhe->bnihe', inner, vc)
    w_k = jnp.exp((L - 1.0 - idx)[None, :] * log_g[:, None])
    kv = jnp.einsum('bnjhd,hj,bnjhe->bnhde', kc, w_k, vc)
    g_L = jnp.exp(L * log_g)[None, :, None, None]

    def step(s, kv_n):
        return g_L * s + kv_n, s

    s_last, s_prev = lax.scan(step, s0, jnp.swapaxes(kv, 0, 1))
    w_q = jnp.exp((idx + 1.0)[None, :] * log_g[:, None])
    o_cross = jnp.einsum('bnihd,hi,nbhde->bnihe', qc, w_q, s_prev)
    return (o_inner + o_cross).reshape(B, T, H, D), s_last


def _conv_module(a, b, prev, w, cb, g, beta):
    u = a * jax.nn.sigmoid(b)
    ext = jnp.concatenate([prev.astype(u.dtype), u], axis=1)
    y = lax.conv_general_dilated(ext, w[:, None, :].astype(u.dtype), window_strides=(1,), padding='VALID',
                                 dimension_numbers=('NWC', 'WIO', 'NWC'), feature_group_count=D_CONV)
    y = jax.nn.silu(_layer_norm(y + cb, g, beta))
    return y, ext[:, -(CONV_WIDTH - 1):]


def _mixer(h, pos0, conv_prev, ret_prev, k_past, v_past, ret_chunk, lam_init,
           w_in, w_out, conv_w, conv_b, conv_ln_g, conv_ln_b, diff_lam, diff_sub_g, rel_bias):
    B, T, _ = h.shape
    proj = h @ w_in
    ca, cg, dq, dk, dv, rq, rk, rv, rg = jnp.split(proj, SPLIT_POINTS, axis=-1)
    conv_out, conv_new = _conv_module(ca, cg, conv_prev, conv_w, conv_b, conv_ln_g, conv_ln_b)
    q_pos = pos0 + jnp.arange(T, dtype=jnp.int32)
    dq = dq.reshape(B, T, N_DIFF, 2, DIFF_HD)
    dk = dk.reshape(B, T, N_DIFF, 2 * DIFF_HD)
    dv = dv.reshape(B, T, N_DIFF, DIFF_VD)
    if k_past is None:
        k_all, v_all, k_pos = dk, dv, q_pos
    else:
        k_all = jnp.concatenate([k_past.astype(dk.dtype), dk], axis=1)
        v_all = jnp.concatenate([v_past.astype(dv.dtype), dv], axis=1)
        k_pos = jnp.arange(k_past.shape[1] + T, dtype=jnp.int32)
    lf = diff_lam.astype(jnp.float32)
    lam = jnp.exp(jnp.sum(lf[0] * lf[1])) - jnp.exp(jnp.sum(lf[2] * lf[3])) + lam_init
    attn_out = _diff_attention(dq, k_all, v_all, q_pos, k_pos, lam, lam_init, diff_sub_g, rel_bias)
    rq = _rope(rq.reshape(B, T, N_RET, RET_HD).astype(jnp.float32), q_pos)
    rk = _rope(rk.reshape(B, T, N_RET, RET_HD).astype(jnp.float32), q_pos) * (RET_HD ** -0.5)
    rv = rv.reshape(B, T, N_RET, RET_HD).astype(jnp.float32)
    o, s_new = _retention(rq, rk, rv, ret_prev.astype(jnp.float32), ret_chunk)
    mu = jnp.mean(o, axis=-1, keepdims=True)
    var = jnp.mean(jnp.square(o - mu), axis=-1, keepdims=True)
    o = ((o - mu) * lax.rsqrt(var + LN_EPS)).reshape(B, T, N_RET * RET_HD)
    ret_out = (jax.nn.silu(rg.astype(jnp.float32)) * o).astype(h.dtype)
    mix = jnp.concatenate([conv_out, attn_out, ret_out], axis=-1) @ w_out
    return mix, conv_new, dk, dv, s_new


def _trunk(x, pos0, cache_conv, cache_k, cache_v, state_ret, ln_g, ln_b, ffn_w_gate, ffn_w_up, ffn_w_down,
           w_in, w_out, conv_w, conv_b, conv_ln_g, conv_ln_b, diff_lam, diff_sub_g, rel_bias):
    B, T, _ = x.shape
    ret_chunk = CHUNK if cache_k is None else T
    conv_l, k_l, v_l, s_l = [], [], [], []
    for l in range(DEPTH):
        lam_init = 0.8 - 0.6 * math.exp(-0.3 * l)
        if cache_k is None:
            conv_prev = jnp.zeros((B, CONV_WIDTH - 1, D_CONV), x.dtype)
            ret_prev = jnp.zeros((B, N_RET, RET_HD, RET_HD), jnp.float32)
            k_past = None
            v_past = None
        else:
            conv_prev, ret_prev, k_past, v_past = cache_conv[l], state_ret[l], cache_k[l], cache_v[l]
        x = _layer_norm(ALPHA * x + 0.5 * _swiglu(x, ffn_w_gate[l, 0], ffn_w_up[l, 0], ffn_w_down[l, 0]),
                        ln_g[l, 0], ln_b[l, 0])
        mix, c_new, k_new, v_new, s_new = _mixer(x, pos0, conv_prev, ret_prev, k_past, v_past, ret_chunk, lam_init,
                                                 w_in[l], w_out[l], conv_w[l], conv_b[l], conv_ln_g[l],
                                                 conv_ln_b[l], diff_lam[l], diff_sub_g[l], rel_bias)
        x = _layer_norm(ALPHA * x + mix, ln_g[l, 1], ln_b[l, 1])
        x = _layer_norm(ALPHA * x + 0.5 * _swiglu(x, ffn_w_gate[l, 1], ffn_w_up[l, 1], ffn_w_down[l, 1]),
                        ln_g[l, 2], ln_b[l, 2])
        conv_l.append(c_new)
        k_l.append(k_new)
        v_l.append(v_new)
        s_l.append(s_new)
    return x, jnp.stack(conv_l), jnp.stack(k_l), jnp.stack(v_l), jnp.stack(s_l)


def setup_inputs(seed: int = 0) -> dict:
    key = jax.random.key(seed)
    ks = jax.random.split(key, 24)
    nrm = lambda k, shape: jax.random.normal(k, shape, jnp.float32)
    return {
        'x_prompt': nrm(ks[0], (BATCH, SEQ, D_MODEL)),
        'x_sample': nrm(ks[1], (DEC_BATCH, DEC_SEQ, D_MODEL)),
        'cache_conv': nrm(ks[2], (DEPTH, DEC_BATCH, CONV_WIDTH - 1, D_CONV)) * 0.5,
        'cache_k': nrm(ks[3], (DEPTH, DEC_BATCH, PAST_LEN, N_DIFF, 2 * DIFF_HD)),
        'cache_v': nrm(ks[4], (DEPTH, DEC_BATCH, PAST_LEN, N_DIFF, DIFF_VD)),
        'state_ret': nrm(ks[5], (DEPTH, DEC_BATCH, N_RET, RET_HD, RET_HD)),
        'ln_g': 1.0 + 0.01 * nrm(ks[6], (DEPTH, 3, D_MODEL)),
        'ln_b': 0.01 * nrm(ks[7], (DEPTH, 3, D_MODEL)),
        'ffn_w_gate': nrm(ks[8], (DEPTH, 2, D_MODEL, D_FF)) * D_MODEL ** -0.5,
        'ffn_w_up': nrm(ks[9], (DEPTH, 2, D_MODEL, D_FF)) * D_MODEL ** -0.5,
        'ffn_w_down': nrm(ks[10], (DEPTH, 2, D_FF, D_MODEL)) * (D_FF ** -0.5 * BETA),
        'w_in': nrm(ks[11], (DEPTH, D_MODEL, D_IN)) * D_MODEL ** -0.5,
        'w_out': nrm(ks[12], (DEPTH, D_MIX, D_MODEL)) * (D_MIX ** -0.5 * BETA),
        'conv_w': nrm(ks[13], (DEPTH, CONV_WIDTH, D_CONV)) * CONV_WIDTH ** -0.5,
        'conv_b': 0.01 * nrm(ks[14], (DEPTH, D_CONV)),
        'conv_ln_g': 1.0 + 0.01 * nrm(ks[15], (DEPTH, D_CONV)),
        'conv_ln_b': 0.01 * nrm(ks[16], (DEPTH, D_CONV)),
        'diff_lam': 0.1 * nrm(ks[17], (DEPTH, 4, DIFF_HD)),
        'diff_sub_g': 1.0 + 0.01 * nrm(ks[18], (DEPTH, DIFF_VD)),
        'rel_bias': 0.5 * nrm(ks[19], (N_BUCKETS, N_DIFF)),
    }


def reference(x_prompt, x_sample, cache_conv, cache_k, cache_v, state_ret, ln_g, ln_b, ffn_w_gate, ffn_w_up,
              ffn_w_down, w_in, w_out, conv_w, conv_b, conv_ln_g, conv_ln_b, diff_lam, diff_sub_g, rel_bias):
    y_prompt, conv_p, k_p, v_p, ret_p = _trunk(
        x_prompt, 0, None, None, None, None, ln_g, ln_b, ffn_w_gate, ffn_w_up, ffn_w_down,
        w_in, w_out, conv_w, conv_b, conv_ln_g, conv_ln_b, diff_lam, diff_sub_g, rel_bias)
    y_sample, conv_s, k_s, v_s, ret_s = _trunk(
        x_sample, cache_k.shape[2], cache_conv, cache_k, cache_v, state_ret, ln_g, ln_b, ffn_w_gate, ffn_w_up,
        ffn_w_down, w_in, w_out, conv_w, conv_b, conv_ln_g, conv_ln_b, diff_lam, diff_sub_g, rel_bias)
    return (y_prompt, y_sample, conv_p, k_p, v_p, ret_p, conv_s, k_s, v_s, ret_s)
```

```cpp
#include <hip/hip_runtime.h>
#include <cstdio>
#include <cstdint>
namespace pg8 {
#define PG8_LAS __attribute__((address_space(3)))
typedef unsigned short bf16_t;
typedef short bf16x8 __attribute__((ext_vector_type(8)));
typedef float f32x4 __attribute__((ext_vector_type(4)));
typedef unsigned u32x4 __attribute__((ext_vector_type(4)));
constexpr int BM = 256, BK = 64, HALF = 128, HTB = HALF * BK * 2  , STAGE_BYTES = 8 * HTB, NXCD = 8, WGM = 4;

__host__ __device__ __forceinline__ int lds_byte(int r, int c) { const int st = (r >> 4) * 2 + (c >> 5), rr = r & 15, cc = c & 31, ob = rr * 64 + cc * 2; return st * 1024 + (ob ^ (((ob >> 9) & 1) << 5)); }
__host__ __device__ __forceinline__ void stage_rc(int b, int& R, int& C) { const int st = b / 1024, sb = b % 1024, swz = sb ^ (((sb >> 9) & 1) << 5); R = (st >> 1) * 16 + swz / 64; C = (st & 1) * 32 + (swz % 64) / 2; }
__host__ __device__ __forceinline__ int perm32(int rho) { const int n = rho >> 4, i = rho & 15; return 8 * (i >> 2) + 4 * n + (i & 3); }

struct Unit { int pm, pn, k0, nt, ks; };
struct Gemm { const bf16_t* A; const bf16_t* Bt; int M, N, K, lda, ldb; size_t ksA, ksB, tsA, tsB; };
__host__ __device__ inline Gemm gemm_rowmajor(const bf16_t* A, const bf16_t* Bt, int M, int N, int K, int ld) { return Gemm{A, Bt, M, N, K, ld, ld, (size_t)BK * 2, (size_t)BK * 2, (size_t)BM * ld * 2, (size_t)BM * ld * 2}; }
__host__ __device__ inline Gemm gemm_atiled(const bf16_t* A, const bf16_t* Bt, int M, int N, int K, int ldb) { return Gemm{A, Bt, M, N, K, BK, ldb, (size_t)BM * BK * 2, (size_t)BK * 2, (size_t)(K / BK) * BM * BK * 2, (size_t)BM * ldb * 2}; }

struct StaticOrder {
    int nM, nN, nwg, G, c, ntf, wgm;
    __host__ __device__ void init(int M, int N, int G_, int c_, int K_) { nM = M / BM; nN = N / BM; nwg = nM * nN; G = G_; c = c_; ntf = K_ / BK; wgm = WGM; }
    __host__ __device__ bool next(int i, Unit& u) const {
        const long L = (long)i * G + c; if (L >= nwg) return false;
        int wgid = (int)L; { const int q = nwg / NXCD, r = nwg % NXCD, xcd = wgid % NXCD, off = wgid / NXCD; wgid = (xcd < r ? xcd * (q + 1) : r * (q + 1) + (xcd - r) * q) + off; }
        const int nig = wgm * nN, gid = wgid / nig, fm = gid * wgm, gsz = (nM - fm) < wgm ? (nM - fm) : wgm;
        u.pm = fm + ((wgid % nig) % gsz); u.pn = (wgid % nig) / gsz; u.k0 = 0; u.nt = ntf; u.ks = 0; return true;
    }
    __device__ __forceinline__ void a_ready(const Unit&) const {}
    __device__ __forceinline__ void done(const Unit&) const {}
};

struct TailSplitOrder {
    StaticOrder P; int nwp, nN, nsplit, ntp, ntot, G, c, mp; bool rev;
    __host__ __device__ void init(int Mp, int Mall, int N, int G_, int c_, int K_, int nsplit_) { P.init(Mp, N, G_, c_, K_); nwp = P.nwg; nN = N / BM; nsplit = nsplit_; ntp = K_ / BK / nsplit_; mp = Mp / BM;
        ntot = nwp + ((Mall - Mp) / BM) * nN * nsplit_; G = G_; c = c_; rev = false; }
    __host__ __device__ bool next(int i, Unit& u) const {
        const long L = (long)i * G + c; if (L >= ntot) return false;
        int pm, pn, k0 = 0, nt = P.ntf, ks = 0;
        if (L < nwp) {
            int wgid = (int)L; { const int q = P.nwg / NXCD, r = P.nwg % NXCD, xcd = wgid % NXCD, off = wgid / NXCD; wgid = (xcd < r ? xcd * (q + 1) : r * (q + 1) + (xcd - r) * q) + off; }
            const int nig = P.wgm * P.nN, gid = wgid / nig, fm = gid * P.wgm, gsz = (P.nM - fm) < P.wgm ? (P.nM - fm) : P.wgm;
            pm = fm + ((wgid % nig) % gsz); pn = (wgid % nig) / gsz;
            if (rev) pm = P.nM - 1 - pm;
        } else {
            const int s = (int)(L - nwp), rest = s / nsplit; ks = s % nsplit;
            pn = rest % nN; pm = mp + rest / nN; nt = ntp; k0 = ks * ntp;
        }
        u.pm = pm; u.pn = pn; u.k0 = k0; u.nt = nt; u.ks = ks; return true;
    }
    __device__ __forceinline__ void a_ready(const Unit&) const {}
    __device__ __forceinline__ void done(const Unit&) const {}
};

typedef float f32x2c_t __attribute__((ext_vector_type(2))); typedef __bf16 bf16x2c_t __attribute__((ext_vector_type(2)));
__device__ __forceinline__ unsigned cvt_pk_bf16(float lo, float hi) { f32x2c_t v = {lo, hi}; bf16x2c_t b = __builtin_convertvector(v, bf16x2c_t); return __builtin_bit_cast(unsigned, b); }
typedef float f32x2 __attribute__((ext_vector_type(2)));
constexpr size_t O_Y = 0, O_CONVP = 68157440, O_KP = 68218880, O_VP = 135327744, O_RETP = 202436608, O_CONVS = 202698752, O_KS = 202944512, O_VS = 203993088, O_RETS = 205041664, O_END = 206090240;
__device__ __forceinline__ float sigm(float x) { return __builtin_amdgcn_rcpf(1.0f + __builtin_amdgcn_exp2f(-1.4426950408889634f * x)); }
__device__ __forceinline__ void st8(bf16_t* p, const float (&v)[8]) { u32x4 w; w.x = cvt_pk_bf16(v[0], v[1]); w.y = cvt_pk_bf16(v[2], v[3]); w.z = cvt_pk_bf16(v[4], v[5]); w.w = cvt_pk_bf16(v[6], v[7]); *(u32x4*)p = w; }
__device__ __forceinline__ void st8_nt(bf16_t* p, const float (&v)[8]) { u32x4 w; w.x = cvt_pk_bf16(v[0], v[1]); w.y = cvt_pk_bf16(v[2], v[3]); w.z = cvt_pk_bf16(v[4], v[5]); w.w = cvt_pk_bf16(v[6], v[7]); __builtin_nontemporal_store(w, (u32x4*)p); }

struct EpiGU {
    static constexpr bool PERM = true, AFTER_DRAIN = false;
    bf16_t* H; int ldh; int tiled;
    __device__ __forceinline__ void operator()(const f32x4 (&acc)[2][2][4][2], const Unit& u, int wr, int wc, int fr, int fq) const {
        const int row0 = u.pm * BM + wr * 64 + fr, col0 = u.pn * 128 + wc * 32 + 8 * fq;
#pragma unroll
        for (int ai = 0; ai < 2; ++ai)
#pragma unroll
            for (int m = 0; m < 4; ++m) {
                float h[8];
#pragma unroll
                for (int n = 0; n < 2; ++n)
#pragma unroll
                    for (int j = 0; j < 4; ++j) { const float g = acc[ai][0][m][n][j], uu = acc[ai][1][m][n][j]; h[n * 4 + j] = g * sigm(g) * uu; }
                { const int row = row0 + ai * HALF + m * 16; st8_nt(tiled ? H + ((size_t)((row >> 8) * (5632 / 64) + (col0 >> 6)) * 256 + (row & 255)) * 64 + (col0 & 63) : H + (size_t)row * ldh + col0, h); }
            }
    }
};
struct EpiRes {
    static constexpr bool PERM = false, AFTER_DRAIN = false;
    float* X; float alpha, scale;
    __device__ __forceinline__ void operator()(const f32x4 (&acc)[2][2][4][2], const Unit& u, int wr, int wc, int fr, int fq) const {
        const int row0 = u.pm * BM + wr * 64 + fr, col0 = u.pn * BM + wc * 32 + 4 * fq;
#pragma unroll
        for (int ai = 0; ai < 2; ++ai)
#pragma unroll
            for (int m = 0; m < 4; ++m) { float* rp = X + (size_t)(row0 + ai * HALF + m * 16) * 2048 + col0;
#pragma unroll
                for (int bj = 0; bj < 2; ++bj)
#pragma unroll
                    for (int n = 0; n < 2; ++n) { f32x4* q = (f32x4*)(rp + bj * HALF + n * 16); const f32x4 v = *q; *q = v * alpha + acc[ai][bj][m][n] * scale; } }
    }
};
struct EpiResB {
    static constexpr bool PERM = true, AFTER_DRAIN = false;
    bf16_t* XBp; float alpha, scale; float* slab;
    __device__ __forceinline__ void operator()(const f32x4 (&acc)[2][2][4][2], const Unit& u, int wr, int wc, int fr, int fq) const {
        const int row0 = u.pm * BM + wr * 64 + fr, col0 = u.pn * BM + wc * 32 + 8 * fq;
        if (u.pm >= 128) {
#pragma unroll
            for (int ai = 0; ai < 2; ++ai)
#pragma unroll
                for (int m = 0; m < 4; ++m) { float* rp = slab + ((size_t)u.ks * 512 + (row0 - 32768 + ai * HALF + m * 16)) * 2048 + col0;
#pragma unroll
                    for (int bj = 0; bj < 2; ++bj) { *(f32x4*)(rp + bj * HALF) = acc[ai][bj][m][0]; *(f32x4*)(rp + bj * HALF + 4) = acc[ai][bj][m][1]; } }
            return;
        }
        u32x4 res[2][4][2];
#pragma unroll
        for (int ai = 0; ai < 2; ++ai)
#pragma unroll
            for (int m = 0; m < 4; ++m)
#pragma unroll
                for (int bj = 0; bj < 2; ++bj) res[ai][m][bj] = *(const u32x4*)(XBp + (size_t)(row0 + ai * HALF + m * 16) * 2048 + col0 + bj * HALF);
        __builtin_amdgcn_sched_barrier(0);
#pragma unroll
        for (int ai = 0; ai < 2; ++ai)
#pragma unroll
            for (int m = 0; m < 4; ++m) { bf16_t* rp = XBp + (size_t)(row0 + ai * HALF + m * 16) * 2048 + col0;
#pragma unroll
                for (int bj = 0; bj < 2; ++bj) { const u32x4 w = res[ai][m][bj]; float y[8];
#pragma unroll
                    for (int n = 0; n < 2; ++n)
#pragma unroll
                        for (int j = 0; j < 4; ++j) { const unsigned ww = w[n * 2 + (j >> 1)]; const float x = __uint_as_float((j & 1) ? (ww & 0xffff0000u) : (ww << 16)); y[n * 4 + j] = x * alpha + acc[ai][bj][m][n][j] * scale; }
                    st8(rp + bj * HALF, y); } }
    }
};
struct EpiIn {
    static constexpr bool PERM = true, AFTER_DRAIN = false;
    int layer; float* out; bf16_t *U, *Q, *KB, *KS, *RQ, *RV; const float* cs;
    static constexpr size_t D_KV = 64u * 1024u * 1024u / 2u * 2u / 2u, D_S = 66u * 1024u * 1024u / 2u, D_R = 34078720u / 2u;
    __device__ __forceinline__ void operator()(const f32x4 (&acc)[2][2][4][2], const Unit& u, int wr, int wc, int fr, int fq) const {
        const int pn = u.pn, pm = u.pm; const bool smp = pm >= 128; const int cb = wc * 32 + 8 * fq;
        const int rbase = pm * BM + wr * 64 + fr;
#define ROWVARS const int row = rbase + ai * HALF + m * 16; int b, t; if (!smp) { b = row >> 14; t = row & 16383; } else { const int r2 = row - 32768; b = r2 >> 6; t = r2 & 63; }
        if (pn < 4) {
#pragma unroll
            for (int ai = 0; ai < 2; ++ai)
#pragma unroll
                for (int m = 0; m < 4; ++m) { ROWVARS
                    float v[8];
#pragma unroll
                    for (int n = 0; n < 2; ++n)
#pragma unroll
                        for (int j = 0; j < 4; ++j) v[n * 4 + j] = acc[ai][0][m][n][j] * sigm(acc[ai][1][m][n][j]);
                    st8(U + (size_t)row * 512 + pn * 128 + cb, v);
                    int jr; float* cp;
                    if (!smp) { jr = t - (16384 - 30); cp = out + O_CONVP + (size_t)((layer * 2 + b) * 30 + jr) * 512; }
                    else { jr = t - 34; cp = out + O_CONVS + (size_t)((layer * 8 + b) * 30 + jr) * 512; }
                    if (jr >= 0) { cp += pn * 128 + cb; *(f32x4*)cp = (f32x4){v[0], v[1], v[2], v[3]}; *(f32x4*)(cp + 4) = (f32x4){v[4], v[5], v[6], v[7]}; }
                }
        } else if (pn < 8) {
#pragma unroll
            for (int ai = 0; ai < 2; ++ai)
#pragma unroll
                for (int m = 0; m < 4; ++m) { const int row = rbase + ai * HALF + m * 16;
#pragma unroll
                    for (int bj = 0; bj < 2; ++bj) { float v[8];
#pragma unroll
                        for (int n = 0; n < 2; ++n)
#pragma unroll
                            for (int j = 0; j < 4; ++j) v[n * 4 + j] = acc[ai][bj][m][n][j] * 0.18033688011112042f;
                        st8(Q + (size_t)row * 1024 + (pn - 4) * 256 + bj * HALF + cb, v); } }
        } else if (pn < 16) {
            const bool isk = pn < 12; const int cq = ((pn - 8) & 3) * 256 + cb;
#pragma unroll
            for (int ai = 0; ai < 2; ++ai)
#pragma unroll
                for (int m = 0; m < 4; ++m) { ROWVARS
                    float* op; bf16_t* bp;
                    if (!smp) { op = out + O_KP + (isk ? (size_t)0 : O_VP - O_KP) + ((size_t)layer * 32768 + row) * 1024; bp = KB + (isk ? (size_t)0 : D_KV) + (size_t)row * 1024; }
                    else { op = out + O_KS + (isk ? (size_t)0 : O_VS - O_KS) + ((size_t)layer * 512 + (row - 32768)) * 1024; bp = KS + (isk ? (size_t)0 : D_S) + ((size_t)((layer * 8 + b) * 2112 + 2048 + t)) * 1024; }
#pragma unroll
                    for (int bj = 0; bj < 2; ++bj) { float v[8];
#pragma unroll
                        for (int n = 0; n < 2; ++n)
#pragma unroll
                            for (int j = 0; j < 4; ++j) v[n * 4 + j] = acc[ai][bj][m][n][j];
                        float* o2 = op + cq + bj * HALF; __builtin_nontemporal_store(acc[ai][bj][m][0], (f32x4*)o2); __builtin_nontemporal_store(acc[ai][bj][m][1], (f32x4*)(o2 + 4));
                        st8(bp + cq + bj * HALF, v); } }
        } else if (pn < 20) {
            const bool isq = pn < 18; const int hb = ((pn - 16) & 1) * 2;
#pragma unroll
            for (int ai = 0; ai < 2; ++ai) {
            f32x4 cc01[4], cc23[4];
#pragma unroll
                for (int m = 0; m < 4; ++m) { ROWVARS (void)b;
                    const int pos = smp ? 2048 + t : t; const float* c = cs + ((size_t)pos * 64 + (cb >> 1)) * 2;
                    cc01[m] = *(const f32x4*)c; cc23[m] = *(const f32x4*)(c + 4); }
            __builtin_amdgcn_sched_barrier(0);
#pragma unroll
                for (int m = 0; m < 4; ++m) { ROWVARS (void)b;
                    const int il = smp ? t : (row & 255);
                    const f32x4 c01 = cc01[m], c23 = cc23[m];
#pragma unroll
                    for (int bj = 0; bj < 2; ++bj) { const int head = hb + bj;
                        const float lg = head == 0 ? -0.04580368961312479f : head == 1 ? -0.02272007650008353f : head == 2 ? -0.011315313227834146f : -0.005646563141142063f;
                        const float e = (float)(il + 1) * lg; const float sc = isq ? __builtin_amdgcn_exp2f(e) : 0.08838834764831845f * __builtin_amdgcn_exp2f(-e);
                        const f32x4 x = acc[ai][bj][m][0], y = acc[ai][bj][m][1]; float v[8];
                        v[0] = (x[0] * c01[0] - x[1] * c01[1]) * sc; v[1] = (x[0] * c01[1] + x[1] * c01[0]) * sc;
                        v[2] = (x[2] * c01[2] - x[3] * c01[3]) * sc; v[3] = (x[2] * c01[3] + x[3] * c01[2]) * sc;
                        v[4] = (y[0] * c23[0] - y[1] * c23[1]) * sc; v[5] = (y[0] * c23[1] + y[1] * c23[0]) * sc;
                        v[6] = (y[2] * c23[2] - y[3] * c23[3]) * sc; v[7] = (y[2] * c23[3] + y[3] * c23[2]) * sc;
                        st8(RQ + (isq ? (size_t)0 : D_R) + (size_t)row * 512 + head * 128 + cb, v); } } }
        } else {
            const bool isv = pn < 22; const int cq = ((pn - 20) & 1) * 256 + cb;
#pragma unroll
            for (int ai = 0; ai < 2; ++ai)
#pragma unroll
                for (int m = 0; m < 4; ++m) { const int row = rbase + ai * HALF + m * 16;
#pragma unroll
                    for (int bj = 0; bj < 2; ++bj) { float v[8];
#pragma unroll
                        for (int n = 0; n < 2; ++n)
#pragma unroll
                            for (int j = 0; j < 4; ++j) { const float x = acc[ai][bj][m][n][j]; v[n * 4 + j] = isv ? x : x * sigm(x); }
                        st8(RV + (isv ? (size_t)0 : D_R) + (size_t)row * 512 + cq + bj * HALF, v); } }
        }
#undef ROWVARS
    }
};
template <class Epi, class Sched, bool ALIGN_EPI = false, bool SP2 = false>
__device__ __forceinline__ void gemm_phase(PG8_LAS unsigned char* lds, const Gemm g, const Sched& S, const Epi& E, int tid0) {
    int tid_ = tid0; asm volatile("" : "+v"(tid_));
    const int tid = tid_, wid = __builtin_amdgcn_readfirstlane(tid >> 6), lane = tid & 63, wr = wid >> 2, wc = wid & 3, fr = lane & 15, fq = lane >> 4;
    const int lda = g.lda, ldb = g.ldb;
    unsigned voffA[2], voffB[2];
#pragma unroll
    for (int i = 0; i < 2; ++i) { int R, C; stage_rc(tid * 16 + i * 8192, R, C); const int Rb = Epi::PERM ? ((R & ~31) + perm32(R & 31)) : R;
        voffA[i] = (unsigned)(R * lda + C) * 2u; voffB[i] = (unsigned)(Rb * ldb + C) * 2u; }
    const size_t ksA = g.ksA, ksB = g.ksB;
    const size_t hsA = (size_t)HALF * lda * 2, hsB = (size_t)HALF * ldb * 2;
    const size_t tsA = g.tsA, tsB = g.tsB;
    const unsigned ldsw = (unsigned)wid * 1024u;
    const int aoff = lds_byte(wr * 64 + fr, fq * 8), boff = lds_byte(wc * 32 + fr, fq * 8);
#define PG8_SA(b, h) (((b) * 2 + (h)) * HTB)
#define PG8_SB(b, h) ((4 + (b) * 2 + (h)) * HTB)
#define PG8_STAGE(bufoff, gbase, voff) do { _Pragma("unroll") for (int _i = 0; _i < 2; ++_i) \
        __builtin_amdgcn_global_load_lds((const unsigned*)((const char*)(gbase) + (voff)[_i]), (PG8_LAS unsigned*)(lds + (bufoff) + ldsw + _i * 8192), 16, 0, 0); } while (0)
#define PG8_LDA(dst, b, h) do { _Pragma("unroll") for (int m = 0; m < 4; ++m) _Pragma("unroll") for (int k = 0; k < 2; ++k) dst[m][k] = *(const PG8_LAS bf16x8*)(lds + PG8_SA(b, h) + aoff + m * 2048 + k * 1024); } while (0)
#define PG8_LDB(dst, b, h) do { _Pragma("unroll") for (int n = 0; n < 2; ++n) _Pragma("unroll") for (int k = 0; k < 2; ++k) dst[n][k] = *(const PG8_LAS bf16x8*)(lds + PG8_SB(b, h) + boff + n * 2048 + k * 1024); } while (0)
#define PG8_MMA(ai, bj, At, Bt) do { __builtin_amdgcn_s_setprio(1); _Pragma("unroll") for (int m = 0; m < 4; ++m) _Pragma("unroll") for (int n = 0; n < 2; ++n) _Pragma("unroll") for (int k = 0; k < 2; ++k) \
        acc[ai][bj][m][n] = __builtin_amdgcn_mfma_f32_16x16x32_bf16(Bt[n][k], At[m][k], acc[ai][bj][m][n], 0, 0, 0); __builtin_amdgcn_s_setprio(0); } while (0)
#define PG8_WAIT_V(n) asm volatile("s_waitcnt vmcnt(" #n ")" ::: "memory")
#define PG8_WAIT_L(n) asm volatile("s_waitcnt lgkmcnt(" #n ")" ::: "memory")
#define PG8_BAR __builtin_amdgcn_s_barrier()
#define PG8_SCHED __builtin_amdgcn_sched_barrier(0)
    Unit cur, nxt; int ui = 0;
    if (!S.next(0, cur)) return;
    f32x4 acc[2][2][4][2];
#pragma unroll
    for (int a = 0; a < 2; ++a)
#pragma unroll
        for (int b = 0; b < 2; ++b)
#pragma unroll
            for (int m = 0; m < 4; ++m)
#pragma unroll
                for (int n = 0; n < 2; ++n) acc[a][b][m][n] = (f32x4){0.f, 0.f, 0.f, 0.f};
    bf16x8 At[4][2], B0[2][2], B1[2][2];
    const char* cA = (const char*)g.A + (size_t)cur.pm * tsA + (size_t)cur.k0 * ksA; const char* cB = (const char*)g.Bt + (size_t)cur.pn * tsB + (size_t)cur.k0 * ksB;
    S.a_ready(cur);
    if constexpr (SP2) {
        PG8_STAGE(PG8_SB(0, 0), cB, voffB); PG8_STAGE(PG8_SB(0, 1), cB + hsB, voffB); PG8_STAGE(PG8_SA(0, 0), cA, voffA); PG8_STAGE(PG8_SA(0, 1), cA + hsA, voffA);
        if (wr == 1) PG8_BAR;
        PG8_WAIT_V(2); PG8_BAR;
        PG8_STAGE(PG8_SB(1, 0), cB + ksB, voffB); PG8_STAGE(PG8_SA(1, 0), cA + ksA, voffA); PG8_STAGE(PG8_SB(1, 1), cB + hsB + ksB, voffB);
        PG8_WAIT_V(6); PG8_BAR;
    } else {
        PG8_STAGE(PG8_SB(0, 0), cB, voffB); PG8_STAGE(PG8_SA(0, 0), cA, voffA); PG8_STAGE(PG8_SB(0, 1), cB + hsB, voffB); PG8_STAGE(PG8_SA(0, 1), cA + hsA, voffA);
        if (wr == 1) PG8_BAR;
        PG8_WAIT_V(4); PG8_BAR;
        PG8_STAGE(PG8_SB(1, 0), cB + ksB, voffB); PG8_STAGE(PG8_SA(1, 0), cA + ksA, voffA); PG8_STAGE(PG8_SB(1, 1), cB + hsB + ksB, voffB);
        PG8_WAIT_V(6); PG8_BAR;
    }
    for (;;) {
        const bool has_next = S.next(ui + 1, nxt);
        const char* nA = has_next ? (const char*)g.A + (size_t)nxt.pm * tsA + (size_t)nxt.k0 * ksA : cA; const char* nB = has_next ? (const char*)g.Bt + (size_t)nxt.pn * tsB + (size_t)nxt.k0 * ksB : cB;
        const int nt = cur.nt;
        for (int t = 0; t < nt; t += 2) {
            const bool last = (t == nt - 2);
            const char* a1 = cA + (size_t)(t + 1) * ksA;
            const char* a2 = last ? nA : cA + (size_t)(t + 2) * ksA; const char* b2 = last ? nB : cB + (size_t)(t + 2) * ksB;
            const char* a3 = a2 + ksA; const char* b3 = b2 + ksB;
            if (last && has_next) S.a_ready(nxt);
            if constexpr (SP2) {
            PG8_LDB(B0, 0, 0); PG8_LDB(B1, 0, 1); PG8_SCHED; PG8_LDA(At, 0, 0); PG8_STAGE(PG8_SA(1, 1), a1 + hsA, voffA);
            PG8_WAIT_V(8); PG8_WAIT_L(0); PG8_BAR; PG8_MMA(0, 0, At, B0); PG8_MMA(0, 1, At, B1); PG8_BAR; PG8_SCHED;
            PG8_LDA(At, 0, 1); PG8_STAGE(PG8_SB(0, 0), b2, voffB); PG8_STAGE(PG8_SB(0, 1), b2 + hsB, voffB); PG8_STAGE(PG8_SA(0, 0), a2, voffA);
            PG8_WAIT_V(8); PG8_WAIT_L(0); PG8_BAR; PG8_MMA(1, 0, At, B0); PG8_MMA(1, 1, At, B1); PG8_BAR; PG8_SCHED;
            PG8_LDB(B0, 1, 0); PG8_LDB(B1, 1, 1); PG8_SCHED; PG8_LDA(At, 1, 0); PG8_STAGE(PG8_SA(0, 1), a2 + hsA, voffA);
            PG8_WAIT_V(8); PG8_WAIT_L(0); PG8_BAR; PG8_MMA(0, 0, At, B0); PG8_MMA(0, 1, At, B1); PG8_BAR; PG8_SCHED;
            PG8_LDA(At, 1, 1); PG8_STAGE(PG8_SB(1, 0), b3, voffB); PG8_STAGE(PG8_SB(1, 1), b3 + hsB, voffB); PG8_STAGE(PG8_SA(1, 0), a3, voffA);
            PG8_WAIT_V(8); PG8_WAIT_L(0); PG8_BAR; PG8_MMA(1, 0, At, B0); PG8_MMA(1, 1, At, B1); PG8_BAR; PG8_SCHED;
            } else {
            PG8_LDB(B0, 0, 0); PG8_SCHED; PG8_LDA(At, 0, 0); PG8_STAGE(PG8_SA(1, 1), a1 + hsA, voffA);
            PG8_WAIT_L(8); PG8_BAR; PG8_WAIT_L(0); PG8_MMA(0, 0, At, B0); PG8_BAR; PG8_SCHED;
            PG8_LDB(B1, 0, 1); PG8_STAGE(PG8_SB(0, 0), b2, voffB);
            PG8_BAR; PG8_WAIT_L(0); PG8_MMA(0, 1, At, B1); PG8_BAR;
            PG8_LDA(At, 0, 1); PG8_STAGE(PG8_SA(0, 0), a2, voffA);
            PG8_BAR; PG8_WAIT_L(0); PG8_MMA(1, 0, At, B0); PG8_BAR; PG8_SCHED;
            PG8_STAGE(PG8_SB(0, 1), b2 + hsB, voffB);
            PG8_WAIT_V(6); PG8_BAR; PG8_MMA(1, 1, At, B1); PG8_BAR;
            PG8_LDB(B0, 1, 0); PG8_SCHED; PG8_LDA(At, 1, 0); PG8_STAGE(PG8_SA(0, 1), a2 + hsA, voffA);
            PG8_WAIT_L(8); PG8_BAR; PG8_WAIT_L(0); PG8_MMA(0, 0, At, B0); PG8_BAR; PG8_SCHED;
            PG8_LDB(B1, 1, 1); PG8_STAGE(PG8_SB(1, 0), b3, voffB);
            PG8_BAR; PG8_WAIT_L(0); PG8_MMA(0, 1, At, B1); PG8_BAR;
            PG8_LDA(At, 1, 1); PG8_STAGE(PG8_SA(1, 0), a3, voffA);
            PG8_BAR; PG8_WAIT_L(0); PG8_MMA(1, 0, At, B0); PG8_BAR; PG8_SCHED;
            PG8_STAGE(PG8_SB(1, 1), b3 + hsB, voffB);
            PG8_WAIT_V(6); PG8_BAR; PG8_MMA(1, 1, At, B1); PG8_BAR;
            }
        }
        if constexpr (ALIGN_EPI) { if (wr == 0) PG8_BAR; }
        if constexpr (!Epi::AFTER_DRAIN) { E(acc, cur, wr, wc, fr, fq); S.done(cur); }
        if (!has_next) break;
#pragma unroll
        for (int a = 0; a < 2; ++a)
#pragma unroll
            for (int b = 0; b < 2; ++b)
#pragma unroll
                for (int m = 0; m < 4; ++m)
#pragma unroll
                    for (int n = 0; n < 2; ++n) acc[a][b][m][n] = (f32x4){0.f, 0.f, 0.f, 0.f};
        cur = nxt; cA = nA; cB = nB; ++ui;
        if constexpr (ALIGN_EPI) { if (wr == 1) PG8_BAR; }
    }
    PG8_WAIT_V(0);
    if constexpr (!ALIGN_EPI) { if (wr == 0) PG8_BAR; }
    PG8_BAR;
    if constexpr (Epi::AFTER_DRAIN) { E.fused(acc, cur, wr, wc, fr, fq, lds, wid, lane); S.done(cur); }
#undef PG8_SA
#undef PG8_SB
#undef PG8_STAGE
#undef PG8_LDA
#undef PG8_LDB
#undef PG8_MMA
#undef PG8_WAIT_V
#undef PG8_WAIT_L
#undef PG8_BAR
#undef PG8_SCHED
}
}
namespace mx {
#define MLAS __attribute__((address_space(3)))
typedef unsigned short bf16_t;
typedef short bf16x8 __attribute__((ext_vector_type(8)));
typedef short s16x4 __attribute__((ext_vector_type(4)));
typedef short v4i16_t __attribute__((ext_vector_type(4)));
typedef float f32x16 __attribute__((ext_vector_type(16)));
typedef float f32x4 __attribute__((ext_vector_type(4)));
typedef unsigned u32x4 __attribute__((ext_vector_type(4)));
typedef unsigned u32x2 __attribute__((ext_vector_type(2)));
typedef MLAS const char* lds_cptr;
typedef MLAS char* lds_ptr;
__device__ __forceinline__ int crow(int r, int hi) { return (r & 3) + 8 * (r >> 2) + 4 * hi; }
typedef float f32x2_t __attribute__((ext_vector_type(2))); typedef __bf16 bf16x2_t __attribute__((ext_vector_type(2)));
__device__ __forceinline__ unsigned cvtpk(float lo, float hi) { f32x2_t v = {lo, hi}; bf16x2_t b = __builtin_convertvector(v, bf16x2_t); return __builtin_bit_cast(unsigned, b); }
__device__ __forceinline__ float bf2f(unsigned short h) { return __uint_as_float((unsigned)h << 16); }
__device__ __forceinline__ void glds16(const void* g, unsigned lds_base) {
    unsigned sv; asm volatile("s_mov_b32 %0, m0\n\ts_mov_b32 m0, %2\n\ts_nop 0\n\tglobal_load_lds_dwordx4 %1, off\n\ts_mov_b32 m0, %0" : "=&s"(sv) : "v"(g), "s"(lds_base) : "memory"); }
__device__ __forceinline__ s16x4 vtr(lds_cptr p) { return __builtin_bit_cast(s16x4, __builtin_amdgcn_ds_read_tr16_b64_v4i16((MLAS v4i16_t*)p)); }
#define MFMA32(a, b, c) __builtin_amdgcn_mfma_f32_32x32x16_bf16(a, b, c, 0, 0, 0)
#define MX_WAIT_BAR(N) asm volatile("s_waitcnt vmcnt(" #N ") lgkmcnt(0)\n\ts_barrier" ::: "memory")
#define RFL(x) ((unsigned)__builtin_amdgcn_readfirstlane((int)(x)))
#define SBAR() __builtin_amdgcn_sched_barrier(0)

template <int NKD> __device__ __forceinline__ void qkt(f32x16& p0, f32x16& p1, lds_cptr kb, const bf16x8* qr, const f32x16& c0) {
    __builtin_amdgcn_s_setprio(1);
#pragma unroll
    for (int d0 = 0; d0 < NKD; ++d0) {
        const bf16x8 b0 = *(const MLAS bf16x8*)(kb + d0 * 2048), b1 = *(const MLAS bf16x8*)(kb + d0 * 2048 + 512);
        if (d0 == 0) { p0 = MFMA32(b0, qr[0], c0); p1 = MFMA32(b1, qr[0], c0); } else { p0 = MFMA32(b0, qr[d0], p0); p1 = MFMA32(b1, qr[d0], p1); }
    }
    __builtin_amdgcn_s_setprio(0);
}
__device__ __forceinline__ void pv4(f32x16 (&o)[4], lds_cptr vp, const bf16x8 (&pa)[4]) {
    __builtin_amdgcn_s_setprio(1);
#pragma unroll
    for (int e0 = 0; e0 < 4; ++e0)
#pragma unroll
        for (int ks = 0; ks < 4; ++ks) {
            const s16x4 lo = vtr(vp + e0 * 4096 + ks * 1024), hh = vtr(vp + e0 * 4096 + ks * 1024 + 512);
            const bf16x8 vf = {lo[0], lo[1], lo[2], lo[3], hh[0], hh[1], hh[2], hh[3]};
            o[e0] = MFMA32(pa[ks], vf, o[e0]);
        }
    __builtin_amdgcn_s_setprio(0);
}
__device__ __forceinline__ void packP(bf16x8 (&pa)[4], const f32x16& p0, const f32x16& p1) {
    u32x4 w;
    w.x = cvtpk(p0[0], p0[1]); w.y = cvtpk(p0[2], p0[3]); w.z = cvtpk(p0[4], p0[5]); w.w = cvtpk(p0[6], p0[7]); pa[0] = __builtin_bit_cast(bf16x8, w);
    w.x = cvtpk(p0[8], p0[9]); w.y = cvtpk(p0[10], p0[11]); w.z = cvtpk(p0[12], p0[13]); w.w = cvtpk(p0[14], p0[15]); pa[1] = __builtin_bit_cast(bf16x8, w);
    w.x = cvtpk(p1[0], p1[1]); w.y = cvtpk(p1[2], p1[3]); w.z = cvtpk(p1[4], p1[5]); w.w = cvtpk(p1[6], p1[7]); pa[2] = __builtin_bit_cast(bf16x8, w);
    w.x = cvtpk(p1[8], p1[9]); w.y = cvtpk(p1[10], p1[11]); w.z = cvtpk(p1[12], p1[13]); w.w = cvtpk(p1[14], p1[15]); pa[3] = __builtin_bit_cast(bf16x8, w);
}
__device__ __forceinline__ float swapsum(float v) { auto rr = __builtin_amdgcn_permlane32_swap(__float_as_uint(v), __float_as_uint(v), false, false); return __uint_as_float(rr[0]) + __uint_as_float(rr[1]); }
__device__ __forceinline__ float swapmax(float v) { auto rr = __builtin_amdgcn_permlane32_swap(__float_as_uint(v), __float_as_uint(v), false, false); return __builtin_fmaxf(__uint_as_float(rr[0]), __uint_as_float(rr[1])); }
__device__ __forceinline__ float half_sum(float v, int lane) {
#pragma unroll
    for (int o = 1; o < 32; o <<= 1) v += __builtin_bit_cast(float, __builtin_amdgcn_ds_bpermute((lane ^ o) << 2, __builtin_bit_cast(int, v)));
    return v;
}
constexpr int A_K = 0, A_KSLOT = 8192, A_V = 3 * A_KSLOT, A_VSLOT = 16384, A_WS = A_V + 3 * A_VSLOT, A_BT = A_WS + 8 * 256, A_END = A_BT + 320 * 4;
#define MX_PIN(x) asm volatile("" : "+v"(x))
template <int THR>
__device__ __forceinline__ void attn_pass(lds_ptr lds, unsigned lds0, int lane, int wid, const bf16_t* Qw, const bf16_t* Kh, const bf16_t* Vh, int NTwg, int NTw, int qpos_w, f32x16 (&o)[4]) {
    const int r32 = lane & 31, hi = lane >> 5;
    const unsigned koff = (unsigned)(lane * 1024 + wid * 8) * 2u, voff = (unsigned)((16 * (wid & 3) + (lane >> 2)) * 1024 + (wid >> 2) * 32 + (lane & 3) * 8) * 2u;
    const unsigned kdst = lds0 + A_K + wid * 1024, vdst = lds0 + A_V + wid * 1024;
    MLAS float* wsf = (MLAS float*)(lds + A_WS) + wid * 64;
    const MLAS float* BT = (const MLAS float*)(lds + A_BT);
    const int trofs = ((lane >> 4) & 1) * 32 + (lane & 3) * 8 + (4 * hi + ((lane & 15) >> 2)) * 64;
#define MX_DMA_K(t, ko) do { unsigned o_ = koff; asm volatile("" : "+v"(o_)); glds16((const char*)Kh + (size_t)(t) * 131072 + o_, RFL(kdst + (ko))); } while (0)
#define MX_DMA_V(t, vo) do { unsigned o_ = voff; asm volatile("" : "+v"(o_)); const char* vs_ = (const char*)Vh + (size_t)(t) * 131072 + o_; glds16(vs_, RFL(vdst + (vo))); glds16(vs_ + 128, RFL(vdst + (vo) + 8192)); } while (0)
    bf16x8 qr[4];
#pragma unroll
    for (int d0 = 0; d0 < 4; ++d0) qr[d0] = (bf16x8){0, 0, 0, 0, 0, 0, 0, 0};
    if (NTw > 0) {
#pragma unroll
        for (int d0 = 0; d0 < 4; ++d0) qr[d0] = *(const bf16x8*)(Qw + (size_t)r32 * 1024 + d0 * 16 + hi * 8);
    }
    MX_DMA_K(0, 0); MX_DMA_V(0, 0);
    if (NTwg > 1) MX_DMA_K(1, A_KSLOT);
    float l = 0.f; f32x16 negm, pA0, pA1, pB0, pB1; bool resc = false;
#pragma unroll
    for (int r = 0; r < 16; ++r) { negm[r] = 0.f; pA0[r] = 0.f; pA1[r] = 0.f; pB0[r] = 0.f; pB1[r] = 0.f; }
#pragma unroll
    for (int e0 = 0; e0 < 4; ++e0)
#pragma unroll
        for (int r = 0; r < 16; ++r) o[e0][r] = 0.f;
    u32x4 pw0, pw1, pw2, pw3;
#define MX_KLD(ko) const lds_cptr kb_ = (lds_cptr)(lds + A_K + (ko) + hi * 1024 + r32 * 16); bf16x8 kf[8]; \
        _Pragma("unroll") for (int d0 = 0; d0 < 4; ++d0) { kf[2 * d0] = *(const MLAS bf16x8*)(kb_ + d0 * 2048); kf[2 * d0 + 1] = *(const MLAS bf16x8*)(kb_ + d0 * 2048 + 512); } SBAR();
#define MX_GA(MF, P, B, W, X0, X1) do { MF; sacc += (P[B] + P[B + 1]) + (P[B + 2] + P[B + 3]); MX_PIN(sacc); W[X0] = cvtpk(P[B], P[B + 1]); W[X1] = cvtpk(P[B + 2], P[B + 3]); MX_PIN(W); SBAR(); } while (0)
#define MX_PHASE_A(C0, C1, N0, N1, ko, PRE) do { MX_KLD(ko) PRE; SBAR(); float sacc = 0.f; \
        MX_GA(N0 = MFMA32(kf[0], qr[0], negm), C0, 0, pw0, 0, 1);  MX_GA(N1 = MFMA32(kf[1], qr[0], negm), C0, 4, pw0, 2, 3); \
        MX_GA(N0 = MFMA32(kf[2], qr[1], N0),   C0, 8, pw1, 0, 1);  MX_GA(N1 = MFMA32(kf[3], qr[1], N1),   C0, 12, pw1, 2, 3); \
        MX_GA(N0 = MFMA32(kf[4], qr[2], N0),   C1, 0, pw2, 0, 1);  MX_GA(N1 = MFMA32(kf[5], qr[2], N1),   C1, 4, pw2, 2, 3); \
        MX_GA(N0 = MFMA32(kf[6], qr[3], N0),   C1, 8, pw3, 0, 1);  MX_GA(N1 = MFMA32(kf[7], qr[3], N1),   C1, 12, pw3, 2, 3); \
        l += sacc; } while (0)
#define MX_MID(N0, N1, t, FIRST) do { \
        if (64 * (t) + 63 - qpos_w > -128) { const int base = 64 * (t) - (qpos_w + r32) + 255; \
            _Pragma("unroll") for (int r = 0; r < 16; ++r) { N0[r] += BT[base + crow(r, hi)]; N1[r] += BT[base + 32 + crow(r, hi)]; } } \
        float m8_[8]; \
        _Pragma("unroll") for (int q = 0; q < 8; ++q) m8_[q] = __builtin_fmaxf(__builtin_fmaxf(N0[2 * q], N0[2 * q + 1]), __builtin_fmaxf(N1[2 * q], N1[2 * q + 1])); \
        float rm = __builtin_fmaxf(__builtin_fmaxf(__builtin_fmaxf(m8_[0], m8_[1]), __builtin_fmaxf(m8_[2], m8_[3])), __builtin_fmaxf(__builtin_fmaxf(m8_[4], m8_[5]), __builtin_fmaxf(m8_[6], m8_[7])));   \
        rm = swapmax(rm); \
        if (FIRST || __any(rm > (float)THR)) { const float dl = FIRST ? rm : __builtin_fmaxf(rm, 0.f); \
            _Pragma("unroll") for (int r = 0; r < 16; ++r) { N0[r] -= dl; N1[r] -= dl; negm[r] -= dl; } \
            const float f = __builtin_amdgcn_exp2f(-dl); l *= f; if (hi == 0) wsf[r32] = f; resc = !(FIRST); } } while (0)
#define MX_VFRAG(i) do { const s16x4 lo_ = vtr(vp_ + ((i) & 3) * 4096 + ((i) >> 2) * 1024), hh_ = vtr(vp_ + ((i) & 3) * 4096 + ((i) >> 2) * 1024 + 512); vf[(i) & 7] = (bf16x8){lo_[0], lo_[1], lo_[2], lo_[3], hh_[0], hh_[1], hh_[2], hh_[3]}; } while (0)
#define MX_PAF(k) __builtin_bit_cast(bf16x8, pw##k)
#define MX_GB(i, PK, X, B) do { if ((i) + 4 < 16) MX_VFRAG((i) + 4); o[(i) & 3] = MFMA32(PK, vf[(i) & 7], o[(i) & 3]); X[B] = __builtin_amdgcn_exp2f(X[B]); X[B + 1] = __builtin_amdgcn_exp2f(X[B + 1]); MX_PIN(X); SBAR(); } while (0)
#define MX_PHASE_B_PRE(vo) const lds_cptr vp_ = (lds_cptr)(lds + A_V + (vo) + trofs); bf16x8 vf[8]; MX_VFRAG(0); MX_VFRAG(1); MX_VFRAG(2); MX_VFRAG(3); SBAR();
#define MX_PHASE_B(N0, N1, vo, DOEXP) do { MX_PHASE_B_PRE(vo) MX_PHASE_B_BODY(N0, N1); } while (0)
#define MX_PHASE_B_BODY(N0, N1) do { \
        MX_GB(0, MX_PAF(0), N0, 0);  MX_GB(1, MX_PAF(0), N0, 2);  MX_GB(2, MX_PAF(0), N0, 4);  MX_GB(3, MX_PAF(0), N0, 6); \
        MX_GB(4, MX_PAF(1), N0, 8);  MX_GB(5, MX_PAF(1), N0, 10); MX_GB(6, MX_PAF(1), N0, 12); MX_GB(7, MX_PAF(1), N0, 14); \
        MX_GB(8, MX_PAF(2), N1, 0);  MX_GB(9, MX_PAF(2), N1, 2);  MX_GB(10, MX_PAF(2), N1, 4); MX_GB(11, MX_PAF(2), N1, 6); \
        MX_GB(12, MX_PAF(3), N1, 8); MX_GB(13, MX_PAF(3), N1, 10); MX_GB(14, MX_PAF(3), N1, 12); MX_GB(15, MX_PAF(3), N1, 14); \
        if (resc) { resc = false; \
            _Pragma("unroll") for (int r = 0; r < 16; ++r) { const float f = wsf[crow(r, hi)]; \
                _Pragma("unroll") for (int e0 = 0; e0 < 4; ++e0) o[e0][r] *= f; } } } while (0)
#define MX_STEP_WAIT(t) do { if ((t) + 1 < NTwg) MX_WAIT_BAR(3); else MX_WAIT_BAR(2); } while (0)
#define MX_STEP_DMA(t) do { if ((t) + 2 < NTwg) MX_DMA_K((t) + 2, kp); if ((t) + 1 < NTwg) MX_DMA_V((t) + 1, vq); } while (0)
#define MX_STEP_BEGIN(t) do { MX_STEP_WAIT(t); MX_STEP_DMA(t); } while (0)
#define MX_STEP_END() do { const int k_ = kp; kp = kc; kc = kn; kn = k_; const int v_ = vq; vq = vp; vp = vc; vc = v_; } while (0)
#define MX_STEP(C0, C1, N0, N1, t) do { MX_STEP_WAIT(t); MX_PHASE_A(C0, C1, N0, N1, kc, MX_STEP_DMA(t)); MX_PHASE_B_PRE(vp) MX_MID(N0, N1, t, false); MX_PHASE_B_BODY(N0, N1); MX_STEP_END(); } while (0)
#define MX_TAIL(X0, X1) do { float sacc = 0.f; \
        _Pragma("unroll") for (int r = 0; r < 16; ++r) sacc += X0[r] + X1[r]; l += sacc; \
        pw0 = (u32x4){cvtpk(X0[0], X0[1]), cvtpk(X0[2], X0[3]), cvtpk(X0[4], X0[5]), cvtpk(X0[6], X0[7])}; pw1 = (u32x4){cvtpk(X0[8], X0[9]), cvtpk(X0[10], X0[11]), cvtpk(X0[12], X0[13]), cvtpk(X0[14], X0[15])}; \
        pw2 = (u32x4){cvtpk(X1[0], X1[1]), cvtpk(X1[2], X1[3]), cvtpk(X1[4], X1[5]), cvtpk(X1[6], X1[7])}; pw3 = (u32x4){cvtpk(X1[8], X1[9]), cvtpk(X1[10], X1[11]), cvtpk(X1[12], X1[13]), cvtpk(X1[14], X1[15])}; \
        const lds_cptr vp_ = (lds_cptr)(lds + A_V + vp + trofs); bf16x8 vf[8]; \
        _Pragma("unroll") for (int ks = 0; ks < 4; ++ks) { \
            MX_VFRAG(4 * ks); MX_VFRAG(4 * ks + 1); MX_VFRAG(4 * ks + 2); MX_VFRAG(4 * ks + 3); \
            const bf16x8 pk_ = ks == 0 ? MX_PAF(0) : ks == 1 ? MX_PAF(1) : ks == 2 ? MX_PAF(2) : MX_PAF(3); \
            o[0] = MFMA32(pk_, vf[(4 * ks) & 7], o[0]); o[1] = MFMA32(pk_, vf[(4 * ks + 1) & 7], o[1]); o[2] = MFMA32(pk_, vf[(4 * ks + 2) & 7], o[2]); o[3] = MFMA32(pk_, vf[(4 * ks + 3) & 7], o[3]); } } while (0)
    MX_WAIT_BAR(0);
    asm volatile("" : "+v"(qr[0]), "+v"(qr[1]), "+v"(qr[2]), "+v"(qr[3]));
    int kp = 2 * A_KSLOT, kc = 0, kn = A_KSLOT, vq = A_VSLOT, vp = 2 * A_VSLOT, vc = 0;
    int t = 0; bool inA = true;
    if (NTw > 0) {
        if (2 < NTwg) MX_DMA_K(2, kp); if (1 < NTwg) MX_DMA_V(1, vq);
        { MX_KLD(kc) pA0 = MFMA32(kf[0], qr[0], negm); pA1 = MFMA32(kf[1], qr[0], negm);
#pragma unroll
          for (int d0 = 1; d0 < 4; ++d0) { pA0 = MFMA32(kf[2 * d0], qr[d0], pA0); pA1 = MFMA32(kf[2 * d0 + 1], qr[d0], pA1); } }
        MX_MID(pA0, pA1, 0, true);
#pragma unroll
        for (int r = 0; r < 16; ++r) { pA0[r] = __builtin_amdgcn_exp2f(pA0[r]); pA1[r] = __builtin_amdgcn_exp2f(pA1[r]); }
        MX_STEP_END(); t = 1;
        for (; t + 1 < NTw; t += 2) { MX_STEP(pA0, pA1, pB0, pB1, t); MX_STEP(pB0, pB1, pA0, pA1, t + 1); }
        if (t < NTw) { MX_STEP(pA0, pA1, pB0, pB1, t); ++t; inA = false; }
    } else {
        if (2 < NTwg) MX_DMA_K(2, kp); if (1 < NTwg) MX_DMA_V(1, vq);
        MX_STEP_END(); t = 1;
    }
    bool pend = NTw > 0;
    for (; t < NTwg; ++t) {
        MX_STEP_BEGIN(t);
        if (pend) { pend = false; if (inA) MX_TAIL(pA0, pA1); else MX_TAIL(pB0, pB1); }
        MX_STEP_END();
    }
    MX_WAIT_BAR(0);
    if (pend) { if (inA) MX_TAIL(pA0, pA1); else MX_TAIL(pB0, pB1); }
    MX_WAIT_BAR(0);
    if (NTw > 0) {
        l = swapsum(l);
        if (hi == 0) wsf[32 + r32] = l;
#pragma unroll
        for (int r = 0; r < 16; ++r) { const float rl = __builtin_amdgcn_rcpf(wsf[32 + crow(r, hi)]);
#pragma unroll
            for (int e0 = 0; e0 < 4; ++e0) o[e0][r] *= rl; }
    }
#undef MX_DMA_K
#undef MX_DMA_V
#undef MX_KLD
#undef MX_GA
#undef MX_PHASE_A
#undef MX_MID
#undef MX_VFRAG
#undef MX_PAF
#undef MX_GB
#undef MX_PHASE_B
#undef MX_PHASE_B_PRE
#undef MX_PHASE_B_BODY
#undef MX_STEP_BEGIN
#undef MX_STEP_WAIT
#undef MX_STEP_DMA
#undef MX_STEP_END
#undef MX_STEP
#undef MX_TAIL
}
__device__ __forceinline__ void attn_unit(lds_ptr lds, unsigned lds0, int tid, const bf16_t* Q, const bf16_t* Kseq, const bf16_t* Vseq, int qrow0, int pos0, int NTwg, int nact, int h,
                                          const float* BTg, int layer, const float* subg, float* scr, bf16_t* MIX) {
    asm volatile("" : "+v"(tid));
    const int lane = tid & 63, wid = __builtin_amdgcn_readfirstlane(tid >> 6), r32 = lane & 31, hi = lane >> 5;
    if (tid < 320) ((MLAS float*)(lds + A_BT))[tid] = BTg[h * 320 + tid];
    const int NTw = wid < nact ? (pos0 + 32 * wid) / 64 + 1 : 0, qpos_w = pos0 + 32 * wid;
    const bf16_t* Qw = Q + (size_t)(qrow0 + 32 * (wid < nact ? wid : 0)) * 1024 + h * 128;
    float* myscr = scr + (size_t)wid * 4096 + lane * 64;
    f32x16 o[4];
    attn_pass<8>(lds, lds0, lane, wid, Qw, Kseq + h * 128, Vseq + h * 128, NTwg, NTw, qpos_w, o);
    if (NTw > 0) {
#pragma unroll
        for (int e0 = 0; e0 < 4; ++e0)
#pragma unroll
            for (int r = 0; r < 16; r += 4) *(f32x4*)(myscr + e0 * 16 + r) = (f32x4){o[e0][r], o[e0][r + 1], o[e0][r + 2], o[e0][r + 3]};
    }
    asm volatile("s_waitcnt vmcnt(0)" ::: "memory");
    attn_pass<8>(lds, lds0, lane, wid, Qw + 64, Kseq + h * 128 + 64, Vseq + h * 128, NTwg, NTw, qpos_w, o);
    if (NTw > 0) {
        const float lam = __builtin_bit_cast(float, __builtin_amdgcn_readfirstlane(__builtin_bit_cast(int, BTg[2560 + layer]))), oml = BTg[2562 + layer];
        float ss[16];
#pragma unroll
        for (int r = 0; r < 16; ++r) ss[r] = 0.f;
        f32x4 sv[16];
        asm volatile("global_load_dwordx4 %0, %16, off sc1\n\tglobal_load_dwordx4 %1, %16, off offset:16 sc1\n\tglobal_load_dwordx4 %2, %16, off offset:32 sc1\n\tglobal_load_dwordx4 %3, %16, off offset:48 sc1\n\t"
                     "global_load_dwordx4 %4, %16, off offset:64 sc1\n\tglobal_load_dwordx4 %5, %16, off offset:80 sc1\n\tglobal_load_dwordx4 %6, %16, off offset:96 sc1\n\tglobal_load_dwordx4 %7, %16, off offset:112 sc1\n\t"
                     "global_load_dwordx4 %8, %16, off offset:128 sc1\n\tglobal_load_dwordx4 %9, %16, off offset:144 sc1\n\tglobal_load_dwordx4 %10, %16, off offset:160 sc1\n\tglobal_load_dwordx4 %11, %16, off offset:176 sc1\n\t"
                     "global_load_dwordx4 %12, %16, off offset:192 sc1\n\tglobal_load_dwordx4 %13, %16, off offset:208 sc1\n\tglobal_load_dwordx4 %14, %16, off offset:224 sc1\n\tglobal_load_dwordx4 %15, %16, off offset:240 sc1\n\t"
                     "s_waitcnt vmcnt(0)"
                     : "=&v"(sv[0]), "=&v"(sv[1]), "=&v"(sv[2]), "=&v"(sv[3]), "=&v"(sv[4]), "=&v"(sv[5]), "=&v"(sv[6]), "=&v"(sv[7]),
                       "=&v"(sv[8]), "=&v"(sv[9]), "=&v"(sv[10]), "=&v"(sv[11]), "=&v"(sv[12]), "=&v"(sv[13]), "=&v"(sv[14]), "=&v"(sv[15])
                     : "v"(myscr) : "memory");
#pragma unroll
        for (int e0 = 0; e0 < 4; ++e0)
#pragma unroll
            for (int r = 0; r < 16; ++r) { const float d = sv[e0 * 4 + (r >> 2)][r & 3] - lam * o[e0][r]; o[e0][r] = d; ss[r] += d * d; }
#pragma unroll
        for (int r = 0; r < 16; ++r) ss[r] = oml * __builtin_amdgcn_rsqf(half_sum(ss[r], lane) * (1.0f / 128.0f) + 1e-5f);
        bf16_t* mp = MIX + (size_t)(qrow0 + 32 * wid + 4 * hi) * 2048 + 512 + h * 128 + r32;
        const float sg0 = subg[r32], sg1 = subg[32 + r32], sg2 = subg[64 + r32], sg3 = subg[96 + r32];
#pragma unroll
        for (int r = 0; r < 16; ++r) { int z_ = 0; asm volatile("" : "+v"(z_)); bf16_t* mr = mp + (size_t)crow(r, 0) * 2048 + z_;
#pragma unroll
            for (int e0 = 0; e0 < 4; ++e0) { const unsigned w = cvtpk(o[e0][r] * ss[r] * (e0 == 0 ? sg0 : e0 == 1 ? sg1 : e0 == 2 ? sg2 : sg3), 0.f); mr[e0 * 32] = (bf16_t)(w & 0xffffu); } }
    }
    asm volatile("s_waitcnt vmcnt(0)" ::: "memory");
}
__device__ __forceinline__ void ret_kv_unit(lds_ptr lds, unsigned lds0, int tid, const bf16_t* RKh, const bf16_t* RVh, int ntile, float* KVTu) {
    asm volatile("" : "+v"(tid));
    const int lane = tid & 63, wid = __builtin_amdgcn_readfirstlane(tid >> 6), r32 = lane & 31, hi = lane >> 5;
    const int trofs = ((lane >> 4) & 1) * 32 + (lane & 3) * 8 + (4 * hi + ((lane & 15) >> 2)) * 64;
    const size_t so = (size_t)(16 * (wid & 3) + (lane >> 2)) * 512 + (wid >> 2) * 32 + (lane & 3) * 8;
    for (int jt = 0; jt < ntile; ++jt) {
        const bf16_t* ks = RKh + (size_t)jt * 64 * 512 + so; const bf16_t* vs = RVh + (size_t)jt * 64 * 512 + so;
        glds16(ks, RFL(lds0 + jt * 16384 + wid * 1024)); glds16(ks + 64, RFL(lds0 + jt * 16384 + 8192 + wid * 1024));
        glds16(vs, RFL(lds0 + 65536 + jt * 16384 + wid * 1024)); glds16(vs + 64, RFL(lds0 + 65536 + jt * 16384 + 8192 + wid * 1024));
    }
    MX_WAIT_BAR(0);
    const int e0 = wid >> 1, d0a = 2 * (wid & 1);
    f32x16 acc[2];
#pragma unroll
    for (int i = 0; i < 2; ++i)
#pragma unroll
        for (int r = 0; r < 16; ++r) acc[i][r] = 0.f;
    for (int jt = 0; jt < ntile; ++jt) {
#pragma unroll
        for (int ks = 0; ks < 4; ++ks) {
            const lds_cptr vp = (lds_cptr)(lds + 65536 + jt * 16384 + e0 * 4096 + ks * 1024 + trofs);
            const s16x4 alo = vtr(vp), ahi = vtr(vp + 512);
            const bf16x8 af = {alo[0], alo[1], alo[2], alo[3], ahi[0], ahi[1], ahi[2], ahi[3]};
#pragma unroll
            for (int i = 0; i < 2; ++i) {
                const lds_cptr kp = (lds_cptr)(lds + jt * 16384 + (d0a + i) * 4096 + ks * 1024 + trofs);
                const s16x4 blo = vtr(kp), bhi = vtr(kp + 512);
                const bf16x8 bfr = {blo[0], blo[1], blo[2], blo[3], bhi[0], bhi[1], bhi[2], bhi[3]};
                acc[i] = MFMA32(af, bfr, acc[i]);
            }
        }
    }
    float* kp0 = KVTu + (32 * e0 + 4 * hi) * 128 + 32 * d0a + r32;
#pragma unroll
    for (int r = 0; r < 16; ++r) { int z_ = 0; asm volatile("" : "+v"(z_)); float* kr = kp0 + crow(r, 0) * 128 + z_; kr[0] = acc[0][r]; kr[32] = acc[1][r]; }
    MX_WAIT_BAR(0);
}
__device__ __forceinline__ void ret_out_unit(lds_ptr lds, unsigned lds0, int tid, const bf16_t* RQh, const bf16_t* RKh, const bf16_t* RVh, const bf16_t* RGh, const bf16_t* SPu,
                                             int ntile, int nact, bf16_t* MIXh) {
    asm volatile("" : "+v"(tid));
    const int lane = tid & 63, wid = __builtin_amdgcn_readfirstlane(tid >> 6), r32 = lane & 31, hi = lane >> 5;
    const int trofs = ((lane >> 4) & 1) * 32 + (lane & 3) * 8 + (4 * hi + ((lane & 15) >> 2)) * 64;
    const size_t so = (size_t)(16 * (wid & 3) + (lane >> 2)) * 512 + (wid >> 2) * 32 + (lane & 3) * 8;
    for (int jt = 0; jt < ntile; ++jt) {
        const bf16_t* ks = RKh + (size_t)(jt * 64 + lane) * 512 + wid * 8; const bf16_t* vs = RVh + (size_t)jt * 64 * 512 + so;
        glds16(ks, RFL(lds0 + jt * 16384 + wid * 1024)); glds16(ks + 64, RFL(lds0 + jt * 16384 + 8192 + wid * 1024));
        glds16(vs, RFL(lds0 + 65536 + jt * 16384 + wid * 1024)); glds16(vs + 64, RFL(lds0 + 65536 + jt * 16384 + 8192 + wid * 1024));
    }
    const bool act = wid < nact;
    bf16x8 qr[8]; f32x16 o[4];
#pragma unroll
    for (int e0 = 0; e0 < 4; ++e0)
#pragma unroll
        for (int r = 0; r < 16; ++r) o[e0][r] = 0.f;
    if (act) {
#pragma unroll
        for (int kd = 0; kd < 8; ++kd) qr[kd] = *(const bf16x8*)(RQh + (size_t)(32 * wid + r32) * 512 + kd * 16 + hi * 8);
#pragma unroll
        for (int e0 = 0; e0 < 4; ++e0) { bf16x8 sf[8];
#pragma unroll
            for (int kd = 0; kd < 8; ++kd) sf[kd] = *(const bf16x8*)(SPu + (size_t)(32 * e0 + r32) * 128 + 16 * kd + 8 * hi);
            SBAR();
#pragma unroll
            for (int kd = 0; kd < 8; ++kd) o[e0] = MFMA32(qr[kd], sf[kd], o[e0]);
            SBAR(); }
    } else {
#pragma unroll
        for (int kd = 0; kd < 8; ++kd) qr[kd] = (bf16x8){0, 0, 0, 0, 0, 0, 0, 0};
    }
    MX_WAIT_BAR(0);
    if (act) {
        const int jd = wid >> 1; f32x16 zero;
#pragma unroll
        for (int r = 0; r < 16; ++r) zero[r] = 0.f;

#ifndef RO_SKIP_INNER
#define RO_SKIP_INNER 0
#endif
        if (!RO_SKIP_INNER) for (int jt = 0; jt <= jd; ++jt) {
            f32x16 p0, p1;
#ifndef RO_CONST_P
            qkt<8>(p0, p1, (lds_cptr)(lds + jt * 16384 + hi * 1024 + r32 * 16), qr, zero);
#else
            for (int r = 0; r < 16; ++r) { p0[r] = 1.0f; p1[r] = 0.5f; }
#endif
            if (jt == jd) { const int q = 32 * wid + r32;
#pragma unroll
                for (int r = 0; r < 16; ++r) { const int k0 = 64 * jt + crow(r, hi); p0[r] = (k0 <= q) ? p0[r] : 0.f; p1[r] = (k0 + 32 <= q) ? p1[r] : 0.f; } }
            bf16x8 pa[4]; packP(pa, p0, p1);
            pv4(o, (lds_cptr)(lds + 65536 + jt * 16384 + trofs), pa);
        }
        float mu[16];
#pragma unroll
        for (int r = 0; r < 16; ++r) { mu[r] = half_sum((o[0][r] + o[1][r]) + (o[2][r] + o[3][r]), lane) * (1.0f / 128.0f); }
        float rs[16];
#pragma unroll
        for (int r = 0; r < 16; ++r) { float q = 0.f;
#pragma unroll
            for (int e0 = 0; e0 < 4; ++e0) { const float d = o[e0][r] - mu[r]; o[e0][r] = d; q += d * d; }
            rs[r] = __builtin_amdgcn_rsqf(half_sum(q, lane) * (1.0f / 128.0f) + 1e-5f); }
        const bf16_t* gp0 = RGh + (size_t)(32 * wid + 4 * hi) * 512 + r32; bf16_t* mp0 = MIXh + (size_t)(32 * wid + 4 * hi) * 2048 + r32;
        unsigned short gv[16][4];
#pragma unroll
        for (int r = 0; r < 16; ++r) { int z_ = 0; asm volatile("" : "+v"(z_)); const bf16_t* gr = gp0 + (size_t)crow(r, 0) * 512 + z_;
#pragma unroll
            for (int e0 = 0; e0 < 4; ++e0) gv[r][e0] = gr[e0 * 32]; }
        SBAR();
#pragma unroll
        for (int r = 0; r < 16; ++r) { int z_ = 0; asm volatile("" : "+v"(z_)); bf16_t* mr = mp0 + (size_t)crow(r, 0) * 2048 + z_;
#pragma unroll
            for (int e0 = 0; e0 < 4; ++e0) { const unsigned w = cvtpk(o[e0][r] * rs[r] * bf2f(gv[r][e0]), 0.f); mr[e0 * 32] = (bf16_t)(w & 0xffffu); } }
    }
    MX_WAIT_BAR(0);
}
#undef RFL
}
constexpr int NWAVES = 8;
constexpr int DM = 2048, MP = 32768, MS = 512, M = MP + MS, DFF = 5632, DIN = 6144;
#ifndef H_PITCH
#define H_PITCH 5696
#endif
constexpr int HP = H_PITCH;
constexpr float ALPHA = 1.4142135623730951f, LN_EPS = 1e-5f;
constexpr size_t HMiB = 512u * 1024u;
constexpr size_t WS_CTL = 0, CTL_ZERO_BYTES = 2 * HMiB;
constexpr size_t WS_TAB = 2 * HMiB;
constexpr size_t WS_CS = 4 * HMiB;
constexpr size_t WS_WGU = 20 * HMiB;
constexpr size_t WS_WD = WS_WGU + 352 * HMiB;
constexpr size_t WS_WIN = WS_WD + 180 * HMiB;
constexpr size_t WS_WOUT = WS_WIN + 96 * HMiB;
constexpr size_t WS_XB = WS_WOUT + 32 * HMiB;
constexpr size_t WS_KS = WS_XB + 260 * HMiB;
constexpr size_t WS_VS = WS_KS + 132 * HMiB;
constexpr size_t WS_R = WS_VS + 132 * HMiB;
constexpr size_t WS_H = WS_R;
constexpr size_t WS_U = WS_R, WS_Q = WS_U + 65 * HMiB, WS_KB = WS_Q + 130 * HMiB, WS_VB = WS_KB + 128 * HMiB, WS_RQ = WS_VB + 128 * HMiB, WS_RK = WS_RQ + 65 * HMiB,
                 WS_RV = WS_RK + 65 * HMiB, WS_RG = WS_RV + 65 * HMiB, WS_KVT = WS_RG + 65 * HMiB, WS_SP = WS_KVT + 68 * HMiB, WS_ASCR = WS_SP + 34 * HMiB, WS_END = WS_ASCR + 64 * HMiB;
constexpr size_t WS_SLAB = WS_R + 740 * HMiB;
static_assert(WS_SLAB >= WS_H + (size_t)M * HP * 2 && WS_SLAB + (size_t)11 * 512 * 2048 * 4 <= WS_END && WS_WD + (size_t)4 * DM * HP * 2 <= WS_WIN, "slab / down-copy placement");
static_assert(WS_H + (size_t)M * HP * 2 <= WS_END, "H fits the shared region");
constexpr int CW_TMO = 0, CW_CODE = 1, CW_BAR = 4096, CW_Q = 8192;
constexpr int RING_OFF = 0, RING_BYTES = 131072, LDSCTL_OFF = RING_BYTES, MISC_OFF = LDSCTL_OFF + 320, LDS_BYTES = 147456;

#define GAS __attribute__((address_space(1)))
#define LAS __attribute__((address_space(3)))
typedef unsigned short bf16;
typedef unsigned v4u __attribute__((ext_vector_type(4)));
typedef unsigned v2u __attribute__((ext_vector_type(2)));
typedef float f32x4 __attribute__((ext_vector_type(4)));
typedef GAS unsigned gu32;
#define RLX_AGENT __ATOMIC_RELAXED, __HIP_MEMORY_SCOPE_AGENT
#define LDS_WAIT() asm volatile("s_waitcnt lgkmcnt(0)" ::: "memory")
#define VM_WAIT() asm volatile("s_waitcnt vmcnt(0)" ::: "memory")
__device__ __forceinline__ unsigned pk2(float lo, float hi) { return pg8::cvt_pk_bf16(lo, hi); }
static_assert(WS_VB - WS_KB == pg8::EpiIn::D_KV * 2 && WS_VS - WS_KS == pg8::EpiIn::D_S * 2 && WS_RK - WS_RQ == pg8::EpiIn::D_R * 2 && WS_RG - WS_RV == pg8::EpiIn::D_R * 2, "EpiIn's pointer deltas match the workspace map");
#define XB_TMO      128
#define XB_XCNT(j)  (256  + 64 * (j))
#define XB_XSUB(j)  (1280 + 64 * (j))
#define XB_XGEN(j)  (2304 + 64 * (j))
#define XB_TOP      3328
#define XB_TOPGEN   3392
#define XCD_BAR_WORDS 3456
#define XB_SPIN_CAP (1u << 22)

__device__ __forceinline__ unsigned xb_ld(unsigned* p)              { return __hip_atomic_load(p, __ATOMIC_RELAXED, __HIP_MEMORY_SCOPE_AGENT); }
__device__ __forceinline__ unsigned xb_add(unsigned* p, unsigned v) { return __hip_atomic_fetch_add(p, v, __ATOMIC_RELAXED, __HIP_MEMORY_SCOPE_AGENT); }
__device__ __forceinline__ unsigned xb_xcc_id() { return (unsigned)__builtin_amdgcn_s_getreg((3 << 11) | 20) & 0xFu; }
#define XB_SPIN(cond, bar) do { unsigned _sp = 0; while (cond) { __builtin_amdgcn_s_sleep(1); \
    if ((++_sp & 255u) == 0u) { if (xb_ld(&(bar)[XB_TMO])) break; if (_sp > XB_SPIN_CAP) { atomicAdd(&(bar)[XB_TMO], 1u); break; } } } } while (0)

struct XcdBarrier {
    unsigned* bar; unsigned x;
    volatile LAS unsigned* st;
};

__device__ __forceinline__ XcdBarrier xcd_barrier_post(unsigned* bar, volatile LAS unsigned* st) {
    XcdBarrier b; b.bar = bar; b.x = xb_xcc_id(); b.st = st;
    if (threadIdx.x == 0) (void)xb_add(&bar[XB_XCNT(b.x)], 1u);
    return b;
}
__device__ __forceinline__ void xcd_barrier_complete(unsigned* bar, unsigned x, unsigned& nloc, unsigned& nx) {
    const unsigned G = gridDim.x * gridDim.y * gridDim.z;
    unsigned sum, cnt, mine, sp = 0u;
    for (;;) {
        sum = 0u; cnt = 0u; mine = 0u;
#pragma unroll
        for (unsigned j = 0; j < 16; ++j) { const unsigned c = xb_ld(&bar[XB_XCNT(j)]); sum += c; cnt += (c > 0u) ? 1u : 0u; mine = (j == x) ? c : mine; }
        if (sum == G) break;
        __builtin_amdgcn_s_sleep(1);
        if ((++sp & 255u) == 0u) { if (xb_ld(&bar[XB_TMO])) break; if (sp > XB_SPIN_CAP) { atomicAdd(&bar[XB_TMO], 1u); break; } }
    }
    nloc = mine > 0u ? mine : 1u; nx = cnt > 0u ? cnt : 1u;
}

__device__ __forceinline__ void xcd_barrier(const XcdBarrier& b, int tid_x  ) {
    asm volatile("s_waitcnt vmcnt(0)" ::: "memory");
    __syncthreads();
    if (tid_x == 0) {
        unsigned* bar = b.bar;
        unsigned bx_ = b.x; asm volatile("" : "+s"(bx_));
#define BX_ bx_
        __builtin_amdgcn_s_waitcnt(0);
        unsigned nloc = b.st[0], nx = b.st[1];
        if (nloc == 0u) { xcd_barrier_complete(bar, BX_, nloc, nx); b.st[0] = nloc; b.st[1] = nx; }
        const unsigned old = xb_add(&bar[XB_XSUB(BX_)], 1u);
        const unsigned gen = old / nloc;
        if (old + 1u == (gen + 1u) * nloc) {
            __builtin_amdgcn_fence(__ATOMIC_RELEASE, "agent");
            asm volatile("s_waitcnt vmcnt(0)" ::: "memory");
            const unsigned og = xb_add(&bar[XB_TOP], 1u);
            const unsigned tg = og / nx;
            if (og + 1u == (tg + 1u) * nx) xb_add(&bar[XB_TOPGEN], 1u);
            else XB_SPIN(xb_ld(&bar[XB_TOPGEN]) == tg, bar);
            __builtin_amdgcn_fence(__ATOMIC_ACQUIRE, "agent");
            xb_add(&bar[XB_XGEN(BX_)], 1u);
            asm volatile("s_waitcnt vmcnt(0)" ::: "memory");
        } else {
            XB_SPIN(xb_ld(&bar[XB_XGEN(BX_)]) == gen, bar);
            __builtin_amdgcn_fence(__ATOMIC_ACQUIRE, "agent");
            asm volatile("s_waitcnt vmcnt(0)" ::: "memory");
        }
    }
    __syncthreads();
}
__device__ __forceinline__ float wave_sum(float v, int lane) {
#pragma unroll
    for (int o = 1; o < 64; o <<= 1) v += __builtin_bit_cast(float, __builtin_amdgcn_ds_bpermute((lane ^ o) << 2, __builtin_bit_cast(int, v)));
    return v;
}
__device__ __forceinline__ int map_row(int code, int n) {
    if (code == 0) return n;
    if (code == 1) return ((n >> 7) << 8) + (n & 127);
    if (code == 2) return ((n >> 7) << 8) + 128 + (n & 127);
    if (n < 512) return ((n >> 7) << 8) + (n & 127);
    if (n < 1024) { const int m = n - 512; return ((m >> 7) << 8) + 128 + (m & 127); }
    if (n >= 4096 && n < 5120) { const int d = n & 127; return (n & ~127) + (d < 64 ? 2 * d : 2 * (d - 64) + 1); }
    return n;
}
__device__ __forceinline__ void p0_transpose_item(const float* W, int K, int N, bf16* WT, int code, LAS float* scr, int item, int lane, int ldw = 0) {
    if (ldw == 0) ldw = K;
    const int nblk = N / 32, kb = item / nblk, nb = item % nblk, k0 = 64 * kb, n0 = 32 * nb;
#pragma unroll 8
    for (int i = 0; i < 32; ++i) { const int kk = 2 * i + (lane >> 5); scr[kk * 33 + (lane & 31)] = W[(size_t)(k0 + kk) * N + n0 + (lane & 31)]; }
    LDS_WAIT(); asm volatile("" ::: "memory");
    const int c = lane & 7;
#pragma unroll
    for (int j = 0; j < 4; ++j) { const int n = (lane >> 3) + 8 * j; const LAS float* s = scr + (8 * c) * 33 + n;
        v4u o; o.x = pk2(s[0 * 33], s[1 * 33]); o.y = pk2(s[2 * 33], s[3 * 33]); o.z = pk2(s[4 * 33], s[5 * 33]); o.w = pk2(s[6 * 33], s[7 * 33]);
        *(GAS v4u*)(WT + (size_t)map_row(code, n0 + n) * ldw + k0 + 8 * c) = o; }
    LDS_WAIT(); asm volatile("" ::: "memory");
}
__device__ __forceinline__ void ln_pass(bf16* XBp, float* fout_base, const float* g, const float* b, int lane, int gw, int NGW, const float* slab, int nsplit, float alpha, float scale) {
    f32x4 gg[8], bb[8];
#pragma unroll
    for (int j = 0; j < 4; ++j) { const int c0 = lane * 8 + 512 * j; gg[2 * j] = *(const GAS f32x4*)(g + c0); gg[2 * j + 1] = *(const GAS f32x4*)(g + c0 + 4); bb[2 * j] = *(const GAS f32x4*)(b + c0); bb[2 * j + 1] = *(const GAS f32x4*)(b + c0 + 4); }
    v4u cur[4];
    if (gw < M) {
#pragma unroll
        for (int j = 0; j < 4; ++j) cur[j] = ((const GAS v4u*)(XBp + (size_t)gw * DM) + lane)[64 * j];
    }
    for (int m = gw; m < M; m += NGW) {
        v4u nx[4]; const int mn = m + NGW;
        if (mn < M) {
#pragma unroll
            for (int j = 0; j < 4; ++j) nx[j] = ((const GAS v4u*)(XBp + (size_t)mn * DM) + lane)[64 * j];
        }
        float v[32]; float s = 0.f;
#pragma unroll
        for (int j = 0; j < 4; ++j)
#pragma unroll
            for (int q = 0; q < 4; ++q) { v[j * 8 + 2 * q] = __uint_as_float(cur[j][q] << 16); v[j * 8 + 2 * q + 1] = __uint_as_float(cur[j][q] & 0xffff0000u); }
        if (m >= MP) { const float* part = slab + (size_t)(m - MP) * DM;
            f32x4 a[8];
#pragma unroll
            for (int q = 0; q < 8; ++q) a[q] = (f32x4){0.f, 0.f, 0.f, 0.f};
            for (int ks = 0; ks < nsplit; ++ks) { const float* pp = part + (size_t)ks * 512 * 2048 + lane * 8; f32x4 t8[8];
#pragma unroll
                for (int j = 0; j < 4; ++j) { t8[2 * j] = *(const GAS f32x4*)(pp + 512 * j); t8[2 * j + 1] = *(const GAS f32x4*)(pp + 512 * j + 4); }
                __builtin_amdgcn_sched_barrier(0);
#pragma unroll
                for (int q = 0; q < 8; ++q) a[q] += t8[q]; }
#pragma unroll
            for (int j = 0; j < 4; ++j)
#pragma unroll
                for (int q = 0; q < 4; ++q) { v[j * 8 + q] = v[j * 8 + q] * alpha + a[2 * j][q] * scale; v[j * 8 + 4 + q] = v[j * 8 + 4 + q] * alpha + a[2 * j + 1][q] * scale; }
        }
#pragma unroll
        for (int i = 0; i < 32; ++i) s += v[i];
        const float mean = wave_sum(s, lane) * (1.f / DM); float s2 = 0.f;
#pragma unroll
        for (int i = 0; i < 32; ++i) { v[i] -= mean; s2 += v[i] * v[i]; }
        const float rstd = 1.f / sqrtf(wave_sum(s2, lane) * (1.f / DM) + LN_EPS);
        GAS v4u* xr = (GAS v4u*)(XBp + (size_t)m * DM) + lane;
#pragma unroll
        for (int j = 0; j < 4; ++j) { const int c0 = lane * 8 + 512 * j; f32x4 o0, o1;
#pragma unroll
            for (int q = 0; q < 4; ++q) { o0[q] = v[j * 8 + q] * rstd * gg[2 * j][q] + bb[2 * j][q]; o1[q] = v[j * 8 + 4 + q] * rstd * gg[2 * j + 1][q] + bb[2 * j + 1][q]; }
            if (fout_base) { float* fo = fout_base + (size_t)m * DM + c0; __builtin_nontemporal_store(o0, (GAS f32x4*)fo); __builtin_nontemporal_store(o1, (GAS f32x4*)(fo + 4)); }
            else { v4u w; w.x = pk2(o0[0], o0[1]); w.y = pk2(o0[2], o0[3]); w.z = pk2(o1[0], o1[1]); w.w = pk2(o1[2], o1[3]); xr[64 * j] = w; } }
#pragma unroll
        for (int j = 0; j < 4; ++j) cur[j] = nx[j];
    }
}
__device__ __forceinline__ void conv_item(LAS unsigned char* lds, int tid, int item, int l, const bf16* U, const float* cache_conv, const float* cw, const float* cbias, const float* cg, const float* cbeta, bf16* MIX) {
    asm volatile("" : "+v"(tid));
    const int lane = tid & 63, wid = tid >> 6;
    int b, t0, urow0; const float* hist = nullptr;
    if (item < 1024) { b = item >> 9; t0 = (item & 511) * 32; urow0 = b * 16384; }
    else { const int i2 = item - 1024; b = i2 >> 1; t0 = (i2 & 1) * 32; urow0 = 32768 + b * 64; hist = cache_conv + (size_t)((l * 8 + b) * 30) * 512; }
    { v4u st[8];
#pragma unroll
      for (int q = 0; q < 8; ++q) { const int idx = tid + 512 * q, lr = idx >> 6, ch = idx & 63, t = t0 - 30 + lr; v4u v = (v4u){0u, 0u, 0u, 0u};
        if (idx < 62 * 64) {
          if (t >= 0) v = *(const GAS v4u*)(U + (size_t)(urow0 + t) * 512 + ch * 8);
          else if (hist) { const float* hp = hist + (size_t)(30 + t) * 512 + ch * 8; const f32x4 a = *(const GAS f32x4*)hp, c = *(const GAS f32x4*)(hp + 4);
            v.x = pk2(a.x, a.y); v.y = pk2(a.z, a.w); v.z = pk2(c.x, c.y); v.w = pk2(c.z, c.w); } }
        st[q] = v; }
      __builtin_amdgcn_sched_barrier(0);
#pragma unroll
      for (int q = 0; q < 8; ++q) { const int idx = tid + 512 * q, lr = idx >> 6, ch = idx & 63; if (idx < 62 * 64) *(LAS v4u*)(lds + (size_t)(lr * 512 + ch * 8) * 2) = st[q]; } }
    __syncthreads();
    const int c = tid;
    float w[31];
    { const float* wp = cw + (size_t)l * 31 * 512 + c;
#pragma unroll
      for (int j = 0; j < 31; ++j) { int z_ = 0; asm volatile("" : "+v"(z_)); w[j] = wp[j * 512 + z_]; } }
    float y[32]; const float bias = cbias[l * 512 + c];
#pragma unroll
    for (int i = 0; i < 32; ++i) y[i] = bias;
    const LAS unsigned short* tile = (const LAS unsigned short*)lds;
#pragma unroll
    for (int k = 0; k < 62; ++k) { const float v = __uint_as_float((unsigned)tile[k * 512 + c] << 16);
#pragma unroll
        for (int i = 0; i < 32; ++i) if (k - i >= 0 && k - i <= 30) y[i] += w[k - i] * v; }
    LAS float* yb = (LAS float*)(lds + 65536);
#pragma unroll
    for (int i = 0; i < 32; ++i) yb[i * 512 + c] = y[i];
    __syncthreads();
    float cgv[8], cbv[8];
#pragma unroll
    for (int k8 = 0; k8 < 8; ++k8) { cgv[k8] = cg[l * 512 + lane + 64 * k8]; cbv[k8] = cbeta[l * 512 + lane + 64 * k8]; }
#pragma unroll
    for (int rr = 0; rr < 4; ++rr) { const int i = wid * 4 + rr; float v[8]; float s = 0.f;
#pragma unroll
        for (int k = 0; k < 8; ++k) { v[k] = yb[i * 512 + lane + 64 * k]; s += v[k]; }
        const float mean = wave_sum(s, lane) * (1.f / 512.f); float q = 0.f;
#pragma unroll
        for (int k = 0; k < 8; ++k) { v[k] -= mean; q += v[k] * v[k]; }
        const float rstd = 1.f / sqrtf(wave_sum(q, lane) * (1.f / 512.f) + LN_EPS);
        int z_ = 0; asm volatile("" : "+v"(z_)); bf16* mr = MIX + (size_t)(urow0 + t0 + i) * 2048 + lane + z_;
#pragma unroll
        for (int k = 0; k < 8; ++k) { float z = v[k] * rstd * cgv[k] + cbv[k]; z = z * pg8::sigm(z);
            mr[64 * k] = (bf16)(pk2(z, 0.f) & 0xffffu); } }
    __syncthreads();
}

#define DERIVE_PTRS(WSV, OUTV) \
    unsigned char* ws = (WSV); float* out = (OUTV); \
    gu32* ctl = (gu32*)(ws + WS_CTL); \
    float* TAB = (float*)(ws + WS_TAB); float* CS = (float*)(ws + WS_CS); \
    bf16* WGU = (bf16*)(ws + WS_WGU); bf16* WD = (bf16*)(ws + WS_WD); bf16* WIN = (bf16*)(ws + WS_WIN); bf16* WOUT = (bf16*)(ws + WS_WOUT); \
    bf16* XB = (bf16*)(ws + WS_XB); bf16* KS = (bf16*)(ws + WS_KS); bf16* VS = (bf16*)(ws + WS_VS); bf16* HB = (bf16*)(ws + WS_H); \
    bf16* U = (bf16*)(ws + WS_U); bf16* Q = (bf16*)(ws + WS_Q); bf16* KB = (bf16*)(ws + WS_KB); bf16* VB = (bf16*)(ws + WS_VB); \
    bf16* RQ = (bf16*)(ws + WS_RQ); bf16* RK = (bf16*)(ws + WS_RK); bf16* RV = (bf16*)(ws + WS_RV); bf16* RG = (bf16*)(ws + WS_RG); \
    float* KVT = (float*)(ws + WS_KVT); bf16* SP = (bf16*)(ws + WS_SP); float* ASCR = (float*)(ws + WS_ASCR); \
    bf16* MIXB = (bf16*)out; float* SLAB = (float*)(ws + WS_SLAB);
__device__ __forceinline__ int fresh_tid(int wave_s) { int l_; asm volatile("v_mbcnt_lo_u32_b32 %0, -1, 0\n\tv_mbcnt_hi_u32_b32 %0, -1, %0" : "=v"(l_)); return (wave_s << 6) | l_; }
#define PH_IDS const int tid = fresh_tid(wave_s); const int lane = tid & 63; const int wave = __builtin_amdgcn_readfirstlane(tid >> 6); const int gw = vcu * NWAVES + wave; (void)lane; (void)gw;
#ifndef STOP_IT
#define STOP_IT -1
#define STOP_PH -1
#endif
#define STOP_AT(ph) do { if (STOP_IT == it && STOP_PH == (ph)) return; } while (0)
#ifndef H_TILED
#define H_TILED 1
#endif
#ifndef GU_WGM
#define GU_WGM 4
#endif
struct Args { const float* in[20]; float* out; unsigned char* ws; };
__global__ void __launch_bounds__(NWAVES * 64, 2) mk_fwd(Args args) {
    extern __shared__ __attribute__((aligned(16))) unsigned char lds_raw[];
    LAS unsigned char* lds = (LAS unsigned char*)lds_raw;
    volatile LAS unsigned* MISC = (volatile LAS unsigned*)(lds + MISC_OFF);
    const int wave_s = __builtin_amdgcn_readfirstlane((int)threadIdx.x >> 6);
    const int G = gridDim.x; const int vcu = (G % 8 == 0) ? ((int)blockIdx.x % 8) * (G / 8) + (int)blockIdx.x / 8 : (int)blockIdx.x;
    DERIVE_PTRS(args.ws, args.out)
    for (int u = fresh_tid(wave_s); u < (LDS_BYTES - LDSCTL_OFF) / 4; u += NWAVES * 64) ((LAS unsigned*)(lds + LDSCTL_OFF))[u] = 0u;
    __syncthreads();
    XcdBarrier bar = xcd_barrier_post((unsigned*)(ctl + CW_BAR), MISC + 8);
    const int NGW = G * NWAVES;
    const unsigned lds0 = (unsigned)(size_t)lds;

#ifndef REP_P0
#define REP_P0 1
#endif
    for (int rep_ = 0; rep_ < REP_P0; ++rep_) { PH_IDS
        LAS float* scr = (LAS float*)(lds + RING_OFF + wave * 16384);
        constexpr int I_F = 5632, I_IN = 6144, I_OUT = 2048, NITEMS = 12 * I_F + 2 * I_IN + 2 * I_OUT;
        for (int it = gw; it < NITEMS; it += NGW) {
            int r = it;
            if (r < 12 * I_F) { const int mtx = r / I_F, k3 = mtx % 3, li = mtx / 3; r -= mtx * I_F;
                if (k3 == 0) p0_transpose_item(args.in[8] + (size_t)li * DM * DFF, DM, DFF, WGU + (size_t)li * 2 * DFF * DM, 1, scr, r, lane);
                else if (k3 == 1) p0_transpose_item(args.in[9] + (size_t)li * DM * DFF, DM, DFF, WGU + (size_t)li * 2 * DFF * DM, 2, scr, r, lane);
                else p0_transpose_item(args.in[10] + (size_t)li * DFF * DM, DFF, DM, WD + (size_t)li * DM * HP, 0, scr, r, lane, HP);
                continue; }
            r -= 12 * I_F;
            if (r < 2 * I_IN) { const int li = r / I_IN; r -= li * I_IN; p0_transpose_item(args.in[11] + (size_t)li * DM * DIN, DM, DIN, WIN + (size_t)li * DIN * DM, 3, scr, r, lane); continue; }
            r -= 2 * I_IN;
            { const int li = r / I_OUT; r -= li * I_OUT; p0_transpose_item(args.in[12] + (size_t)li * DM * DM, DM, DM, WOUT + (size_t)li * DM * DM, 0, scr, r, lane); }
        }
        for (int m = gw; m < M; m += NGW) {
            const float* src = m < MP ? args.in[0] + (size_t)m * DM : args.in[1] + (size_t)(m - MP) * DM;
            const GAS f32x4* xr = (const GAS f32x4*)src + lane; GAS v2u* o8 = (GAS v2u*)(XB + (size_t)m * DM) + lane;
            f32x4 v8[8];
#pragma unroll
            for (int j = 0; j < 8; ++j) v8[j] = xr[64 * j];
            __builtin_amdgcn_sched_barrier(0);
#pragma unroll
            for (int j = 0; j < 8; ++j) { v2u w; w.x = pk2(v8[j].x, v8[j].y); w.y = pk2(v8[j].z, v8[j].w); o8[64 * j] = w; }
        }
        for (int r = gw; r < 65536; r += NGW) {
            const int which = r >> 15, rr = r & 32767, lb = rr >> 11, t = rr & 2047;
            const GAS f32x4* xr = (const GAS f32x4*)(args.in[3 + which] + (size_t)rr * 1024) + lane;
            GAS v2u* o8 = (GAS v2u*)((which ? VS : KS) + ((size_t)lb * 2112 + t) * 1024) + lane;
            f32x4 v4[4];
#pragma unroll
            for (int j = 0; j < 4; ++j) v4[j] = xr[64 * j];
            __builtin_amdgcn_sched_barrier(0);
#pragma unroll
            for (int j = 0; j < 4; ++j) { v2u w; w.x = pk2(v4[j].x, v4[j].y); w.y = pk2(v4[j].z, v4[j].w); o8[64 * j] = w; }
        }
        for (int i = vcu * 512 + tid; i < 16384 * 64; i += G * 512) {
            const int pos = i >> 6, k = i & 63;
            const float p = (float)exp2((double)k * (13.287712379549449 / 64.0)); const float inv = 1.0f / p; const float ang = (float)pos * inv;
            const double a = (double)ang; const double n = rint(a * 0.15915494309189535); const float red = (float)(a - n * 6.283185307179586);
            CS[2 * (size_t)i] = cosf(red); CS[2 * (size_t)i + 1] = sinf(red);
        }
        if (blockIdx.x == 0) {
            const float* rb = args.in[19];
            for (int i = tid; i < 8 * 320; i += 512) { const int h = i / 320, rel = (i % 320) - 255, n = rel < 0 ? -rel : rel;
                int bk = n < 8 ? n : 8 + (n >= 12) + (n >= 16) + (n >= 23) + (n >= 32) + (n >= 46) + (n >= 64) + (n >= 91);
                bk += rel > 0 ? 16 : 0;
                TAB[i] = (rb[bk * 8 + h] - rb[15 * 8 + h]) * 1.4426950408889634f; }
            if (tid < 2) { const float* lf = args.in[17] + tid * 256; float a = 0.f, c = 0.f;
                for (int i = 0; i < 64; ++i) { a += lf[i] * lf[64 + i]; c += lf[128 + i] * lf[192 + i]; }
                TAB[2560 + tid] = expf(a) - expf(c) + (tid == 0 ? 0.2f : 0.35550906759096934f); TAB[2562 + tid] = tid == 0 ? 0.8f : 0.64449093240903066f; }
        }
    }
    xcd_barrier(bar, fresh_tid(wave_s));

    for (int it = 0; it < 4; ++it) {
        const int l = it >> 1, j = it & 1;
        size_t zoff; asm volatile("s_mov_b64 %0, 0" : "=s"(zoff));
        unsigned char* ws_l = args.ws + zoff; float* out_l = args.out + zoff;
        DERIVE_PTRS(ws_l, out_l)
#ifndef REP_GU
#define REP_GU 1
#endif
        for (int rep_ = 0; rep_ < REP_GU; ++rep_)
        { const pg8::Gemm g = pg8::gemm_rowmajor(XB, WGU + (size_t)it * 2 * DFF * DM, M, 2 * DFF, DM, DM); pg8::StaticOrder S; S.init(M, 2 * DFF, G, (int)blockIdx.x, DM); S.wgm = GU_WGM;
          pg8::EpiGU E{HB, HP, H_TILED};
          pg8::gemm_phase<pg8::EpiGU, pg8::StaticOrder, true, true>(lds + RING_OFF, g, S, E, fresh_tid(wave_s)); }
        STOP_AT(2);
        xcd_barrier(bar, fresh_tid(wave_s));
#ifndef REP_DOWN
#define REP_DOWN 1
#endif
        for (int rep_ = 0; rep_ < REP_DOWN; ++rep_)
        { const pg8::Gemm g = H_TILED ? pg8::gemm_atiled(HB, WD + (size_t)it * DM * HP, M, DM, DFF, HP) : pg8::gemm_rowmajor(HB, WD + (size_t)it * DM * HP, M, DM, DFF, HP); pg8::TailSplitOrder S; S.init(MP, M, DM, G, (int)blockIdx.x, DFF, 11); S.rev = true;
          pg8::EpiResB E{XB, rep_ + 1 < REP_DOWN ? 1.0f : ALPHA, rep_ + 1 < REP_DOWN ? 0.0f : 0.5f, SLAB};
          pg8::gemm_phase<pg8::EpiResB, pg8::TailSplitOrder, true, true>(lds + RING_OFF, g, S, E, fresh_tid(wave_s)); }
        STOP_AT(3);
        xcd_barrier(bar, fresh_tid(wave_s));
        { PH_IDS const float* gp = args.in[6] + (size_t)(l * 3 + 2 * j) * DM; const float* bp = args.in[7] + (size_t)(l * 3 + 2 * j) * DM;
          ln_pass(XB, it == 3 ? out : (float*)nullptr, gp, bp, lane, gw, NGW, SLAB, 11, ALPHA, 0.5f); }
        if (it == 3) break;
        STOP_AT(4);
        xcd_barrier(bar, fresh_tid(wave_s));
        if (j == 0) {
#ifndef REP_IN
#define REP_IN 1
#endif
            for (int rep_ = 0; rep_ < REP_IN; ++rep_)
            { const pg8::Gemm g = pg8::gemm_rowmajor(XB, WIN + (size_t)l * DIN * DM, M, DIN, DM, DM); pg8::StaticOrder S; S.init(M, DIN, G, (int)blockIdx.x, DM);
              pg8::EpiIn E{l, out, U, Q, KB, KS, RQ, RV, CS};
              pg8::gemm_phase<pg8::EpiIn, pg8::StaticOrder, true, true>(lds + RING_OFF, g, S, E, fresh_tid(wave_s)); }
            STOP_AT(5);
            xcd_barrier(bar, fresh_tid(wave_s));
#ifndef REP_M1
#define REP_M1 1
#endif
            for (int rep_ = 0; rep_ < REP_M1; ++rep_) { PH_IDS
                const float* subg = args.in[18] + l * 128;
                float* scr = ASCR + (size_t)blockIdx.x * 32768;
#ifndef SKIP_ATTN
#define SKIP_ATTN 0
#endif
#ifndef SKIP_CONV
#define SKIP_CONV 0
#endif
#ifndef SKIP_RET
#define SKIP_RET 0
#endif
                if (!SKIP_ATTN) for (int p = vcu; p < 512; p += G) { const int bh = p >> 5, s = p & 31, b = bh >> 3, h = bh & 7;
                    for (int k = 0; k < 2; ++k) { const int qb = k == 0 ? 63 - s : s;
                        mx::attn_unit((mx::lds_ptr)lds, lds0, fresh_tid(wave_s), Q, KB + (size_t)b * 16384 * 1024, VB + (size_t)b * 16384 * 1024, b * 16384 + 256 * qb, 256 * qb, 4 * qb + 4, 8, h, TAB, l, subg, scr, MIXB); } }
                for (;;) {
                    __syncthreads(); if (tid == 0) MISC[0] = __hip_atomic_fetch_add(ctl + CW_Q + 64 * l, 1u, RLX_AGENT); __syncthreads();
                    const int item = (int)MISC[0];
                    if (item >= 64 + 544 + 1040) break;
                    if (item < 64) { const int b = item >> 3, h = item & 7; const size_t so = (size_t)((l * 8 + b) * 2112) * 1024;
                        mx::attn_unit((mx::lds_ptr)lds, lds0, fresh_tid(wave_s), Q, KS + so, VS + so, MP + 64 * b, 2048, 33, 2, h, TAB, l, subg, scr, MIXB); }
                    else if (item < 608) { const int u = item - 64; int row0, h, nt;
                        if (u < 512) { row0 = (u >> 8) * 16384 + ((u >> 2) & 63) * 256; h = u & 3; nt = 4; } else { const int s = u - 512; row0 = MP + (s >> 2) * 64; h = s & 3; nt = 1; }
                        mx::ret_kv_unit((mx::lds_ptr)lds, lds0, fresh_tid(wave_s), RK + (size_t)row0 * 512 + h * 128, RV + (size_t)row0 * 512 + h * 128, nt, KVT + (size_t)u * 16384); }
                    else if (!SKIP_CONV) conv_item(lds, fresh_tid(wave_s), item - 608, l, U, args.in[2], args.in[13], args.in[14], args.in[15], args.in[16], MIXB);
                }
            }
            STOP_AT(6);
            xcd_barrier(bar, fresh_tid(wave_s));
#ifndef REP_M23
#define REP_M23 1
#endif
            for (int rep23_ = 0; rep23_ < REP_M23; ++rep23_) {
            { PH_IDS
            for (int i = vcu; i < 256 + 1024; i += G) {
                const bool pr = i < 256; const int jj = pr ? i : i - 256, chain = jj >> 5, slab = jj & 31, idx = slab * 512 + tid, b = chain >> 2, h = chain & 3;
                const int e = idx >> 7, d = idx & 127, dnat = (d >> 1) + 64 * (d & 1);
                const float lg = h == 0 ? -0.04580368961312479f : h == 1 ? -0.02272007650008353f : h == 2 ? -0.011315313227834146f : -0.005646563141142063f;
                if (pr) { const float gL = __builtin_amdgcn_exp2f(256.f * lg); float S = 0.f;
                    for (int n0 = 0; n0 < 64; n0 += 8) { float kv8[8];
#pragma unroll
                        for (int j = 0; j < 8; ++j) kv8[j] = KVT[(size_t)((b * 64 + n0 + j) * 4 + h) * 16384 + idx];
                        __builtin_amdgcn_sched_barrier(0);
#pragma unroll
                        for (int j = 0; j < 8; ++j) { const size_t uo = (size_t)((b * 64 + n0 + j) * 4 + h) * 16384 + idx; SP[uo] = (bf16)(pk2(S, 0.f) & 0xffffu); S = gL * (S + kv8[j]); } }
                    out[pg8::O_RETP + ((size_t)((l * 2 + b) * 4 + h) * 128 + dnat) * 128 + e] = S; }
                else { const float gL = __builtin_amdgcn_exp2f(64.f * lg); const size_t uo = (size_t)(512 + b * 4 + h) * 16384 + idx; const size_t so = ((size_t)((l * 8 + b) * 4 + h) * 128 + dnat) * 128 + e;
                    const float S0 = args.in[5][so]; SP[uo] = (bf16)(pk2(S0, 0.f) & 0xffffu); out[pg8::O_RETS + so] = gL * (S0 + KVT[uo]); }
            } }
#ifdef DUMP_KVT
            xcd_barrier(bar, fresh_tid(wave_s));
            for (size_t i = (size_t)blockIdx.x * 512 + fresh_tid(wave_s); i < (size_t)544 * 16384; i += (size_t)G * 512) { out[pg8::O_KP + i] = KVT[i]; out[pg8::O_VP + i] = __uint_as_float((unsigned)SP[i] << 16); }
#endif
            STOP_AT(7);
            xcd_barrier(bar, fresh_tid(wave_s));
            { PH_IDS
            if (!SKIP_RET) for (int u = vcu; u < 544; u += G) { int row0, h, nt, na;
                if (u < 512) { row0 = (u >> 8) * 16384 + ((u >> 2) & 63) * 256; h = u & 3; nt = 4; na = 8; } else { const int s = u - 512; row0 = MP + (s >> 2) * 64; h = s & 3; nt = 1; na = 2; }
                const size_t ro = (size_t)row0 * 512 + h * 128;
                mx::ret_out_unit((mx::lds_ptr)lds, lds0, fresh_tid(wave_s), RQ + ro, RK + ro, RV + ro, RG + ro, SP + (size_t)u * 16384, nt, na, MIXB + (size_t)row0 * 2048 + 1536 + h * 128); } }
#ifdef DUMP_MIX
            xcd_barrier(bar, fresh_tid(wave_s));
            for (size_t i = (size_t)blockIdx.x * 512 + fresh_tid(wave_s); i < (size_t)M * 2048; i += (size_t)G * 512) out[pg8::O_KP + i] = __uint_as_float((unsigned)MIXB[i] << 16);
#endif
            STOP_AT(8);
            xcd_barrier(bar, fresh_tid(wave_s));
            }
            { const pg8::Gemm g = pg8::gemm_rowmajor(MIXB, WOUT + (size_t)l * DM * DM, M, DM, DM, DM); pg8::TailSplitOrder S; S.init(MP, M, DM, G, (int)blockIdx.x, DM, 4);
              pg8::EpiResB E{XB, ALPHA, 1.0f, SLAB};
              pg8::gemm_phase<pg8::EpiResB, pg8::TailSplitOrder, true, true>(lds + RING_OFF, g, S, E, fresh_tid(wave_s)); }
            STOP_AT(9);
            xcd_barrier(bar, fresh_tid(wave_s));
            { PH_IDS const float* gp = args.in[6] + (size_t)(l * 3 + 1) * DM; const float* bp = args.in[7] + (size_t)(l * 3 + 1) * DM;
              ln_pass(XB, (float*)nullptr, gp, bp, lane, gw, NGW, SLAB, 4, ALPHA, 1.0f); }
            xcd_barrier(bar, fresh_tid(wave_s));
        }
    }
}

extern "C" void kernel_launch(void* const* d_in, const int* in_sizes, int n_in, void* d_out, int out_size, void* d_ws, size_t ws_size, hipStream_t stream) {
    static int grid = 0;
    if (grid == 0) {
        if (n_in != 20 || in_sizes[0] != MP * DM || (size_t)out_size != pg8::O_END || ws_size < WS_END) {
            fprintf(stderr, "kernel_launch: unexpected problem sizes (n_in %d, in0 %d, out %d, ws %zu; need ws >= %zu); nothing launched\n", n_in, n_in > 0 ? in_sizes[0] : -1, out_size, ws_size, (size_t)WS_END); grid = -1; return; }
        int dev = 0, cus = 0;
        if (hipGetDevice(&dev) != hipSuccess || hipDeviceGetAttribute(&cus, hipDeviceAttributeMultiprocessorCount, dev) != hipSuccess) { grid = -1; return; }
        if (hipFuncSetAttribute((const void*)mk_fwd, hipFuncAttributeMaxDynamicSharedMemorySize, LDS_BYTES) != hipSuccess) { fprintf(stderr, "kernel_launch: hipFuncSetAttribute failed\n"); grid = -1; return; }
        int per_cu = 0;
        if (hipOccupancyMaxActiveBlocksPerMultiprocessor(&per_cu, (const void*)mk_fwd, NWAVES * 64, LDS_BYTES) != hipSuccess || per_cu < 1) fprintf(stderr, "kernel_launch: occupancy query reports %d\n", per_cu);
        (void)hipGetLastError();
        grid = cus;
    }
    if (grid < 0) return;
    if (hipMemsetAsync((char*)d_ws + WS_CTL, 0, CTL_ZERO_BYTES, stream) != hipSuccess) return;
    Args a{};
    for (int i = 0; i < 20; ++i) a.in[i] = (const float*)d_in[i];
    a.out = (float*)d_out; a.ws = (unsigned char*)d_ws;
    hipLaunchKernelGGL(mk_fwd, dim3(grid), dim3(NWAVES * 64), LDS_BYTES, stream, a);
}
```

```cpp
#include <hip/hip_runtime.h>
#include <cstdio>
#include <cstdint>
namespace pg8 {
#define PG8_LAS __attribute__((address_space(3)))
typedef unsigned short bf16_t;
typedef short bf16x8 __attribute__((ext_vector_type(8)));
typedef float f32x4 __attribute__((ext_vector_type(4)));
typedef unsigned u32x4 __attribute__((ext_vector_type(4)));
constexpr int BM = 256, BK = 64, HALF = 128, HTB = HALF * BK * 2  , STAGE_BYTES = 8 * HTB, NXCD = 8, WGM = 4;

__host__ __device__ __forceinline__ int lds_byte(int r, int c) { const int st = (r >> 4) * 2 + (c >> 5), rr = r & 15, cc = c & 31, ob = rr * 64 + cc * 2; return st * 1024 + (ob ^ (((ob >> 9) & 1) << 5)); }
__host__ __device__ __forceinline__ void stage_rc(int b, int& R, int& C) { const int st = b / 1024, sb = b % 1024, swz = sb ^ (((sb >> 9) & 1) << 5); R = (st >> 1) * 16 + swz / 64; C = (st & 1) * 32 + (swz % 64) / 2; }
__host__ __device__ __forceinline__ int perm32(int rho) { const int n = rho >> 4, i = rho & 15; return 8 * (i >> 2) + 4 * n + (i & 3); }

struct Unit { int pm, pn, k0, nt, ks; };
struct Gemm { const bf16_t* A; const bf16_t* Bt; int M, N, K, lda, ldb; size_t ksA, ksB, tsA, tsB; };
__host__ __device__ inline Gemm gemm_rowmajor(const bf16_t* A, const bf16_t* Bt, int M, int N, int K, int ld) { return Gemm{A, Bt, M, N, K, ld, ld, (size_t)BK * 2, (size_t)BK * 2, (size_t)BM * ld * 2, (size_t)BM * ld * 2}; }
__host__ __device__ inline Gemm gemm_atiled(const bf16_t* A, const bf16_t* Bt, int M, int N, int K, int ldb) { return Gemm{A, Bt, M, N, K, BK, ldb, (size_t)BM * BK * 2, (size_t)BK * 2, (size_t)(K / BK) * BM * BK * 2, (size_t)BM * ldb * 2}; }

struct StaticOrder {
    int nM, nN, nwg, G, c, ntf, wgm;
    __host__ __device__ void init(int M, int N, int G_, int c_, int K_) { nM = M / BM; nN = N / BM; nwg = nM * nN; G = G_; c = c_; ntf = K_ / BK; wgm = WGM; }
    __host__ __device__ bool next(int i, Unit& u) const {
        const long L = (long)i * G + c; if (L >= nwg) return false;
        int wgid = (int)L; { const int q = nwg / NXCD, r = nwg % NXCD, xcd = wgid % NXCD, off = wgid / NXCD; wgid = (xcd < r ? xcd * (q + 1) : r * (q + 1) + (xcd - r) * q) + off; }
        const int nig = wgm * nN, gid = wgid / nig, fm = gid * wgm, gsz = (nM - fm) < wgm ? (nM - fm) : wgm;
        u.pm = fm + ((wgid % nig) % gsz); u.pn = (wgid % nig) / gsz; u.k0 = 0; u.nt = ntf; u.ks = 0; return true;
    }
    __device__ __forceinline__ void a_ready(const Unit&) const {}
    __device__ __forceinline__ void done(const Unit&) const {}
};

struct TailSplitOrder {
    StaticOrder P; int nwp, nN, nsplit, ntp, ntot, G, c, mp; bool rev;
    __host__ __device__ void init(int Mp, int Mall, int N, int G_, int c_, int K_, int nsplit_) { P.init(Mp, N, G_, c_, K_); nwp = P.nwg; nN = N / BM; nsplit = nsplit_; ntp = K_ / BK / nsplit_; mp = Mp / BM;
        ntot = nwp + ((Mall - Mp) / BM) * nN * nsplit_; G = G_; c = c_; rev = false; }
    __host__ __device__ bool next(int i, Unit& u) const {
        const long L = (long)i * G + c; if (L >= ntot) return false;
        int pm, pn, k0 = 0, nt = P.ntf, ks = 0;
        if (L < nwp) {
            int wgid = (int)L; { const int q = P.nwg / NXCD, r = P.nwg % NXCD, xcd = wgid % NXCD, off = wgid / NXCD; wgid = (xcd < r ? xcd * (q + 1) : r * (q + 1) + (xcd - r) * q) + off; }
            const int nig = P.wgm * P.nN, gid = wgid / nig, fm = gid * P.wgm, gsz = (P.nM - fm) < P.wgm ? (P.nM - fm) : P.wgm;
            pm = fm + ((wgid % nig) % gsz); pn = (wgid % nig) / gsz;
            if (rev) pm = P.nM - 1 - pm;
        } else {
            const int s = (int)(L - nwp), rest = s / nsplit; ks = s % nsplit;
            pn = rest % nN; pm = mp + rest / nN; nt = ntp; k0 = ks * ntp;
        }
        u.pm = pm; u.pn = pn; u.k0 = k0; u.nt = nt; u.ks = ks; return true;
    }
    __device__ __forceinline__ void a_ready(const Unit&) const {}
    __device__ __forceinline__ void done(const Unit&) const {}
};

struct PanelOrder {
    int pm0, nN, ntot, NP, c, ntf;
    __host__ __device__ void init(int pm0_, int np, int N, int NP_, int c_, int K_) { pm0 = pm0_; nN = N / BM; ntot = np * nN; NP = NP_; c = c_; ntf = K_ / BK; }
    __host__ __device__ bool next(int i, Unit& u) const {
        const int L = i * NP + c; if (L >= ntot) return false;
        const int pm = pm0 + L / nN, pn = L % nN;
        u.pm = pm; u.pn = pn; u.k0 = 0; u.nt = ntf; u.ks = 0; return true;
    }
    __device__ __forceinline__ void a_ready(const Unit&) const {}
    __device__ __forceinline__ void done(const Unit&) const {}
};

typedef float f32x2c_t __attribute__((ext_vector_type(2))); typedef __bf16 bf16x2c_t __attribute__((ext_vector_type(2)));
__device__ __forceinline__ unsigned cvt_pk_bf16(float lo, float hi) { f32x2c_t v = {lo, hi}; bf16x2c_t b = __builtin_convertvector(v, bf16x2c_t); return __builtin_bit_cast(unsigned, b); }
typedef float f32x2 __attribute__((ext_vector_type(2)));
constexpr size_t O_Y = 0, O_CONVP = 68157440, O_KP = 68218880, O_VP = 135327744, O_RETP = 202436608, O_CONVS = 202698752, O_KS = 202944512, O_VS = 203993088, O_RETS = 205041664, O_END = 206090240;
__device__ __forceinline__ float sigm(float x) { return __builtin_amdgcn_rcpf(1.0f + __builtin_amdgcn_exp2f(-1.4426950408889634f * x)); }
__device__ __forceinline__ void st8(bf16_t* p, const float (&v)[8]) { u32x4 w; w.x = cvt_pk_bf16(v[0], v[1]); w.y = cvt_pk_bf16(v[2], v[3]); w.z = cvt_pk_bf16(v[4], v[5]); w.w = cvt_pk_bf16(v[6], v[7]); *(u32x4*)p = w; }

struct EpiGU {
    static constexpr bool PERM = true, AFTER_DRAIN = false;
    bf16_t* H; int ldh; int tiled;
    __device__ __forceinline__ void operator()(const f32x4 (&acc)[2][2][4][2], const Unit& u, int wr, int wc, int fr, int fq) const {
        const int row0 = u.pm * BM + wr * 64 + fr, col0 = u.pn * 128 + wc * 32 + 8 * fq;
#pragma unroll
        for (int ai = 0; ai < 2; ++ai)
#pragma unroll
            for (int m = 0; m < 4; ++m) {
                float h[8];
#pragma unroll
                for (int n = 0; n < 2; ++n)
#pragma unroll
                    for (int j = 0; j < 4; ++j) { const float g = acc[ai][0][m][n][j], uu = acc[ai][1][m][n][j]; h[n * 4 + j] = g * sigm(g) * uu; }
                { const int row = row0 + ai * HALF + m * 16; st8(tiled ? H + ((size_t)((row >> 8) * (5632 / 64) + (col0 >> 6)) * 256 + (row & 255)) * 64 + (col0 & 63) : H + (size_t)row * ldh + col0, h); }
            }
    }
};
struct EpiRes {
    static constexpr bool PERM = false, AFTER_DRAIN = false;
    float* X; float alpha, scale;
    __device__ __forceinline__ void operator()(const f32x4 (&acc)[2][2][4][2], const Unit& u, int wr, int wc, int fr, int fq) const {
        const int row0 = u.pm * BM + wr * 64 + fr, col0 = u.pn * BM + wc * 32 + 4 * fq;
#pragma unroll
        for (int ai = 0; ai < 2; ++ai)
#pragma unroll
            for (int m = 0; m < 4; ++m) { float* rp = X + (size_t)(row0 + ai * HALF + m * 16) * 2048 + col0;
#pragma unroll
                for (int bj = 0; bj < 2; ++bj)
#pragma unroll
                    for (int n = 0; n < 2; ++n) { f32x4* q = (f32x4*)(rp + bj * HALF + n * 16); const f32x4 v = *q; *q = v * alpha + acc[ai][bj][m][n] * scale; } }
    }
};
struct EpiResB {
    static constexpr bool PERM = true, AFTER_DRAIN = false;
    bf16_t* XBp; float alpha, scale; float* slab;
    __device__ __forceinline__ void operator()(const f32x4 (&acc)[2][2][4][2], const Unit& u, int wr, int wc, int fr, int fq) const {
        const int row0 = u.pm * BM + wr * 64 + fr, col0 = u.pn * BM + wc * 32 + 8 * fq;
        if (u.pm >= 128) {
#pragma unroll
            for (int ai = 0; ai < 2; ++ai)
#pragma unroll
                for (int m = 0; m < 4; ++m) { float* rp = slab + ((size_t)u.ks * 512 + (row0 - 32768 + ai * HALF + m * 16)) * 2048 + col0;
#pragma unroll
                    for (int bj = 0; bj < 2; ++bj) { *(f32x4*)(rp + bj * HALF) = acc[ai][bj][m][0]; *(f32x4*)(rp + bj * HALF + 4) = acc[ai][bj][m][1]; } }
            return;
        }
        u32x4 res[2][4][2];
#pragma unroll
        for (int ai = 0; ai < 2; ++ai)
#pragma unroll
            for (int m = 0; m < 4; ++m)
#pragma unroll
                for (int bj = 0; bj < 2; ++bj) res[ai][m][bj] = *(const u32x4*)(XBp + (size_t)(row0 + ai * HALF + m * 16) * 2048 + col0 + bj * HALF);
        __builtin_amdgcn_sched_barrier(0);
#pragma unroll
        for (int ai = 0; ai < 2; ++ai)
#pragma unroll
            for (int m = 0; m < 4; ++m) { bf16_t* rp = XBp + (size_t)(row0 + ai * HALF + m * 16) * 2048 + col0;
#pragma unroll
                for (int bj = 0; bj < 2; ++bj) { const u32x4 w = res[ai][m][bj]; float y[8];
#pragma unroll
                    for (int n = 0; n < 2; ++n)
#pragma unroll
                        for (int j = 0; j < 4; ++j) { const unsigned ww = w[n * 2 + (j >> 1)]; const float x = __uint_as_float((j & 1) ? (ww & 0xffff0000u) : (ww << 16)); y[n * 4 + j] = x * alpha + acc[ai][bj][m][n][j] * scale; }
                    st8(rp + bj * HALF, y); } }
    }
};
struct EpiIn {
    static constexpr bool PERM = true, AFTER_DRAIN = false;
    int layer; float* out; bf16_t *U, *Q, *KB, *KS, *RQ, *RV; const float* cs;
    static constexpr size_t D_KV = 64u * 1024u * 1024u / 2u * 2u / 2u, D_S = 66u * 1024u * 1024u / 2u, D_R = 34078720u / 2u;
    __device__ __forceinline__ void operator()(const f32x4 (&acc)[2][2][4][2], const Unit& u, int wr, int wc, int fr, int fq) const {
        const int pn = u.pn, pm = u.pm; const bool smp = pm >= 128; const int cb = wc * 32 + 8 * fq;
        const int rbase = pm * BM + wr * 64 + fr;
#define ROWVARS const int row = rbase + ai * HALF + m * 16; int b, t; if (!smp) { b = row >> 14; t = row & 16383; } else { const int r2 = row - 32768; b = r2 >> 6; t = r2 & 63; }
        if (pn < 4) {
#pragma unroll
            for (int ai = 0; ai < 2; ++ai)
#pragma unroll
                for (int m = 0; m < 4; ++m) { ROWVARS
                    float v[8];
#pragma unroll
                    for (int n = 0; n < 2; ++n)
#pragma unroll
                        for (int j = 0; j < 4; ++j) v[n * 4 + j] = acc[ai][0][m][n][j] * sigm(acc[ai][1][m][n][j]);
                    st8(U + (size_t)row * 512 + pn * 128 + cb, v);
                    int jr; float* cp;
                    if (!smp) { jr = t - (16384 - 30); cp = out + O_CONVP + (size_t)((layer * 2 + b) * 30 + jr) * 512; }
                    else { jr = t - 34; cp = out + O_CONVS + (size_t)((layer * 8 + b) * 30 + jr) * 512; }
                    if (jr >= 0) { cp += pn * 128 + cb; *(f32x4*)cp = (f32x4){v[0], v[1], v[2], v[3]}; *(f32x4*)(cp + 4) = (f32x4){v[4], v[5], v[6], v[7]}; }
                }
        } else if (pn < 8) {
#pragma unroll
            for (int ai = 0; ai < 2; ++ai)
#pragma unroll
                for (int m = 0; m < 4; ++m) { const int row = rbase + ai * HALF + m * 16;
#pragma unroll
                    for (int bj = 0; bj < 2; ++bj) { float v[8];
#pragma unroll
                        for (int n = 0; n < 2; ++n)
#pragma unroll
                            for (int j = 0; j < 4; ++j) v[n * 4 + j] = acc[ai][bj][m][n][j] * 0.18033688011112042f;
                        st8(Q + (size_t)row * 1024 + (pn - 4) * 256 + bj * HALF + cb, v); } }
        } else if (pn < 16) {
            const bool isk = pn < 12; const int cq = ((pn - 8) & 3) * 256 + cb;
#pragma unroll
            for (int ai = 0; ai < 2; ++ai)
#pragma unroll
                for (int m = 0; m < 4; ++m) { ROWVARS
                    float* op; bf16_t* bp;
                    if (!smp) { op = out + O_KP + (isk ? (size_t)0 : O_VP - O_KP) + ((size_t)layer * 32768 + row) * 1024; bp = KB + (isk ? (size_t)0 : D_KV) + (size_t)row * 1024; }
                    else { op = out + O_KS + (isk ? (size_t)0 : O_VS - O_KS) + ((size_t)layer * 512 + (row - 32768)) * 1024; bp = KS + (isk ? (size_t)0 : D_S) + ((size_t)((layer * 8 + b) * 2112 + 2048 + t)) * 1024; }
#pragma unroll
                    for (int bj = 0; bj < 2; ++bj) { float v[8];
#pragma unroll
                        for (int n = 0; n < 2; ++n)
#pragma unroll
                            for (int j = 0; j < 4; ++j) v[n * 4 + j] = acc[ai][bj][m][n][j];
                        float* o2 = op + cq + bj * HALF; __builtin_nontemporal_store(acc[ai][bj][m][0], (f32x4*)o2); __builtin_nontemporal_store(acc[ai][bj][m][1], (f32x4*)(o2 + 4));
                        st8(bp + cq + bj * HALF, v); } }
        } else if (pn < 20) {
            const bool isq = pn < 18; const int hb = ((pn - 16) & 1) * 2;
#pragma unroll
            for (int ai = 0; ai < 2; ++ai) {
            f32x4 cc01[4], cc23[4];
#pragma unroll
                for (int m = 0; m < 4; ++m) { ROWVARS (void)b;
                    const int pos = smp ? 2048 + t : t; const float* c = cs + ((size_t)pos * 64 + (cb >> 1)) * 2;
                    cc01[m] = *(const f32x4*)c; cc23[m] = *(const f32x4*)(c + 4); }
            __builtin_amdgcn_sched_barrier(0);
#pragma unroll
                for (int m = 0; m < 4; ++m) { ROWVARS (void)b;
                    const int il = smp ? t : (row & 255);
                    const f32x4 c01 = cc01[m], c23 = cc23[m];
#pragma unroll
                    for (int bj = 0; bj < 2; ++bj) { const int head = hb + bj;
                        const float lg = head == 0 ? -0.04580368961312479f : head == 1 ? -0.02272007650008353f : head == 2 ? -0.011315313227834146f : -0.005646563141142063f;
                        const float e = (float)(il + 1) * lg; const float sc = isq ? __builtin_amdgcn_exp2f(e) : 0.08838834764831845f * __builtin_amdgcn_exp2f(-e);
                        const f32x4 x = acc[ai][bj][m][0], y = acc[ai][bj][m][1]; float v[8];
                        v[0] = (x[0] * c01[0] - x[1] * c01[1]) * sc; v[1] = (x[0] * c01[1] + x[1] * c01[0]) * sc;
                        v[2] = (x[2] * c01[2] - x[3] * c01[3]) * sc; v[3] = (x[2] * c01[3] + x[3] * c01[2]) * sc;
                        v[4] = (y[0] * c23[0] - y[1] * c23[1]) * sc; v[5] = (y[0] * c23[1] + y[1] * c23[0]) * sc;
                        v[6] = (y[2] * c23[2] - y[3] * c23[3]) * sc; v[7] = (y[2] * c23[3] + y[3] * c23[2]) * sc;
                        st8(RQ + (isq ? (size_t)0 : D_R) + (size_t)row * 512 + head * 128 + cb, v); } } }
        } else {
            const bool isv = pn < 22; const int cq = ((pn - 20) & 1) * 256 + cb;
#pragma unroll
            for (int ai = 0; ai < 2; ++ai)
#pragma unroll
                for (int m = 0; m < 4; ++m) { const int row = rbase + ai * HALF + m * 16;
#pragma unroll
                    for (int bj = 0; bj < 2; ++bj) { float v[8];
#pragma unroll
                        for (int n = 0; n < 2; ++n)
#pragma unroll
                            for (int j = 0; j < 4; ++j) { const float x = acc[ai][bj][m][n][j]; v[n * 4 + j] = isv ? x : x * sigm(x); }
                        st8(RV + (isv ? (size_t)0 : D_R) + (size_t)row * 512 + cq + bj * HALF, v); } }
        }
#undef ROWVARS
    }
};
template <class Epi, class Sched, bool ALIGN_EPI = false, bool SP2 = false>
__device__ __forceinline__ void gemm_phase(PG8_LAS unsigned char* lds, const Gemm g, const Sched& S, const Epi& E, int tid0) {
    int tid_ = tid0; asm volatile("" : "+v"(tid_));
    const int tid = tid_, wid = __builtin_amdgcn_readfirstlane(tid >> 6), lane = tid & 63, wr = wid >> 2, wc = wid & 3, fr = lane & 15, fq = lane >> 4;
    const int lda = g.lda, ldb = g.ldb;
    unsigned voffA[2], voffB[2];
#pragma unroll
    for (int i = 0; i < 2; ++i) { int R, C; stage_rc(tid * 16 + i * 8192, R, C); const int Rb = Epi::PERM ? ((R & ~31) + perm32(R & 31)) : R;
        voffA[i] = (unsigned)(R * lda + C) * 2u; voffB[i] = (unsigned)(Rb * ldb + C) * 2u; }
    const size_t ksA = g.ksA, ksB = g.ksB;
    const size_t hsA = (size_t)HALF * lda * 2, hsB = (size_t)HALF * ldb * 2;
    const size_t tsA = g.tsA, tsB = g.tsB;
    const unsigned ldsw = (unsigned)wid * 1024u;
    const int aoff = lds_byte(wr * 64 + fr, fq * 8), boff = lds_byte(wc * 32 + fr, fq * 8);
#define PG8_SA(b, h) (((b) * 2 + (h)) * HTB)
#define PG8_SB(b, h) ((4 + (b) * 2 + (h)) * HTB)
#define PG8_STAGE(bufoff, gbase, voff) do { _Pragma("unroll") for (int _i = 0; _i < 2; ++_i) \
        __builtin_amdgcn_global_load_lds((const unsigned*)((const char*)(gbase) + (voff)[_i]), (PG8_LAS unsigned*)(lds + (bufoff) + ldsw + _i * 8192), 16, 0, 0); } while (0)
#define PG8_LDA(dst, b, h) do { _Pragma("unroll") for (int m = 0; m < 4; ++m) _Pragma("unroll") for (int k = 0; k < 2; ++k) dst[m][k] = *(const PG8_LAS bf16x8*)(lds + PG8_SA(b, h) + aoff + m * 2048 + k * 1024); } while (0)
#define PG8_LDB(dst, b, h) do { _Pragma("unroll") for (int n = 0; n < 2; ++n) _Pragma("unroll") for (int k = 0; k < 2; ++k) dst[n][k] = *(const PG8_LAS bf16x8*)(lds + PG8_SB(b, h) + boff + n * 2048 + k * 1024); } while (0)
#define PG8_MMA(ai, bj, At, Bt) do { __builtin_amdgcn_s_setprio(1); _Pragma("unroll") for (int m = 0; m < 4; ++m) _Pragma("unroll") for (int n = 0; n < 2; ++n) _Pragma("unroll") for (int k = 0; k < 2; ++k) \
        acc[ai][bj][m][n] = __builtin_amdgcn_mfma_f32_16x16x32_bf16(Bt[n][k], At[m][k], acc[ai][bj][m][n], 0, 0, 0); __builtin_amdgcn_s_setprio(0); } while (0)
#define PG8_WAIT_V(n) asm volatile("s_waitcnt vmcnt(" #n ")" ::: "memory")
#define PG8_WAIT_L(n) asm volatile("s_waitcnt lgkmcnt(" #n ")" ::: "memory")
#define PG8_BAR __builtin_amdgcn_s_barrier()
#define PG8_SCHED __builtin_amdgcn_sched_barrier(0)
    Unit cur, nxt; int ui = 0;
    if (!S.next(0, cur)) return;
    f32x4 acc[2][2][4][2];
#pragma unroll
    for (int a = 0; a < 2; ++a)
#pragma unroll
        for (int b = 0; b < 2; ++b)
#pragma unroll
            for (int m = 0; m < 4; ++m)
#pragma unroll
                for (int n = 0; n < 2; ++n) acc[a][b][m][n] = (f32x4){0.f, 0.f, 0.f, 0.f};
    bf16x8 At[4][2], B0[2][2], B1[2][2];
    const char* cA = (const char*)g.A + (size_t)cur.pm * tsA + (size_t)cur.k0 * ksA; const char* cB = (const char*)g.Bt + (size_t)cur.pn * tsB + (size_t)cur.k0 * ksB;
    S.a_ready(cur);
    if constexpr (SP2) {
        PG8_STAGE(PG8_SB(0, 0), cB, voffB); PG8_STAGE(PG8_SB(0, 1), cB + hsB, voffB); PG8_STAGE(PG8_SA(0, 0), cA, voffA); PG8_STAGE(PG8_SA(0, 1), cA + hsA, voffA);
        if (wr == 1) PG8_BAR;
        PG8_WAIT_V(2); PG8_BAR;
        PG8_STAGE(PG8_SB(1, 0), cB + ksB, voffB); PG8_STAGE(PG8_SA(1, 0), cA + ksA, voffA); PG8_STAGE(PG8_SB(1, 1), cB + hsB + ksB, voffB);
        PG8_WAIT_V(6); PG8_BAR;
    } else {
        PG8_STAGE(PG8_SB(0, 0), cB, voffB); PG8_STAGE(PG8_SA(0, 0), cA, voffA); PG8_STAGE(PG8_SB(0, 1), cB + hsB, voffB); PG8_STAGE(PG8_SA(0, 1), cA + hsA, voffA);
        if (wr == 1) PG8_BAR;
        PG8_WAIT_V(4); PG8_BAR;
        PG8_STAGE(PG8_SB(1, 0), cB + ksB, voffB); PG8_STAGE(PG8_SA(1, 0), cA + ksA, voffA); PG8_STAGE(PG8_SB(1, 1), cB + hsB + ksB, voffB);
        PG8_WAIT_V(6); PG8_BAR;
    }
    for (;;) {
        const bool has_next = S.next(ui + 1, nxt);
        const char* nA = has_next ? (const char*)g.A + (size_t)nxt.pm * tsA + (size_t)nxt.k0 * ksA : cA; const char* nB = has_next ? (const char*)g.Bt + (size_t)nxt.pn * tsB + (size_t)nxt.k0 * ksB : cB;
        const int nt = cur.nt;
        for (int t = 0; t < nt; t += 2) {
            const bool last = (t == nt - 2);
            const char* a1 = cA + (size_t)(t + 1) * ksA;
            const char* a2 = last ? nA : cA + (size_t)(t + 2) * ksA; const char* b2 = last ? nB : cB + (size_t)(t + 2) * ksB;
            const char* a3 = a2 + ksA; const char* b3 = b2 + ksB;
            if (last && has_next) S.a_ready(nxt);
            if constexpr (SP2) {
            PG8_LDB(B0, 0, 0); PG8_LDB(B1, 0, 1); PG8_SCHED; PG8_LDA(At, 0, 0); PG8_STAGE(PG8_SA(1, 1), a1 + hsA, voffA);
            PG8_WAIT_V(8); PG8_WAIT_L(0); PG8_BAR; PG8_MMA(0, 0, At, B0); PG8_MMA(0, 1, At, B1); PG8_BAR; PG8_SCHED;
            PG8_LDA(At, 0, 1); PG8_STAGE(PG8_SB(0, 0), b2, voffB); PG8_STAGE(PG8_SB(0, 1), b2 + hsB, voffB); PG8_STAGE(PG8_SA(0, 0), a2, voffA);
            PG8_WAIT_V(8); PG8_WAIT_L(0); PG8_BAR; PG8_MMA(1, 0, At, B0); PG8_MMA(1, 1, At, B1); PG8_BAR; PG8_SCHED;
            PG8_LDB(B0, 1, 0); PG8_LDB(B1, 1, 1); PG8_SCHED; PG8_LDA(At, 1, 0); PG8_STAGE(PG8_SA(0, 1), a2 + hsA, voffA);
            PG8_WAIT_V(8); PG8_WAIT_L(0); PG8_BAR; PG8_MMA(0, 0, At, B0); PG8_MMA(0, 1, At, B1); PG8_BAR; PG8_SCHED;
            PG8_LDA(At, 1, 1); PG8_STAGE(PG8_SB(1, 0), b3, voffB); PG8_STAGE(PG8_SB(1, 1), b3 + hsB, voffB); PG8_STAGE(PG8_SA(1, 0), a3, voffA);
            PG8_WAIT_V(8); PG8_WAIT_L(0); PG8_BAR; PG8_MMA(1, 0, At, B0); PG8_MMA(1, 1, At, B1); PG8_BAR; PG8_SCHED;
            } else {
            PG8_LDB(B0, 0, 0); PG8_SCHED; PG8_LDA(At, 0, 0); PG8_STAGE(PG8_SA(1, 1), a1 + hsA, voffA);
            PG8_WAIT_L(8); PG8_BAR; PG8_WAIT_L(0); PG8_MMA(0, 0, At, B0); PG8_BAR; PG8_SCHED;
            PG8_LDB(B1, 0, 1); PG8_STAGE(PG8_SB(0, 0), b2, voffB);
            PG8_BAR; PG8_WAIT_L(0); PG8_MMA(0, 1, At, B1); PG8_BAR;
            PG8_LDA(At, 0, 1); PG8_STAGE(PG8_SA(0, 0), a2, voffA);
            PG8_BAR; PG8_WAIT_L(0); PG8_MMA(1, 0, At, B0); PG8_BAR; PG8_SCHED;
            PG8_STAGE(PG8_SB(0, 1), b2 + hsB, voffB);
            PG8_WAIT_V(6); PG8_BAR; PG8_MMA(1, 1, At, B1); PG8_BAR;
            PG8_LDB(B0, 1, 0); PG8_SCHED; PG8_LDA(At, 1, 0); PG8_STAGE(PG8_SA(0, 1), a2 + hsA, voffA);
            PG8_WAIT_L(8); PG8_BAR; PG8_WAIT_L(0); PG8_MMA(0, 0, At, B0); PG8_BAR; PG8_SCHED;
            PG8_LDB(B1, 1, 1); PG8_STAGE(PG8_SB(1, 0), b3, voffB);
            PG8_BAR; PG8_WAIT_L(0); PG8_MMA(0, 1, At, B1); PG8_BAR;
            PG8_LDA(At, 1, 1); PG8_STAGE(PG8_SA(1, 0), a3, voffA);
            PG8_BAR; PG8_WAIT_L(0); PG8_MMA(1, 0, At, B0); PG8_BAR; PG8_SCHED;
            PG8_STAGE(PG8_SB(1, 1), b3 + hsB, voffB);
            PG8_WAIT_V(6); PG8_BAR; PG8_MMA(1, 1, At, B1); PG8_BAR;
            }
        }
        if constexpr (ALIGN_EPI) { if (wr == 0) PG8_BAR; }
        if constexpr (!Epi::AFTER_DRAIN) { E(acc, cur, wr, wc, fr, fq); S.done(cur); }
        if (!has_next) break;
#pragma unroll
        for (int a = 0; a < 2; ++a)
#pragma unroll
            for (int b = 0; b < 2; ++b)
#pragma unroll
                for (int m = 0; m < 4; ++m)
#pragma unroll
                    for (int n = 0; n < 2; ++n) acc[a][b][m][n] = (f32x4){0.f, 0.f, 0.f, 0.f};
        cur = nxt; cA = nA; cB = nB; ++ui;
        if constexpr (ALIGN_EPI) { if (wr == 1) PG8_BAR; }
    }
    PG8_WAIT_V(0);
    if constexpr (!ALIGN_EPI) { if (wr == 0) PG8_BAR; }
    PG8_BAR;
    if constexpr (Epi::AFTER_DRAIN) { E.fused(acc, cur, wr, wc, fr, fq, lds, wid, lane); S.done(cur); }
#undef PG8_SA
#undef PG8_SB
#undef PG8_STAGE
#undef PG8_LDA
#undef PG8_LDB
#undef PG8_MMA
#undef PG8_WAIT_V
#undef PG8_WAIT_L
#undef PG8_BAR
#undef PG8_SCHED
}
}
namespace mx {
#define MLAS __attribute__((address_space(3)))
typedef unsigned short bf16_t;
typedef short bf16x8 __attribute__((ext_vector_type(8)));
typedef short s16x4 __attribute__((ext_vector_type(4)));
typedef short v4i16_t __attribute__((ext_vector_type(4)));
typedef float f32x16 __attribute__((ext_vector_type(16)));
typedef float f32x4 __attribute__((ext_vector_type(4)));
typedef unsigned u32x4 __attribute__((ext_vector_type(4)));
typedef unsigned u32x2 __attribute__((ext_vector_type(2)));
typedef MLAS const char* lds_cptr;
typedef MLAS char* lds_ptr;
__device__ __forceinline__ int crow(int r, int hi) { return (r & 3) + 8 * (r >> 2) + 4 * hi; }
typedef float f32x2_t __attribute__((ext_vector_type(2))); typedef __bf16 bf16x2_t __attribute__((ext_vector_type(2)));
__device__ __forceinline__ unsigned cvtpk(float lo, float hi) { f32x2_t v = {lo, hi}; bf16x2_t b = __builtin_convertvector(v, bf16x2_t); return __builtin_bit_cast(unsigned, b); }
__device__ __forceinline__ float bf2f(unsigned short h) { return __uint_as_float((unsigned)h << 16); }
__device__ __forceinline__ void glds16(const void* g, unsigned lds_base) {
    unsigned sv; asm volatile("s_mov_b32 %0, m0\n\ts_mov_b32 m0, %2\n\ts_nop 0\n\tglobal_load_lds_dwordx4 %1, off\n\ts_mov_b32 m0, %0" : "=&s"(sv) : "v"(g), "s"(lds_base) : "memory"); }
__device__ __forceinline__ s16x4 vtr(lds_cptr p) { return __builtin_bit_cast(s16x4, __builtin_amdgcn_ds_read_tr16_b64_v4i16((MLAS v4i16_t*)p)); }
#define MFMA32(a, b, c) __builtin_amdgcn_mfma_f32_32x32x16_bf16(a, b, c, 0, 0, 0)
#define MX_WAIT_BAR(N) asm volatile("s_waitcnt vmcnt(" #N ") lgkmcnt(0)\n\ts_barrier" ::: "memory")
#define RFL(x) ((unsigned)__builtin_amdgcn_readfirstlane((int)(x)))
#define SBAR() __builtin_amdgcn_sched_barrier(0)

template <int NKD> __device__ __forceinline__ void qkt(f32x16& p0, f32x16& p1, lds_cptr kb, const bf16x8* qr, const f32x16& c0) {
    __builtin_amdgcn_s_setprio(1);
#pragma unroll
    for (int d0 = 0; d0 < NKD; ++d0) {
        const bf16x8 b0 = *(const MLAS bf16x8*)(kb + d0 * 2048), b1 = *(const MLAS bf16x8*)(kb + d0 * 2048 + 512);
        if (d0 == 0) { p0 = MFMA32(b0, qr[0], c0); p1 = MFMA32(b1, qr[0], c0); } else { p0 = MFMA32(b0, qr[d0], p0); p1 = MFMA32(b1, qr[d0], p1); }
    }
    __builtin_amdgcn_s_setprio(0);
}
__device__ __forceinline__ void pv4(f32x16 (&o)[4], lds_cptr vp, const bf16x8 (&pa)[4]) {
    __builtin_amdgcn_s_setprio(1);
#pragma unroll
    for (int e0 = 0; e0 < 4; ++e0)
#pragma unroll
        for (int ks = 0; ks < 4; ++ks) {
            const s16x4 lo = vtr(vp + e0 * 4096 + ks * 1024), hh = vtr(vp + e0 * 4096 + ks * 1024 + 512);
            const bf16x8 vf = {lo[0], lo[1], lo[2], lo[3], hh[0], hh[1], hh[2], hh[3]};
            o[e0] = MFMA32(pa[ks], vf, o[e0]);
        }
    __builtin_amdgcn_s_setprio(0);
}
__device__ __forceinline__ void packP(bf16x8 (&pa)[4], const f32x16& p0, const f32x16& p1) {
    u32x4 w;
    w.x = cvtpk(p0[0], p0[1]); w.y = cvtpk(p0[2], p0[3]); w.z = cvtpk(p0[4], p0[5]); w.w = cvtpk(p0[6], p0[7]); pa[0] = __builtin_bit_cast(bf16x8, w);
    w.x = cvtpk(p0[8], p0[9]); w.y = cvtpk(p0[10], p0[11]); w.z = cvtpk(p0[12], p0[13]); w.w = cvtpk(p0[14], p0[15]); pa[1] = __builtin_bit_cast(bf16x8, w);
    w.x = cvtpk(p1[0], p1[1]); w.y = cvtpk(p1[2], p1[3]); w.z = cvtpk(p1[4], p1[5]); w.w = cvtpk(p1[6], p1[7]); pa[2] = __builtin_bit_cast(bf16x8, w);
    w.x = cvtpk(p1[8], p1[9]); w.y = cvtpk(p1[10], p1[11]); w.z = cvtpk(p1[12], p1[13]); w.w = cvtpk(p1[14], p1[15]); pa[3] = __builtin_bit_cast(bf16x8, w);
}
__device__ __forceinline__ float swapsum(float v) { auto rr = __builtin_amdgcn_permlane32_swap(__float_as_uint(v), __float_as_uint(v), false, false); return __uint_as_float(rr[0]) + __uint_as_float(rr[1]); }
__device__ __forceinline__ float swapmax(float v) { auto rr = __builtin_amdgcn_permlane32_swap(__float_as_uint(v), __float_as_uint(v), false, false); return __builtin_fmaxf(__uint_as_float(rr[0]), __uint_as_float(rr[1])); }
__device__ __forceinline__ float half_sum(float v, int lane) {
#pragma unroll
    for (int o = 1; o < 32; o <<= 1) v += __builtin_bit_cast(float, __builtin_amdgcn_ds_bpermute((lane ^ o) << 2, __builtin_bit_cast(int, v)));
    return v;
}
constexpr int A_K = 0, A_KSLOT = 8192, A_V = 3 * A_KSLOT, A_VSLOT = 16384, A_WS = A_V + 3 * A_VSLOT, A_BT = A_WS + 8 * 256, A_END = A_BT + 320 * 4;
#define MX_PIN(x) asm volatile("" : "+v"(x))
template <int THR>
__device__ __forceinline__ void attn_pass(lds_ptr lds, unsigned lds0, int lane, int wid, const bf16_t* Qw, const bf16_t* Kh, const bf16_t* Vh, int NTwg, int NTw, int qpos_w, f32x16 (&o)[4]) {
    const int r32 = lane & 31, hi = lane >> 5;
    const unsigned koff = (unsigned)(lane * 1024 + wid * 8) * 2u, voff = (unsigned)((16 * (wid & 3) + (lane >> 2)) * 1024 + (wid >> 2) * 32 + (lane & 3) * 8) * 2u;
    const unsigned kdst = lds0 + A_K + wid * 1024, vdst = lds0 + A_V + wid * 1024;
    MLAS float* wsf = (MLAS float*)(lds + A_WS) + wid * 64;
    const MLAS float* BT = (const MLAS float*)(lds + A_BT);
    const int trofs = ((lane >> 4) & 1) * 32 + (lane & 3) * 8 + (4 * hi + ((lane & 15) >> 2)) * 64;
#define MX_DMA_K(t, ko) do { unsigned o_ = koff; asm volatile("" : "+v"(o_)); glds16((const char*)Kh + (size_t)(t) * 131072 + o_, RFL(kdst + (ko))); } while (0)
#define MX_DMA_V(t, vo) do { unsigned o_ = voff; asm volatile("" : "+v"(o_)); const char* vs_ = (const char*)Vh + (size_t)(t) * 131072 + o_; glds16(vs_, RFL(vdst + (vo))); glds16(vs_ + 128, RFL(vdst + (vo) + 8192)); } while (0)
    bf16x8 qr[4];
#pragma unroll
    for (int d0 = 0; d0 < 4; ++d0) qr[d0] = (bf16x8){0, 0, 0, 0, 0, 0, 0, 0};
    if (NTw > 0) {
#pragma unroll
        for (int d0 = 0; d0 < 4; ++d0) qr[d0] = *(const bf16x8*)(Qw + (size_t)r32 * 1024 + d0 * 16 + hi * 8);
    }
    MX_DMA_K(0, 0); MX_DMA_V(0, 0);
    if (NTwg > 1) MX_DMA_K(1, A_KSLOT);
    float l = 0.f; f32x16 negm, pA0, pA1, pB0, pB1; bool resc = false;
#pragma unroll
    for (int r = 0; r < 16; ++r) { negm[r] = 0.f; pA0[r] = 0.f; pA1[r] = 0.f; pB0[r] = 0.f; pB1[r] = 0.f; }
#pragma unroll
    for (int e0 = 0; e0 < 4; ++e0)
#pragma unroll
        for (int r = 0; r < 16; ++r) o[e0][r] = 0.f;
    u32x4 pw0, pw1, pw2, pw3;
#define MX_KLD(ko) const lds_cptr kb_ = (lds_cptr)(lds + A_K + (ko) + hi * 1024 + r32 * 16); bf16x8 kf[8]; \
        _Pragma("unroll") for (int d0 = 0; d0 < 4; ++d0) { kf[2 * d0] = *(const MLAS bf16x8*)(kb_ + d0 * 2048); kf[2 * d0 + 1] = *(const MLAS bf16x8*)(kb_ + d0 * 2048 + 512); } SBAR();
#define MX_GA(MF, P, B, W, X0, X1) do { MF; sacc += (P[B] + P[B + 1]) + (P[B + 2] + P[B + 3]); MX_PIN(sacc); W[X0] = cvtpk(P[B], P[B + 1]); W[X1] = cvtpk(P[B + 2], P[B + 3]); MX_PIN(W); SBAR(); } while (0)
#define MX_PHASE_A(C0, C1, N0, N1, ko, PRE) do { MX_KLD(ko) PRE; SBAR(); float sacc = 0.f; \
        MX_GA(N0 = MFMA32(kf[0], qr[0], negm), C0, 0, pw0, 0, 1);  MX_GA(N1 = MFMA32(kf[1], qr[0], negm), C0, 4, pw0, 2, 3); \
        MX_GA(N0 = MFMA32(kf[2], qr[1], N0),   C0, 8, pw1, 0, 1);  MX_GA(N1 = MFMA32(kf[3], qr[1], N1),   C0, 12, pw1, 2, 3); \
        MX_GA(N0 = MFMA32(kf[4], qr[2], N0),   C1, 0, pw2, 0, 1);  MX_GA(N1 = MFMA32(kf[5], qr[2], N1),   C1, 4, pw2, 2, 3); \
        MX_GA(N0 = MFMA32(kf[6], qr[3], N0),   C1, 8, pw3, 0, 1);  MX_GA(N1 = MFMA32(kf[7], qr[3], N1),   C1, 12, pw3, 2, 3); \
        l += sacc; } while (0)
#define MX_MID(N0, N1, t, FIRST) do { \
        if (64 * (t) + 63 - qpos_w > -128) { const int base = 64 * (t) - (qpos_w + r32) + 255; \
            _Pragma("unroll") for (int r = 0; r < 16; ++r) { N0[r] += BT[base + crow(r, hi)]; N1[r] += BT[base + 32 + crow(r, hi)]; } } \
        float m8_[8]; \
        _Pragma("unroll") for (int q = 0; q < 8; ++q) m8_[q] = __builtin_fmaxf(__builtin_fmaxf(N0[2 * q], N0[2 * q + 1]), __builtin_fmaxf(N1[2 * q], N1[2 * q + 1])); \
        float rm = __builtin_fmaxf(__builtin_fmaxf(__builtin_fmaxf(m8_[0], m8_[1]), __builtin_fmaxf(m8_[2], m8_[3])), __builtin_fmaxf(__builtin_fmaxf(m8_[4], m8_[5]), __builtin_fmaxf(m8_[6], m8_[7])));   \
        rm = swapmax(rm); \
        if (FIRST || __any(rm > (float)THR)) { const float dl = FIRST ? rm : __builtin_fmaxf(rm, 0.f); \
            _Pragma("unroll") for (int r = 0; r < 16; ++r) { N0[r] -= dl; N1[r] -= dl; negm[r] -= dl; } \
            const float f = __builtin_amdgcn_exp2f(-dl); l *= f; if (hi == 0) wsf[r32] = f; resc = !(FIRST); } } while (0)
#define MX_VFRAG(i) do { const s16x4 lo_ = vtr(vp_ + ((i) & 3) * 4096 + ((i) >> 2) * 1024), hh_ = vtr(vp_ + ((i) & 3) * 4096 + ((i) >> 2) * 1024 + 512); vf[(i) & 7] = (bf16x8){lo_[0], lo_[1], lo_[2], lo_[3], hh_[0], hh_[1], hh_[2], hh_[3]}; } while (0)
#define MX_PAF(k) __builtin_bit_cast(bf16x8, pw##k)
#define MX_GB(i, PK, X, B) do { if ((i) + 4 < 16) MX_VFRAG((i) + 4); o[(i) & 3] = MFMA32(PK, vf[(i) & 7], o[(i) & 3]); X[B] = __builtin_amdgcn_exp2f(X[B]); X[B + 1] = __builtin_amdgcn_exp2f(X[B + 1]); MX_PIN(X); SBAR(); } while (0)
#define MX_PHASE_B_PRE(vo) const lds_cptr vp_ = (lds_cptr)(lds + A_V + (vo) + trofs); bf16x8 vf[8]; MX_VFRAG(0); MX_VFRAG(1); MX_VFRAG(2); MX_VFRAG(3); SBAR();
#define MX_PHASE_B(N0, N1, vo, DOEXP) do { MX_PHASE_B_PRE(vo) MX_PHASE_B_BODY(N0, N1); } while (0)
#define MX_PHASE_B_BODY(N0, N1) do { \
        MX_GB(0, MX_PAF(0), N0, 0);  MX_GB(1, MX_PAF(0), N0, 2);  MX_GB(2, MX_PAF(0), N0, 4);  MX_GB(3, MX_PAF(0), N0, 6); \
        MX_GB(4, MX_PAF(1), N0, 8);  MX_GB(5, MX_PAF(1), N0, 10); MX_GB(6, MX_PAF(1), N0, 12); MX_GB(7, MX_PAF(1), N0, 14); \
        MX_GB(8, MX_PAF(2), N1, 0);  MX_GB(9, MX_PAF(2), N1, 2);  MX_GB(10, MX_PAF(2), N1, 4); MX_GB(11, MX_PAF(2), N1, 6); \
        MX_GB(12, MX_PAF(3), N1, 8); MX_GB(13, MX_PAF(3), N1, 10); MX_GB(14, MX_PAF(3), N1, 12); MX_GB(15, MX_PAF(3), N1, 14); \
        if (resc) { resc = false; \
            _Pragma("unroll") for (int r = 0; r < 16; ++r) { const float f = wsf[crow(r, hi)]; \
                _Pragma("unroll") for (int e0 = 0; e0 < 4; ++e0) o[e0][r] *= f; } } } while (0)
#define MX_STEP_WAIT(t) do { if ((t) + 1 < NTwg) MX_WAIT_BAR(3); else MX_WAIT_BAR(2); } while (0)
#define MX_STEP_DMA(t) do { if ((t) + 2 < NTwg) MX_DMA_K((t) + 2, kp); if ((t) + 1 < NTwg) MX_DMA_V((t) + 1, vq); } while (0)
#define MX_STEP_BEGIN(t) do { MX_STEP_WAIT(t); MX_STEP_DMA(t); } while (0)
#define MX_STEP_END() do { const int k_ = kp; kp = kc; kc = kn; kn = k_; const int v_ = vq; vq = vp; vp = vc; vc = v_; } while (0)
#define MX_STEP(C0, C1, N0, N1, t) do { MX_STEP_WAIT(t); MX_PHASE_A(C0, C1, N0, N1, kc, MX_STEP_DMA(t)); MX_PHASE_B_PRE(vp) MX_MID(N0, N1, t, false); MX_PHASE_B_BODY(N0, N1); MX_STEP_END(); } while (0)
#define MX_TAIL(X0, X1) do { float sacc = 0.f; \
        _Pragma("unroll") for (int r = 0; r < 16; ++r) sacc += X0[r] + X1[r]; l += sacc; \
        pw0 = (u32x4){cvtpk(X0[0], X0[1]), cvtpk(X0[2], X0[3]), cvtpk(X0[4], X0[5]), cvtpk(X0[6], X0[7])}; pw1 = (u32x4){cvtpk(X0[8], X0[9]), cvtpk(X0[10], X0[11]), cvtpk(X0[12], X0[13]), cvtpk(X0[14], X0[15])}; \
        pw2 = (u32x4){cvtpk(X1[0], X1[1]), cvtpk(X1[2], X1[3]), cvtpk(X1[4], X1[5]), cvtpk(X1[6], X1[7])}; pw3 = (u32x4){cvtpk(X1[8], X1[9]), cvtpk(X1[10], X1[11]), cvtpk(X1[12], X1[13]), cvtpk(X1[14], X1[15])}; \
        const lds_cptr vp_ = (lds_cptr)(lds + A_V + vp + trofs); bf16x8 vf[8]; \
        _Pragma("unroll") for (int ks = 0; ks < 4; ++ks) { \
            MX_VFRAG(4 * ks); MX_VFRAG(4 * ks + 1); MX_VFRAG(4 * ks + 2); MX_VFRAG(4 * ks + 3); \
            const bf16x8 pk_ = ks == 0 ? MX_PAF(0) : ks == 1 ? MX_PAF(1) : ks == 2 ? MX_PAF(2) : MX_PAF(3); \
            o[0] = MFMA32(pk_, vf[(4 * ks) & 7], o[0]); o[1] = MFMA32(pk_, vf[(4 * ks + 1) & 7], o[1]); o[2] = MFMA32(pk_, vf[(4 * ks + 2) & 7], o[2]); o[3] = MFMA32(pk_, vf[(4 * ks + 3) & 7], o[3]); } } while (0)
    MX_WAIT_BAR(0);
    asm volatile("" : "+v"(qr[0]), "+v"(qr[1]), "+v"(qr[2]), "+v"(qr[3]));
    int kp = 2 * A_KSLOT, kc = 0, kn = A_KSLOT, vq = A_VSLOT, vp = 2 * A_VSLOT, vc = 0;
    int t = 0; bool inA = true;
    if (NTw > 0) {
        if (2 < NTwg) MX_DMA_K(2, kp); if (1 < NTwg) MX_DMA_V(1, vq);
        { MX_KLD(kc) pA0 = MFMA32(kf[0], qr[0], negm); pA1 = MFMA32(kf[1], qr[0], negm);
#pragma unroll
          for (int d0 = 1; d0 < 4; ++d0) { pA0 = MFMA32(kf[2 * d0], qr[d0], pA0); pA1 = MFMA32(kf[2 * d0 + 1], qr[d0], pA1); } }
        MX_MID(pA0, pA1, 0, true);
#pragma unroll
        for (int r = 0; r < 16; ++r) { pA0[r] = __builtin_amdgcn_exp2f(pA0[r]); pA1[r] = __builtin_amdgcn_exp2f(pA1[r]); }
        MX_STEP_END(); t = 1;
        for (; t + 1 < NTw; t += 2) { MX_STEP(pA0, pA1, pB0, pB1, t); MX_STEP(pB0, pB1, pA0, pA1, t + 1); }
        if (t < NTw) { MX_STEP(pA0, pA1, pB0, pB1, t); ++t; inA = false; }
    } else {
        if (2 < NTwg) MX_DMA_K(2, kp); if (1 < NTwg) MX_DMA_V(1, vq);
        MX_STEP_END(); t = 1;
    }
    bool pend = NTw > 0;
    for (; t < NTwg; ++t) {
        MX_STEP_BEGIN(t);
        if (pend) { pend = false; if (inA) MX_TAIL(pA0, pA1); else MX_TAIL(pB0, pB1); }
        MX_STEP_END();
    }
    MX_WAIT_BAR(0);
    if (pend) { if (inA) MX_TAIL(pA0, pA1); else MX_TAIL(pB0, pB1); }
    MX_WAIT_BAR(0);
    if (NTw > 0) {
        l = swapsum(l);
        if (hi == 0) wsf[32 + r32] = l;
#pragma unroll
        for (int r = 0; r < 16; ++r) { const float rl = __builtin_amdgcn_rcpf(wsf[32 + crow(r, hi)]);
#pragma unroll
            for (int e0 = 0; e0 < 4; ++e0) o[e0][r] *= rl; }
    }
#undef MX_DMA_K
#undef MX_DMA_V
#undef MX_KLD
#undef MX_GA
#undef MX_PHASE_A
#undef MX_MID
#undef MX_VFRAG
#undef MX_PAF
#undef MX_GB
#undef MX_PHASE_B
#undef MX_PHASE_B_PRE
#undef MX_PHASE_B_BODY
#undef MX_STEP_BEGIN
#undef MX_STEP_WAIT
#undef MX_STEP_DMA
#undef MX_STEP_END
#undef MX_STEP
#undef MX_TAIL
}
__device__ __forceinline__ void attn_unit(lds_ptr lds, unsigned lds0, int tid, const bf16_t* Q, const bf16_t* Kseq, const bf16_t* Vseq, int qrow0, int pos0, int NTwg, int nact, int h,
                                          const float* BTg, int layer, const float* subg, float* scr, bf16_t* MIX) {
    asm volatile("" : "+v"(tid));
    const int lane = tid & 63, wid = __builtin_amdgcn_readfirstlane(tid >> 6), r32 = lane & 31, hi = lane >> 5;
    if (tid < 320) ((MLAS float*)(lds + A_BT))[tid] = BTg[h * 320 + tid];
    const int NTw = wid < nact ? (pos0 + 32 * wid) / 64 + 1 : 0, qpos_w = pos0 + 32 * wid;
    const bf16_t* Qw = Q + (size_t)(qrow0 + 32 * (wid < nact ? wid : 0)) * 1024 + h * 128;
    float* myscr = scr + (size_t)wid * 4096 + lane * 64;
    f32x16 o[4];
    attn_pass<8>(lds, lds0, lane, wid, Qw, Kseq + h * 128, Vseq + h * 128, NTwg, NTw, qpos_w, o);
    if (NTw > 0) {
#pragma unroll
        for (int e0 = 0; e0 < 4; ++e0)
#pragma unroll
            for (int r = 0; r < 16; r += 4) *(f32x4*)(myscr + e0 * 16 + r) = (f32x4){o[e0][r], o[e0][r + 1], o[e0][r + 2], o[e0][r + 3]};
    }
    asm volatile("s_waitcnt vmcnt(0)" ::: "memory");
    attn_pass<8>(lds, lds0, lane, wid, Qw + 64, Kseq + h * 128 + 64, Vseq + h * 128, NTwg, NTw, qpos_w, o);
    if (NTw > 0) {
        const float lam = __builtin_bit_cast(float, __builtin_amdgcn_readfirstlane(__builtin_bit_cast(int, BTg[2560 + layer]))), oml = BTg[2562 + layer];
        float ss[16];
#pragma unroll
        for (int r = 0; r < 16; ++r) ss[r] = 0.f;
        f32x4 sv[16];
        asm volatile("global_load_dwordx4 %0, %16, off sc1\n\tglobal_load_dwordx4 %1, %16, off offset:16 sc1\n\tglobal_load_dwordx4 %2, %16, off offset:32 sc1\n\tglobal_load_dwordx4 %3, %16, off offset:48 sc1\n\t"
                     "global_load_dwordx4 %4, %16, off offset:64 sc1\n\tglobal_load_dwordx4 %5, %16, off offset:80 sc1\n\tglobal_load_dwordx4 %6, %16, off offset:96 sc1\n\tglobal_load_dwordx4 %7, %16, off offset:112 sc1\n\t"
                     "global_load_dwordx4 %8, %16, off offset:128 sc1\n\tglobal_load_dwordx4 %9, %16, off offset:144 sc1\n\tglobal_load_dwordx4 %10, %16, off offset:160 sc1\n\tglobal_load_dwordx4 %11, %16, off offset:176 sc1\n\t"
                     "global_load_dwordx4 %12, %16, off offset:192 sc1\n\tglobal_load_dwordx4 %13, %16, off offset:208 sc1\n\tglobal_load_dwordx4 %14, %16, off offset:224 sc1\n\tglobal_load_dwordx4 %15, %16, off offset:240 sc1\n\t"
                     "s_waitcnt vmcnt(0)"
                     : "=&v"(sv[0]), "=&v"(sv[1]), "=&v"(sv[2]), "=&v"(sv[3]), "=&v"(sv[4]), "=&v"(sv[5]), "=&v"(sv[6]), "=&v"(sv[7]),
                       "=&v"(sv[8]), "=&v"(sv[9]), "=&v"(sv[10]), "=&v"(sv[11]), "=&v"(sv[12]), "=&v"(sv[13]), "=&v"(sv[14]), "=&v"(sv[15])
                     : "v"(myscr) : "memory");
#pragma unroll
        for (int e0 = 0; e0 < 4; ++e0)
#pragma unroll
            for (int r = 0; r < 16; ++r) { const float d = sv[e0 * 4 + (r >> 2)][r & 3] - lam * o[e0][r]; o[e0][r] = d; ss[r] += d * d; }
#pragma unroll
        for (int r = 0; r < 16; ++r) ss[r] = oml * __builtin_amdgcn_rsqf(half_sum(ss[r], lane) * (1.0f / 128.0f) + 1e-5f);
        bf16_t* mp = MIX + (size_t)(qrow0 + 32 * wid + 4 * hi) * 2048 + 512 + h * 128 + r32;
        const float sg0 = subg[r32], sg1 = subg[32 + r32], sg2 = subg[64 + r32], sg3 = subg[96 + r32];
#pragma unroll
        for (int r = 0; r < 16; ++r) { int z_ = 0; asm volatile("" : "+v"(z_)); bf16_t* mr = mp + (size_t)crow(r, 0) * 2048 + z_;
#pragma unroll
            for (int e0 = 0; e0 < 4; ++e0) { const unsigned w = cvtpk(o[e0][r] * ss[r] * (e0 == 0 ? sg0 : e0 == 1 ? sg1 : e0 == 2 ? sg2 : sg3), 0.f); mr[e0 * 32] = (bf16_t)(w & 0xffffu); } }
    }
    asm volatile("s_waitcnt vmcnt(0)" ::: "memory");
}
__device__ __forceinline__ void ret_kv_unit(lds_ptr lds, unsigned lds0, int tid, const bf16_t* RKh, const bf16_t* RVh, int ntile, float* KVTu) {
    asm volatile("" : "+v"(tid));
    const int lane = tid & 63, wid = __builtin_amdgcn_readfirstlane(tid >> 6), r32 = lane & 31, hi = lane >> 5;
    const int trofs = ((lane >> 4) & 1) * 32 + (lane & 3) * 8 + (4 * hi + ((lane & 15) >> 2)) * 64;
    const size_t so = (size_t)(16 * (wid & 3) + (lane >> 2)) * 512 + (wid >> 2) * 32 + (lane & 3) * 8;
    for (int jt = 0; jt < ntile; ++jt) {
        const bf16_t* ks = RKh + (size_t)jt * 64 * 512 + so; const bf16_t* vs = RVh + (size_t)jt * 64 * 512 + so;
        glds16(ks, RFL(lds0 + jt * 16384 + wid * 1024)); glds16(ks + 64, RFL(lds0 + jt * 16384 + 8192 + wid * 1024));
        glds16(vs, RFL(lds0 + 65536 + jt * 16384 + wid * 1024)); glds16(vs + 64, RFL(lds0 + 65536 + jt * 16384 + 8192 + wid * 1024));
    }
    MX_WAIT_BAR(0);
    const int e0 = wid >> 1, d0a = 2 * (wid & 1);
    f32x16 acc[2];
#pragma unroll
    for (int i = 0; i < 2; ++i)
#pragma unroll
        for (int r = 0; r < 16; ++r) acc[i][r] = 0.f;
    for (int jt = 0; jt < ntile; ++jt) {
#pragma unroll
        for (int ks = 0; ks < 4; ++ks) {
            const lds_cptr vp = (lds_cptr)(lds + 65536 + jt * 16384 + e0 * 4096 + ks * 1024 + trofs);
            const s16x4 alo = vtr(vp), ahi = vtr(vp + 512);
            const bf16x8 af = {alo[0], alo[1], alo[2], alo[3], ahi[0], ahi[1], ahi[2], ahi[3]};
#pragma unroll
            for (int i = 0; i < 2; ++i) {
                const lds_cptr kp = (lds_cptr)(lds + jt * 16384 + (d0a + i) * 4096 + ks * 1024 + trofs);
                const s16x4 blo = vtr(kp), bhi = vtr(kp + 512);
                const bf16x8 bfr = {blo[0], blo[1], blo[2], blo[3], bhi[0], bhi[1], bhi[2], bhi[3]};
                acc[i] = MFMA32(af, bfr, acc[i]);
            }
        }
    }
    float* kp0 = KVTu + (32 * e0 + 4 * hi) * 128 + 32 * d0a + r32;
#pragma unroll
    for (int r = 0; r < 16; ++r) { int z_ = 0; asm volatile("" : "+v"(z_)); float* kr = kp0 + crow(r, 0) * 128 + z_; kr[0] = acc[0][r]; kr[32] = acc[1][r]; }
    MX_WAIT_BAR(0);
}
__device__ __forceinline__ void ret_out_unit(lds_ptr lds, unsigned lds0, int tid, const bf16_t* RQh, const bf16_t* RKh, const bf16_t* RVh, const bf16_t* RGh, const bf16_t* SPu,
                                             int ntile, int nact, bf16_t* MIXh) {
    asm volatile("" : "+v"(tid));
    const int lane = tid & 63, wid = __builtin_amdgcn_readfirstlane(tid >> 6), r32 = lane & 31, hi = lane >> 5;
    const int trofs = ((lane >> 4) & 1) * 32 + (lane & 3) * 8 + (4 * hi + ((lane & 15) >> 2)) * 64;
    const size_t so = (size_t)(16 * (wid & 3) + (lane >> 2)) * 512 + (wid >> 2) * 32 + (lane & 3) * 8;
    for (int jt = 0; jt < ntile; ++jt) {
        const bf16_t* ks = RKh + (size_t)(jt * 64 + lane) * 512 + wid * 8; const bf16_t* vs = RVh + (size_t)jt * 64 * 512 + so;
        glds16(ks, RFL(lds0 + jt * 16384 + wid * 1024)); glds16(ks + 64, RFL(lds0 + jt * 16384 + 8192 + wid * 1024));
        glds16(vs, RFL(lds0 + 65536 + jt * 16384 + wid * 1024)); glds16(vs + 64, RFL(lds0 + 65536 + jt * 16384 + 8192 + wid * 1024));
    }
    const bool act = wid < nact;
    bf16x8 qr[8]; f32x16 o[4];
#pragma unroll
    for (int e0 = 0; e0 < 4; ++e0)
#pragma unroll
        for (int r = 0; r < 16; ++r) o[e0][r] = 0.f;
    if (act) {
#pragma unroll
        for (int kd = 0; kd < 8; ++kd) qr[kd] = *(const bf16x8*)(RQh + (size_t)(32 * wid + r32) * 512 + kd * 16 + hi * 8);
#pragma unroll
        for (int e0 = 0; e0 < 4; ++e0) { bf16x8 sf[8];
#pragma unroll
            for (int kd = 0; kd < 8; ++kd) sf[kd] = *(const bf16x8*)(SPu + (size_t)(32 * e0 + r32) * 128 + 16 * kd + 8 * hi);
            SBAR();
#pragma unroll
            for (int kd = 0; kd < 8; ++kd) o[e0] = MFMA32(qr[kd], sf[kd], o[e0]);
            SBAR(); }
    } else {
#pragma unroll
        for (int kd = 0; kd < 8; ++kd) qr[kd] = (bf16x8){0, 0, 0, 0, 0, 0, 0, 0};
    }
    MX_WAIT_BAR(0);
    if (act) {
        const int jd = wid >> 1; f32x16 zero;
#pragma unroll
        for (int r = 0; r < 16; ++r) zero[r] = 0.f;

#ifndef RO_SKIP_INNER
#define RO_SKIP_INNER 0
#endif
        if (!RO_SKIP_INNER) for (int jt = 0; jt <= jd; ++jt) {
            f32x16 p0, p1;
#ifndef RO_CONST_P
            qkt<8>(p0, p1, (lds_cptr)(lds + jt * 16384 + hi * 1024 + r32 * 16), qr, zero);
#else
            for (int r = 0; r < 16; ++r) { p0[r] = 1.0f; p1[r] = 0.5f; }
#endif
            if (jt == jd) { const int q = 32 * wid + r32;
#pragma unroll
                for (int r = 0; r < 16; ++r) { const int k0 = 64 * jt + crow(r, hi); p0[r] = (k0 <= q) ? p0[r] : 0.f; p1[r] = (k0 + 32 <= q) ? p1[r] : 0.f; } }
            bf16x8 pa[4]; packP(pa, p0, p1);
            pv4(o, (lds_cptr)(lds + 65536 + jt * 16384 + trofs), pa);
        }
        float mu[16];
#pragma unroll
        for (int r = 0; r < 16; ++r) { mu[r] = half_sum((o[0][r] + o[1][r]) + (o[2][r] + o[3][r]), lane) * (1.0f / 128.0f); }
        float rs[16];
#pragma unroll
        for (int r = 0; r < 16; ++r) { float q = 0.f;
#pragma unroll
            for (int e0 = 0; e0 < 4; ++e0) { const float d = o[e0][r] - mu[r]; o[e0][r] = d; q += d * d; }
            rs[r] = __builtin_amdgcn_rsqf(half_sum(q, lane) * (1.0f / 128.0f) + 1e-5f); }
        const bf16_t* gp0 = RGh + (size_t)(32 * wid + 4 * hi) * 512 + r32; bf16_t* mp0 = MIXh + (size_t)(32 * wid + 4 * hi) * 2048 + r32;
        unsigned short gv[16][4];
#pragma unroll
        for (int r = 0; r < 16; ++r) { int z_ = 0; asm volatile("" : "+v"(z_)); const bf16_t* gr = gp0 + (size_t)crow(r, 0) * 512 + z_;
#pragma unroll
            for (int e0 = 0; e0 < 4; ++e0) gv[r][e0] = gr[e0 * 32]; }
        SBAR();
#pragma unroll
        for (int r = 0; r < 16; ++r) { int z_ = 0; asm volatile("" : "+v"(z_)); bf16_t* mr = mp0 + (size_t)crow(r, 0) * 2048 + z_;
#pragma unroll
            for (int e0 = 0; e0 < 4; ++e0) { const unsigned w = cvtpk(o[e0][r] * rs[r] * bf2f(gv[r][e0]), 0.f); mr[e0 * 32] = (bf16_t)(w & 0xffffu); } }
    }
    MX_WAIT_BAR(0);
}
#undef RFL
}
constexpr int NWAVES = 8;
constexpr int DM = 2048, MP = 32768, MS = 512, M = MP + MS, DFF = 5632, DIN = 6144;
#ifndef H_PITCH
#define H_PITCH 5696
#endif
constexpr int HP = H_PITCH;
constexpr float ALPHA = 1.4142135623730951f, LN_EPS = 1e-5f;
constexpr size_t HMiB = 512u * 1024u;
constexpr size_t WS_CTL = 0, CTL_ZERO_BYTES = 2 * HMiB;
constexpr size_t WS_TAB = 2 * HMiB;
constexpr size_t WS_CS = 4 * HMiB;
constexpr size_t WS_WGU = 20 * HMiB;
constexpr size_t WS_WD = WS_WGU + 352 * HMiB;
constexpr size_t WS_WIN = WS_WD + 180 * HMiB;
constexpr size_t WS_WOUT = WS_WIN + 96 * HMiB;
constexpr size_t WS_XB = WS_WOUT + 32 * HMiB;
constexpr size_t WS_KS = WS_XB + 260 * HMiB;
constexpr size_t WS_VS = WS_KS + 132 * HMiB;
constexpr size_t WS_R = WS_VS + 132 * HMiB;
constexpr size_t WS_H = WS_R;
constexpr size_t WS_U = WS_R, WS_Q = WS_U + 65 * HMiB, WS_KB = WS_Q + 130 * HMiB, WS_VB = WS_KB + 128 * HMiB, WS_RQ = WS_VB + 128 * HMiB, WS_RK = WS_RQ + 65 * HMiB,
                 WS_RV = WS_RK + 65 * HMiB, WS_RG = WS_RV + 65 * HMiB, WS_KVT = WS_RG + 65 * HMiB, WS_SP = WS_KVT + 68 * HMiB, WS_ASCR = WS_SP + 34 * HMiB, WS_END = WS_ASCR + 64 * HMiB;
constexpr size_t WS_SLAB = WS_R + 740 * HMiB;
static_assert(WS_SLAB >= WS_H + (size_t)M * HP * 2 && WS_SLAB + (size_t)11 * 512 * 2048 * 4 <= WS_END && WS_WD + (size_t)4 * DM * HP * 2 <= WS_WIN, "slab / down-copy placement");
static_assert(WS_H + (size_t)M * HP * 2 <= WS_END, "H fits the shared region");
constexpr int CW_TMO = 0, CW_CODE = 1, CW_BAR = 4096, CW_Q = 8192;
constexpr int RING_OFF = 0, RING_BYTES = 131072, LDSCTL_OFF = RING_BYTES, MISC_OFF = LDSCTL_OFF + 320, LDS_BYTES = 147456;

#define GAS __attribute__((address_space(1)))
#define LAS __attribute__((address_space(3)))
typedef unsigned short bf16;
typedef unsigned v4u __attribute__((ext_vector_type(4)));
typedef unsigned v2u __attribute__((ext_vector_type(2)));
typedef float f32x4 __attribute__((ext_vector_type(4)));
typedef GAS unsigned gu32;
#define RLX_AGENT __ATOMIC_RELAXED, __HIP_MEMORY_SCOPE_AGENT
#define LDS_WAIT() asm volatile("s_waitcnt lgkmcnt(0)" ::: "memory")
#define VM_WAIT() asm volatile("s_waitcnt vmcnt(0)" ::: "memory")
__device__ __forceinline__ unsigned pk2(float lo, float hi) { return pg8::cvt_pk_bf16(lo, hi); }
static_assert(WS_VB - WS_KB == pg8::EpiIn::D_KV * 2 && WS_VS - WS_KS == pg8::EpiIn::D_S * 2 && WS_RK - WS_RQ == pg8::EpiIn::D_R * 2 && WS_RG - WS_RV == pg8::EpiIn::D_R * 2, "EpiIn's pointer deltas match the workspace map");
#define XB_TMO      128
#define XB_XCNT(j)  (256  + 64 * (j))
#define XB_XSUB(j)  (1280 + 64 * (j))
#define XB_XGEN(j)  (2304 + 64 * (j))
#define XB_TOP      3328
#define XB_TOPGEN   3392
#define XCD_BAR_WORDS 3456
#define XB_SPIN_CAP (1u << 22)

__device__ __forceinline__ unsigned xb_ld(unsigned* p)              { return __hip_atomic_load(p, __ATOMIC_RELAXED, __HIP_MEMORY_SCOPE_AGENT); }
__device__ __forceinline__ unsigned xb_add(unsigned* p, unsigned v) { return __hip_atomic_fetch_add(p, v, __ATOMIC_RELAXED, __HIP_MEMORY_SCOPE_AGENT); }
__device__ __forceinline__ unsigned xb_xcc_id() { return (unsigned)__builtin_amdgcn_s_getreg((3 << 11) | 20) & 0xFu; }
#define XB_SPIN(cond, bar) do { unsigned _sp = 0; while (cond) { __builtin_amdgcn_s_sleep(1); \
    if ((++_sp & 255u) == 0u) { if (xb_ld(&(bar)[XB_TMO])) break; if (_sp > XB_SPIN_CAP) { atomicAdd(&(bar)[XB_TMO], 1u); break; } } } } while (0)

struct XcdBarrier {
    unsigned* bar; unsigned x;
    volatile LAS unsigned* st;
};

__device__ __forceinline__ XcdBarrier xcd_barrier_post(unsigned* bar, volatile LAS unsigned* st) {
    XcdBarrier b; b.bar = bar; b.x = xb_xcc_id(); b.st = st;
    if (threadIdx.x == 0) (void)xb_add(&bar[XB_XCNT(b.x)], 1u);
    return b;
}
__device__ __forceinline__ void xcd_barrier_complete(unsigned* bar, unsigned x, unsigned& nloc, unsigned& nx) {
    const unsigned G = gridDim.x * gridDim.y * gridDim.z;
    unsigned sum, cnt, mine, sp = 0u;
    for (;;) {
        sum = 0u; cnt = 0u; mine = 0u;
#pragma unroll
        for (unsigned j = 0; j < 16; ++j) { const unsigned c = xb_ld(&bar[XB_XCNT(j)]); sum += c; cnt += (c > 0u) ? 1u : 0u; mine = (j == x) ? c : mine; }
        if (sum == G) break;
        __builtin_amdgcn_s_sleep(1);
        if ((++sp & 255u) == 0u) { if (xb_ld(&bar[XB_TMO])) break; if (sp > XB_SPIN_CAP) { atomicAdd(&bar[XB_TMO], 1u); break; } }
    }
    nloc = mine > 0u ? mine : 1u; nx = cnt > 0u ? cnt : 1u;
}

__device__ __forceinline__ void xcd_barrier(const XcdBarrier& b, int tid_x  ) {
    asm volatile("s_waitcnt vmcnt(0)" ::: "memory");
    __syncthreads();
    if (tid_x == 0) {
        unsigned* bar = b.bar;
        unsigned bx_ = b.x; asm volatile("" : "+s"(bx_));
#define BX_ bx_
        __builtin_amdgcn_s_waitcnt(0);
        unsigned nloc = b.st[0], nx = b.st[1];
        if (nloc == 0u) { xcd_barrier_complete(bar, BX_, nloc, nx); b.st[0] = nloc; b.st[1] = nx; }
        const unsigned old = xb_add(&bar[XB_XSUB(BX_)], 1u);
        const unsigned gen = old / nloc;
        if (old + 1u == (gen + 1u) * nloc) {
            __builtin_amdgcn_fence(__ATOMIC_RELEASE, "agent");
            asm volatile("s_waitcnt vmcnt(0)" ::: "memory");
            const unsigned og = xb_add(&bar[XB_TOP], 1u);
            const unsigned tg = og / nx;
            if (og + 1u == (tg + 1u) * nx) xb_add(&bar[XB_TOPGEN], 1u);
            else XB_SPIN(xb_ld(&bar[XB_TOPGEN]) == tg, bar);
            __builtin_amdgcn_fence(__ATOMIC_ACQUIRE, "agent");
            xb_add(&bar[XB_XGEN(BX_)], 1u);
            asm volatile("s_waitcnt vmcnt(0)" ::: "memory");
        } else {
            XB_SPIN(xb_ld(&bar[XB_XGEN(BX_)]) == gen, bar);
            __builtin_amdgcn_fence(__ATOMIC_ACQUIRE, "agent");
            asm volatile("s_waitcnt vmcnt(0)" ::: "memory");
        }
    }
    __syncthreads();
}
__device__ __forceinline__ float wave_sum(float v, int lane) {
#pragma unroll
    for (int o = 1; o < 64; o <<= 1) v += __builtin_bit_cast(float, __builtin_amdgcn_ds_bpermute((lane ^ o) << 2, __builtin_bit_cast(int, v)));
    return v;
}
__device__ __forceinline__ int map_row(int code, int n) {
    if (code == 0) return n;
    if (code == 1) return ((n >> 7) << 8) + (n & 127);
    if (code == 2) return ((n >> 7) << 8) + 128 + (n & 127);
    if (n < 512) return ((n >> 7) << 8) + (n & 127);
    if (n < 1024) { const int m = n - 512; return ((m >> 7) << 8) + 128 + (m & 127); }
    if (n >= 4096 && n < 5120) { const int d = n & 127; return (n & ~127) + (d < 64 ? 2 * d : 2 * (d - 64) + 1); }
    return n;
}
__device__ __forceinline__ void p0_transpose_item(const float* W, int K, int N, bf16* WT, int code, LAS float* scr, int item, int lane, int ldw = 0) {
    if (ldw == 0) ldw = K;
    const int nblk = N / 32, kb = item / nblk, nb = item % nblk, k0 = 64 * kb, n0 = 32 * nb;
#pragma unroll 8
    for (int i = 0; i < 32; ++i) { const int kk = 2 * i + (lane >> 5); scr[kk * 33 + (lane & 31)] = W[(size_t)(k0 + kk) * N + n0 + (lane & 31)]; }
    LDS_WAIT(); asm volatile("" ::: "memory");
    const int c = lane & 7;
#pragma unroll
    for (int j = 0; j < 4; ++j) { const int n = (lane >> 3) + 8 * j; const LAS float* s = scr + (8 * c) * 33 + n;
        v4u o; o.x = pk2(s[0 * 33], s[1 * 33]); o.y = pk2(s[2 * 33], s[3 * 33]); o.z = pk2(s[4 * 33], s[5 * 33]); o.w = pk2(s[6 * 33], s[7 * 33]);
        *(GAS v4u*)(WT + (size_t)map_row(code, n0 + n) * ldw + k0 + 8 * c) = o; }
    LDS_WAIT(); asm volatile("" ::: "memory");
}
__device__ __forceinline__ void ln_pass(bf16* XBp, float* fout_base, const float* g, const float* b, int lane, int gw, int NGW, const float* slab, int nsplit, float alpha, float scale, int m_end) {
    f32x4 gg[8], bb[8];
#pragma unroll
    for (int j = 0; j < 4; ++j) { const int c0 = lane * 8 + 512 * j; gg[2 * j] = *(const GAS f32x4*)(g + c0); gg[2 * j + 1] = *(const GAS f32x4*)(g + c0 + 4); bb[2 * j] = *(const GAS f32x4*)(b + c0); bb[2 * j + 1] = *(const GAS f32x4*)(b + c0 + 4); }
    v4u cur[4];
    if (gw < m_end) {
#pragma unroll
        for (int j = 0; j < 4; ++j) cur[j] = ((const GAS v4u*)(XBp + (size_t)gw * DM) + lane)[64 * j];
    }
    for (int m = gw; m < m_end; m += NGW) {
        v4u nx[4]; const int mn = m + NGW;
        if (mn < m_end) {
#pragma unroll
            for (int j = 0; j < 4; ++j) nx[j] = ((const GAS v4u*)(XBp + (size_t)mn * DM) + lane)[64 * j];
        }
        float v[32]; float s = 0.f;
#pragma unroll
        for (int j = 0; j < 4; ++j)
#pragma unroll
            for (int q = 0; q < 4; ++q) { v[j * 8 + 2 * q] = __uint_as_float(cur[j][q] << 16); v[j * 8 + 2 * q + 1] = __uint_as_float(cur[j][q] & 0xffff0000u); }
        if (m >= MP) { const float* part = slab + (size_t)(m - MP) * DM;
            f32x4 a[8];
#pragma unroll
            for (int q = 0; q < 8; ++q) a[q] = (f32x4){0.f, 0.f, 0.f, 0.f};
            for (int ks = 0; ks < nsplit; ++ks) { const float* pp = part + (size_t)ks * 512 * 2048 + lane * 8; f32x4 t8[8];
#pragma unroll
                for (int j = 0; j < 4; ++j) { t8[2 * j] = *(const GAS f32x4*)(pp + 512 * j); t8[2 * j + 1] = *(const GAS f32x4*)(pp + 512 * j + 4); }
                __builtin_amdgcn_sched_barrier(0);
#pragma unroll
                for (int q = 0; q < 8; ++q) a[q] += t8[q]; }
#pragma unroll
            for (int j = 0; j < 4; ++j)
#pragma unroll
                for (int q = 0; q < 4; ++q) { v[j * 8 + q] = v[j * 8 + q] * alpha + a[2 * j][q] * scale; v[j * 8 + 4 + q] = v[j * 8 + 4 + q] * alpha + a[2 * j + 1][q] * scale; }
        }
#pragma unroll
        for (int i = 0; i < 32; ++i) s += v[i];
        const float mean = wave_sum(s, lane) * (1.f / DM); float s2 = 0.f;
#pragma unroll
        for (int i = 0; i < 32; ++i) { v[i] -= mean; s2 += v[i] * v[i]; }
        const float rstd = 1.f / sqrtf(wave_sum(s2, lane) * (1.f / DM) + LN_EPS);
        GAS v4u* xr = (GAS v4u*)(XBp + (size_t)m * DM) + lane;
#pragma unroll
        for (int j = 0; j < 4; ++j) { const int c0 = lane * 8 + 512 * j; f32x4 o0, o1;
#pragma unroll
            for (int q = 0; q < 4; ++q) { o0[q] = v[j * 8 + q] * rstd * gg[2 * j][q] + bb[2 * j][q]; o1[q] = v[j * 8 + 4 + q] * rstd * gg[2 * j + 1][q] + bb[2 * j + 1][q]; }
            if (fout_base) { float* fo = fout_base + (size_t)m * DM + c0; __builtin_nontemporal_store(o0, (GAS f32x4*)fo); __builtin_nontemporal_store(o1, (GAS f32x4*)(fo + 4)); }
            else { v4u w; w.x = pk2(o0[0], o0[1]); w.y = pk2(o0[2], o0[3]); w.z = pk2(o1[0], o1[1]); w.w = pk2(o1[2], o1[3]); xr[64 * j] = w; } }
#pragma unroll
        for (int j = 0; j < 4; ++j) cur[j] = nx[j];
    }
}
template <int NS>
__device__ __forceinline__ void ln_sample(LAS unsigned char* lds, bf16* XBp, const float* g, const float* b, int tid, int vcu, int G, const float* slab, float alpha, float scale) {
    const int lane = tid & 63, wave = tid >> 6, q = wave & 3, rs = wave >> 2, c0 = q * 512 + lane * 8;
    LAS float* ex = (LAS float*)lds;
    const f32x4 g0 = *(const GAS f32x4*)(g + c0), g1 = *(const GAS f32x4*)(g + c0 + 4), b0 = *(const GAS f32x4*)(b + c0), b1 = *(const GAS f32x4*)(b + c0 + 4);
    for (int r2 = vcu; r2 < MS / 2; r2 += G) {
        const int ms = r2 * 2 + rs;
        GAS v4u* xp = (GAS v4u*)(XBp + (size_t)(MP + ms) * DM + c0);
        const v4u xv = *xp;
        const float* pp = slab + (size_t)ms * DM + c0;
        f32x4 t[2 * NS];
#pragma unroll
        for (int ks = 0; ks < NS; ++ks) { t[2 * ks] = *(const GAS f32x4*)(pp + (size_t)ks * 512 * 2048); t[2 * ks + 1] = *(const GAS f32x4*)(pp + (size_t)ks * 512 * 2048 + 4); }
        __builtin_amdgcn_sched_barrier(0);
        f32x4 a0 = (f32x4){0.f, 0.f, 0.f, 0.f}, a1 = a0;
#pragma unroll
        for (int ks = 0; ks < NS; ++ks) { a0 += t[2 * ks]; a1 += t[2 * ks + 1]; }
        float v[8]; float s = 0.f;
#pragma unroll
        for (int i = 0; i < 4; ++i) { v[2 * i] = __uint_as_float(xv[i] << 16); v[2 * i + 1] = __uint_as_float(xv[i] & 0xffff0000u); }
#pragma unroll
        for (int i = 0; i < 4; ++i) { v[i] = v[i] * alpha + a0[i] * scale; v[4 + i] = v[4 + i] * alpha + a1[i] * scale; }
#pragma unroll
        for (int i = 0; i < 8; ++i) s += v[i];
        const float ws1 = wave_sum(s, lane);
        if (lane == 0) ex[rs * 4 + q] = ws1;
        __syncthreads();
        const float mean = (((ex[rs * 4] + ex[rs * 4 + 1]) + ex[rs * 4 + 2]) + ex[rs * 4 + 3]) * (1.f / DM); float s2 = 0.f;
#pragma unroll
        for (int i = 0; i < 8; ++i) { v[i] -= mean; s2 += v[i] * v[i]; }
        const float ws2 = wave_sum(s2, lane);
        if (lane == 0) ex[8 + rs * 4 + q] = ws2;
        __syncthreads();
        const float rstd = 1.f / sqrtf((((ex[8 + rs * 4] + ex[8 + rs * 4 + 1]) + ex[8 + rs * 4 + 2]) + ex[8 + rs * 4 + 3]) * (1.f / DM) + LN_EPS);
        f32x4 o0, o1;
#pragma unroll
        for (int i = 0; i < 4; ++i) { o0[i] = v[i] * rstd * g0[i] + b0[i]; o1[i] = v[4 + i] * rstd * g1[i] + b1[i]; }
        v4u w; w.x = pk2(o0[0], o0[1]); w.y = pk2(o0[2], o0[3]); w.z = pk2(o1[0], o1[1]); w.w = pk2(o1[2], o1[3]);
        *xp = w;
        __syncthreads();
    }
}
__device__ __forceinline__ void conv_item(LAS unsigned char* lds, int tid, int item, int l, const bf16* U, const float* cache_conv, const float* cw, const float* cbias, const float* cg, const float* cbeta, bf16* MIX) {
    asm volatile("" : "+v"(tid));
    const int lane = tid & 63, wid = tid >> 6;
    int b, t0, urow0; const float* hist = nullptr;
    if (item < 1024) { b = item >> 9; t0 = (item & 511) * 32; urow0 = b * 16384; }
    else { const int i2 = item - 1024; b = i2 >> 1; t0 = (i2 & 1) * 32; urow0 = 32768 + b * 64; hist = cache_conv + (size_t)((l * 8 + b) * 30) * 512; }
    { v4u st[8];
#pragma unroll
      for (int q = 0; q < 8; ++q) { const int idx = tid + 512 * q, lr = idx >> 6, ch = idx & 63, t = t0 - 30 + lr; v4u v = (v4u){0u, 0u, 0u, 0u};
        if (idx < 62 * 64) {
          if (t >= 0) v = *(const GAS v4u*)(U + (size_t)(urow0 + t) * 512 + ch * 8);
          else if (hist) { const float* hp = hist + (size_t)(30 + t) * 512 + ch * 8; const f32x4 a = *(const GAS f32x4*)hp, c = *(const GAS f32x4*)(hp + 4);
            v.x = pk2(a.x, a.y); v.y = pk2(a.z, a.w); v.z = pk2(c.x, c.y); v.w = pk2(c.z, c.w); } }
        st[q] = v; }
      __builtin_amdgcn_sched_barrier(0);
#pragma unroll
      for (int q = 0; q < 8; ++q) { const int idx = tid + 512 * q, lr = idx >> 6, ch = idx & 63; if (idx < 62 * 64) *(LAS v4u*)(lds + (size_t)(lr * 512 + ch * 8) * 2) = st[q]; } }
    __syncthreads();
    const int c = tid;
    float w[31];
    { const float* wp = cw + (size_t)l * 31 * 512 + c;
#pragma unroll
      for (int j = 0; j < 31; ++j) { int z_ = 0; asm volatile("" : "+v"(z_)); w[j] = wp[j * 512 + z_]; } }
    float y[32]; const float bias = cbias[l * 512 + c];
#pragma unroll
    for (int i = 0; i < 32; ++i) y[i] = bias;
    const LAS unsigned short* tile = (const LAS unsigned short*)lds;
#pragma unroll
    for (int k = 0; k < 62; ++k) { const float v = __uint_as_float((unsigned)tile[k * 512 + c] << 16);
#pragma unroll
        for (int i = 0; i < 32; ++i) if (k - i >= 0 && k - i <= 30) y[i] += w[k - i] * v; }
    LAS float* yb = (LAS float*)(lds + 65536);
#pragma unroll
    for (int i = 0; i < 32; ++i) yb[i * 512 + c] = y[i];
    __syncthreads();
    float cgv[8], cbv[8];
#pragma unroll
    for (int k8 = 0; k8 < 8; ++k8) { cgv[k8] = cg[l * 512 + lane + 64 * k8]; cbv[k8] = cbeta[l * 512 + lane + 64 * k8]; }
#pragma unroll
    for (int rr = 0; rr < 4; ++rr) { const int i = wid * 4 + rr; float v[8]; float s = 0.f;
#pragma unroll
        for (int k = 0; k < 8; ++k) { v[k] = yb[i * 512 + lane + 64 * k]; s += v[k]; }
        const float mean = wave_sum(s, lane) * (1.f / 512.f); float q = 0.f;
#pragma unroll
        for (int k = 0; k < 8; ++k) { v[k] -= mean; q += v[k] * v[k]; }
        const float rstd = 1.f / sqrtf(wave_sum(q, lane) * (1.f / 512.f) + LN_EPS);
        int z_ = 0; asm volatile("" : "+v"(z_)); bf16* mr = MIX + (size_t)(urow0 + t0 + i) * 2048 + lane + z_;
#pragma unroll
        for (int k = 0; k < 8; ++k) { float z = v[k] * rstd * cgv[k] + cbv[k]; z = z * pg8::sigm(z);
            mr[64 * k] = (bf16)(pk2(z, 0.f) & 0xffffu); } }
    __syncthreads();
}

#define DERIVE_PTRS(WSV, OUTV) \
    unsigned char* ws = (WSV); float* out = (OUTV); \
    gu32* ctl = (gu32*)(ws + WS_CTL); \
    float* TAB = (float*)(ws + WS_TAB); float* CS = (float*)(ws + WS_CS); \
    bf16* WGU = (bf16*)(ws + WS_WGU); bf16* WD = (bf16*)(ws + WS_WD); bf16* WIN = (bf16*)(ws + WS_WIN); bf16* WOUT = (bf16*)(ws + WS_WOUT); \
    bf16* XB = (bf16*)(ws + WS_XB); bf16* KS = (bf16*)(ws + WS_KS); bf16* VS = (bf16*)(ws + WS_VS); bf16* HB = (bf16*)(ws + WS_H); \
    bf16* U = (bf16*)(ws + WS_U); bf16* Q = (bf16*)(ws + WS_Q); bf16* KB = (bf16*)(ws + WS_KB); bf16* VB = (bf16*)(ws + WS_VB); \
    bf16* RQ = (bf16*)(ws + WS_RQ); bf16* RK = (bf16*)(ws + WS_RK); bf16* RV = (bf16*)(ws + WS_RV); bf16* RG = (bf16*)(ws + WS_RG); \
    float* KVT = (float*)(ws + WS_KVT); bf16* SP = (bf16*)(ws + WS_SP); float* ASCR = (float*)(ws + WS_ASCR); \
    bf16* MIXB = (bf16*)out; float* SLAB = (float*)(ws + WS_SLAB);
__device__ __forceinline__ int fresh_tid(int wave_s) { int l_; asm volatile("v_mbcnt_lo_u32_b32 %0, -1, 0\n\tv_mbcnt_hi_u32_b32 %0, -1, %0" : "=v"(l_)); return (wave_s << 6) | l_; }
#define PH_IDS const int tid = fresh_tid(wave_s); const int lane = tid & 63; const int wave = __builtin_amdgcn_readfirstlane(tid >> 6); const int gw = vcu * NWAVES + wave; (void)lane; (void)gw;
#define SPLIT_IDS(NSU) const int nx_ = (G % 8 == 0) ? 8 : 1, cpx_ = G / nx_, xx_ = (int)blockIdx.x % nx_, xr_ = (int)blockIdx.x / nx_, per0_ = ((NSU) + nx_ - 1) / nx_, per_ = per0_ < cpx_ - 1 ? per0_ : cpx_ - 1; \
    const bool gemm_cu_ = xr_ < per_; const int NP_ = per_ * nx_, pidx_ = xx_ * per_ + xr_, NL_ = nx_ * (cpx_ - per_), lnidx_ = xx_ * (cpx_ - per_) + (xr_ - per_);
#ifndef STOP_IT
#define STOP_IT -1
#define STOP_PH -1
#endif
#define STOP_AT(ph) do { if (STOP_IT == it && STOP_PH == (ph)) return; } while (0)
#ifndef H_TILED
#define H_TILED 1
#endif
#ifndef GU_WGM
#define GU_WGM 4
#endif
struct Args { const float* in[20]; float* out; unsigned char* ws; };
__global__ void __launch_bounds__(NWAVES * 64, 2) mk_fwd(Args args) {
    extern __shared__ __attribute__((aligned(16))) unsigned char lds_raw[];
    LAS unsigned char* lds = (LAS unsigned char*)lds_raw;
    volatile LAS unsigned* MISC = (volatile LAS unsigned*)(lds + MISC_OFF);
    const int wave_s = __builtin_amdgcn_readfirstlane((int)threadIdx.x >> 6);
    const int G = gridDim.x; const int vcu = (G % 8 == 0) ? ((int)blockIdx.x % 8) * (G / 8) + (int)blockIdx.x / 8 : (int)blockIdx.x;
    DERIVE_PTRS(args.ws, args.out)
    for (int u = fresh_tid(wave_s); u < (LDS_BYTES - LDSCTL_OFF) / 4; u += NWAVES * 64) ((LAS unsigned*)(lds + LDSCTL_OFF))[u] = 0u;
    __syncthreads();
    XcdBarrier bar = xcd_barrier_post((unsigned*)(ctl + CW_BAR), MISC + 8);
    const int NGW = G * NWAVES;
    const unsigned lds0 = (unsigned)(size_t)lds;

#ifndef REP_P0
#define REP_P0 1
#endif
    for (int rep_ = 0; rep_ < REP_P0; ++rep_) { PH_IDS
        LAS float* scr = (LAS float*)(lds + RING_OFF + wave * 16384);
        constexpr int I_F = 5632, I_IN = 6144, I_OUT = 2048, NITEMS = 12 * I_F + 2 * I_IN + 2 * I_OUT;
        for (int it = gw; it < NITEMS; it += NGW) {
            int r = it;
            if (r < 12 * I_F) { const int mtx = r / I_F, k3 = mtx % 3, li = mtx / 3; r -= mtx * I_F;
                if (k3 == 0) p0_transpose_item(args.in[8] + (size_t)li * DM * DFF, DM, DFF, WGU + (size_t)li * 2 * DFF * DM, 1, scr, r, lane);
                else if (k3 == 1) p0_transpose_item(args.in[9] + (size_t)li * DM * DFF, DM, DFF, WGU + (size_t)li * 2 * DFF * DM, 2, scr, r, lane);
                else p0_transpose_item(args.in[10] + (size_t)li * DFF * DM, DFF, DM, WD + (size_t)li * DM * HP, 0, scr, r, lane, HP);
                continue; }
            r -= 12 * I_F;
            if (r < 2 * I_IN) { const int li = r / I_IN; r -= li * I_IN; p0_transpose_item(args.in[11] + (size_t)li * DM * DIN, DM, DIN, WIN + (size_t)li * DIN * DM, 3, scr, r, lane); continue; }
            r -= 2 * I_IN;
            { const int li = r / I_OUT; r -= li * I_OUT; p0_transpose_item(args.in[12] + (size_t)li * DM * DM, DM, DM, WOUT + (size_t)li * DM * DM, 0, scr, r, lane); }
        }
        for (int m = gw; m < M; m += NGW) {
            const float* src = m < MP ? args.in[0] + (size_t)m * DM : args.in[1] + (size_t)(m - MP) * DM;
            const GAS f32x4* xr = (const GAS f32x4*)src + lane; GAS v2u* o8 = (GAS v2u*)(XB + (size_t)m * DM) + lane;
            f32x4 v8[8];
#pragma unroll
            for (int j = 0; j < 8; ++j) v8[j] = xr[64 * j];
            __builtin_amdgcn_sched_barrier(0);
#pragma unroll
            for (int j = 0; j < 8; ++j) { v2u w; w.x = pk2(v8[j].x, v8[j].y); w.y = pk2(v8[j].z, v8[j].w); o8[64 * j] = w; }
        }
        for (int r = gw; r < 65536; r += NGW) {
            const int which = r >> 15, rr = r & 32767, lb = rr >> 11, t = rr & 2047;
            const GAS f32x4* xr = (const GAS f32x4*)(args.in[3 + which] + (size_t)rr * 1024) + lane;
            GAS v2u* o8 = (GAS v2u*)((which ? VS : KS) + ((size_t)lb * 2112 + t) * 1024) + lane;
            f32x4 v4[4];
#pragma unroll
            for (int j = 0; j < 4; ++j) v4[j] = xr[64 * j];
            __builtin_amdgcn_sched_barrier(0);
#pragma unroll
            for (int j = 0; j < 4; ++j) { v2u w; w.x = pk2(v4[j].x, v4[j].y); w.y = pk2(v4[j].z, v4[j].w); o8[64 * j] = w; }
        }
        for (int i = vcu * 512 + tid; i < 16384 * 64; i += G * 512) {
            const int pos = i >> 6, k = i & 63;
            const float p = (float)exp2((double)k * (13.287712379549449 / 64.0)); const float inv = 1.0f / p; const float ang = (float)pos * inv;
            const double a = (double)ang; const double n = rint(a * 0.15915494309189535); const float red = (float)(a - n * 6.283185307179586);
            CS[2 * (size_t)i] = cosf(red); CS[2 * (size_t)i + 1] = sinf(red);
        }
        if (blockIdx.x == 0) {
            const float* rb = args.in[19];
            for (int i = tid; i < 8 * 320; i += 512) { const int h = i / 320, rel = (i % 320) - 255, n = rel < 0 ? -rel : rel;
                int bk = n < 8 ? n : 8 + (n >= 12) + (n >= 16) + (n >= 23) + (n >= 32) + (n >= 46) + (n >= 64) + (n >= 91);
                bk += rel > 0 ? 16 : 0;
                TAB[i] = (rb[bk * 8 + h] - rb[15 * 8 + h]) * 1.4426950408889634f; }
            if (tid < 2) { const float* lf = args.in[17] + tid * 256; float a = 0.f, c = 0.f;
                for (int i = 0; i < 64; ++i) { a += lf[i] * lf[64 + i]; c += lf[128 + i] * lf[192 + i]; }
                TAB[2560 + tid] = expf(a) - expf(c) + (tid == 0 ? 0.2f : 0.35550906759096934f); TAB[2562 + tid] = tid == 0 ? 0.8f : 0.64449093240903066f; }
        }
    }
    xcd_barrier(bar, fresh_tid(wave_s));

    for (int it = 0; it < 4; ++it) {
        const int l = it >> 1, j = it & 1;
        size_t zoff; asm volatile("s_mov_b64 %0, 0" : "=s"(zoff));
        unsigned char* ws_l = args.ws + zoff; float* out_l = args.out + zoff;
        DERIVE_PTRS(ws_l, out_l)
        if (it > 0) { PH_IDS SPLIT_IDS(2 * (2 * DFF / 256))
            if (gemm_cu_) { const pg8::Gemm g = pg8::gemm_rowmajor(XB, WGU + (size_t)it * 2 * DFF * DM, M, 2 * DFF, DM, DM); pg8::PanelOrder S; S.init(MP / 256, MS / 256, 2 * DFF, NP_, pidx_, DM);
                pg8::EpiGU E{HB, HP, H_TILED};
                pg8::gemm_phase<pg8::EpiGU, pg8::PanelOrder, true, true>(lds + RING_OFF, g, S, E, fresh_tid(wave_s)); }
            else { const int pi = j == 0 ? (l - 1) * 3 + 2 : l * 3 + 1; const float* gp = args.in[6] + (size_t)pi * DM; const float* bp = args.in[7] + (size_t)pi * DM;
                ln_pass(XB, (float*)nullptr, gp, bp, lane, lnidx_ * NWAVES + wave, NL_ * NWAVES, SLAB, 0, ALPHA, 0.f, MP); }
        }
        if (it > 0) xcd_barrier(bar, fresh_tid(wave_s));
#ifndef REP_GU
#define REP_GU 1
#endif
        for (int rep_ = 0; rep_ < REP_GU; ++rep_)
        { const int Mg = it == 0 ? M : MP; const pg8::Gemm g = pg8::gemm_rowmajor(XB, WGU + (size_t)it * 2 * DFF * DM, Mg, 2 * DFF, DM, DM); pg8::StaticOrder S; S.init(Mg, 2 * DFF, G, (int)blockIdx.x, DM); S.wgm = GU_WGM;
          pg8::EpiGU E{HB, HP, H_TILED};
          pg8::gemm_phase<pg8::EpiGU, pg8::StaticOrder, true, true>(lds + RING_OFF, g, S, E, fresh_tid(wave_s)); }
        STOP_AT(2);
        xcd_barrier(bar, fresh_tid(wave_s));
#ifndef REP_DOWN
#define REP_DOWN 1
#endif
        for (int rep_ = 0; rep_ < REP_DOWN; ++rep_)
        { const pg8::Gemm g = H_TILED ? pg8::gemm_atiled(HB, WD + (size_t)it * DM * HP, M, DM, DFF, HP) : pg8::gemm_rowmajor(HB, WD + (size_t)it * DM * HP, M, DM, DFF, HP); pg8::TailSplitOrder S; S.init(MP, M, DM, G, (int)blockIdx.x, DFF, 11); S.rev = true;
          pg8::EpiResB E{XB, rep_ + 1 < REP_DOWN ? 1.0f : ALPHA, rep_ + 1 < REP_DOWN ? 0.0f : 0.5f, SLAB};
          pg8::gemm_phase<pg8::EpiResB, pg8::TailSplitOrder, true, true>(lds + RING_OFF, g, S, E, fresh_tid(wave_s)); }
        STOP_AT(3);
        xcd_barrier(bar, fresh_tid(wave_s));
        { PH_IDS const float* gp = args.in[6] + (size_t)(l * 3 + 2 * j) * DM; const float* bp = args.in[7] + (size_t)(l * 3 + 2 * j) * DM;
          if (it == 3) ln_pass(XB, out, gp, bp, lane, gw, NGW, SLAB, 11, ALPHA, 0.5f, M);
          else ln_sample<11>(lds + RING_OFF, XB, gp, bp, tid, vcu, G, SLAB, ALPHA, 0.5f); }
        if (it == 3) break;
        STOP_AT(4);
        xcd_barrier(bar, fresh_tid(wave_s));
        if (j == 0) {
            { PH_IDS SPLIT_IDS(2 * (DIN / 256))
              if (gemm_cu_) { const pg8::Gemm g = pg8::gemm_rowmajor(XB, WIN + (size_t)l * DIN * DM, M, DIN, DM, DM); pg8::PanelOrder S; S.init(MP / 256, MS / 256, DIN, NP_, pidx_, DM);
                  pg8::EpiIn E{l, out, U, Q, KB, KS, RQ, RV, CS};
                  pg8::gemm_phase<pg8::EpiIn, pg8::PanelOrder, true, true>(lds + RING_OFF, g, S, E, fresh_tid(wave_s)); }
              else { const float* gp = args.in[6] + (size_t)(l * 3) * DM; const float* bp = args.in[7] + (size_t)(l * 3) * DM;
                  ln_pass(XB, (float*)nullptr, gp, bp, lane, lnidx_ * NWAVES + wave, NL_ * NWAVES, SLAB, 0, ALPHA, 0.f, MP); }
            }
            xcd_barrier(bar, fresh_tid(wave_s));
#ifndef REP_IN
#define REP_IN 1
#endif
            for (int rep_ = 0; rep_ < REP_IN; ++rep_)
            { const pg8::Gemm g = pg8::gemm_rowmajor(XB, WIN + (size_t)l * DIN * DM, MP, DIN, DM, DM); pg8::StaticOrder S; S.init(MP, DIN, G, (int)blockIdx.x, DM);
              pg8::EpiIn E{l, out, U, Q, KB, KS, RQ, RV, CS};
              pg8::gemm_phase<pg8::EpiIn, pg8::StaticOrder, true, true>(lds + RING_OFF, g, S, E, fresh_tid(wave_s)); }
            STOP_AT(5);
            xcd_barrier(bar, fresh_tid(wave_s));
#ifndef REP_M1
#define REP_M1 1
#endif
            for (int rep_ = 0; rep_ < REP_M1; ++rep_) { PH_IDS
                const float* subg = args.in[18] + l * 128;
                float* scr = ASCR + (size_t)blockIdx.x * 32768;
#ifndef SKIP_ATTN
#define SKIP_ATTN 0
#endif
#ifndef SKIP_CONV
#define SKIP_CONV 0
#endif
#ifndef SKIP_RET
#define SKIP_RET 0
#endif
                if (!SKIP_ATTN) for (int p = vcu; p < 512; p += G) { const int bh = p >> 5, s = p & 31, b = bh >> 3, h = bh & 7;
                    for (int k = 0; k < 2; ++k) { const int qb = k == 0 ? 63 - s : s;
                        mx::attn_unit((mx::lds_ptr)lds, lds0, fresh_tid(wave_s), Q, KB + (size_t)b * 16384 * 1024, VB + (size_t)b * 16384 * 1024, b * 16384 + 256 * qb, 256 * qb, 4 * qb + 4, 8, h, TAB, l, subg, scr, MIXB); } }
                for (;;) {
                    __syncthreads(); if (tid == 0) MISC[0] = __hip_atomic_fetch_add(ctl + CW_Q + 64 * l, 1u, RLX_AGENT); __syncthreads();
                    const int item = (int)MISC[0];
                    if (item >= 64 + 544 + 1040) break;
                    if (item < 64) { const int b = item >> 3, h = item & 7; const size_t so = (size_t)((l * 8 + b) * 2112) * 1024;
                        mx::attn_unit((mx::lds_ptr)lds, lds0, fresh_tid(wave_s), Q, KS + so, VS + so, MP + 64 * b, 2048, 33, 2, h, TAB, l, subg, scr, MIXB); }
                    else if (item < 608) { const int u = item - 64; int row0, h, nt;
                        if (u < 512) { row0 = (u >> 8) * 16384 + ((u >> 2) & 63) * 256; h = u & 3; nt = 4; } else { const int s = u - 512; row0 = MP + (s >> 2) * 64; h = s & 3; nt = 1; }
                        mx::ret_kv_unit((mx::lds_ptr)lds, lds0, fresh_tid(wave_s), RK + (size_t)row0 * 512 + h * 128, RV + (size_t)row0 * 512 + h * 128, nt, KVT + (size_t)u * 16384); }
                    else if (!SKIP_CONV) conv_item(lds, fresh_tid(wave_s), item - 608, l, U, args.in[2], args.in[13], args.in[14], args.in[15], args.in[16], MIXB);
                }
            }
            STOP_AT(6);
            xcd_barrier(bar, fresh_tid(wave_s));
#ifndef REP_M23
#define REP_M23 1
#endif
            for (int rep23_ = 0; rep23_ < REP_M23; ++rep23_) {
            { PH_IDS
            for (int i = vcu; i < 256 + 1024; i += G) {
                const bool pr = i < 256; const int jj = pr ? i : i - 256, chain = jj >> 5, slab = jj & 31, idx = slab * 512 + tid, b = chain >> 2, h = chain & 3;
                const int e = idx >> 7, d = idx & 127, dnat = (d >> 1) + 64 * (d & 1);
                const float lg = h == 0 ? -0.04580368961312479f : h == 1 ? -0.02272007650008353f : h == 2 ? -0.011315313227834146f : -0.005646563141142063f;
                if (pr) { const float gL = __builtin_amdgcn_exp2f(256.f * lg); float S = 0.f;
                    for (int n0 = 0; n0 < 64; n0 += 8) { float kv8[8];
#pragma unroll
                        for (int j = 0; j < 8; ++j) kv8[j] = KVT[(size_t)((b * 64 + n0 + j) * 4 + h) * 16384 + idx];
                        __builtin_amdgcn_sched_barrier(0);
#pragma unroll
                        for (int j = 0; j < 8; ++j) { const size_t uo = (size_t)((b * 64 + n0 + j) * 4 + h) * 16384 + idx; SP[uo] = (bf16)(pk2(S, 0.f) & 0xffffu); S = gL * (S + kv8[j]); } }
                    out[pg8::O_RETP + ((size_t)((l * 2 + b) * 4 + h) * 128 + dnat) * 128 + e] = S; }
                else { const float gL = __builtin_amdgcn_exp2f(64.f * lg); const size_t uo = (size_t)(512 + b * 4 + h) * 16384 + idx; const size_t so = ((size_t)((l * 8 + b) * 4 + h) * 128 + dnat) * 128 + e;
                    const float S0 = args.in[5][so]; SP[uo] = (bf16)(pk2(S0, 0.f) & 0xffffu); out[pg8::O_RETS + so] = gL * (S0 + KVT[uo]); }
            } }
#ifdef DUMP_KVT
            xcd_barrier(bar, fresh_tid(wave_s));
            for (size_t i = (size_t)blockIdx.x * 512 + fresh_tid(wave_s); i < (size_t)544 * 16384; i += (size_t)G * 512) { out[pg8::O_KP + i] = KVT[i]; out[pg8::O_VP + i] = __uint_as_float((unsigned)SP[i] << 16); }
#endif
            STOP_AT(7);
            xcd_barrier(bar, fresh_tid(wave_s));
            { PH_IDS
            if (!SKIP_RET) for (int u = vcu; u < 544; u += G) { int row0, h, nt, na;
                if (u < 512) { row0 = (u >> 8) * 16384 + ((u >> 2) & 63) * 256; h = u & 3; nt = 4; na = 8; } else { const int s = u - 512; row0 = MP + (s >> 2) * 64; h = s & 3; nt = 1; na = 2; }
                const size_t ro = (size_t)row0 * 512 + h * 128;
                mx::ret_out_unit((mx::lds_ptr)lds, lds0, fresh_tid(wave_s), RQ + ro, RK + ro, RV + ro, RG + ro, SP + (size_t)u * 16384, nt, na, MIXB + (size_t)row0 * 2048 + 1536 + h * 128); } }
#ifdef DUMP_MIX
            xcd_barrier(bar, fresh_tid(wave_s));
            for (size_t i = (size_t)blockIdx.x * 512 + fresh_tid(wave_s); i < (size_t)M * 2048; i += (size_t)G * 512) out[pg8::O_KP + i] = __uint_as_float((unsigned)MIXB[i] << 16);
#endif
            STOP_AT(8);
            xcd_barrier(bar, fresh_tid(wave_s));
            }
            { const pg8::Gemm g = pg8::gemm_rowmajor(MIXB, WOUT + (size_t)l * DM * DM, M, DM, DM, DM); pg8::TailSplitOrder S; S.init(MP, M, DM, G, (int)blockIdx.x, DM, 4);
              pg8::EpiResB E{XB, ALPHA, 1.0f, SLAB};
              pg8::gemm_phase<pg8::EpiResB, pg8::TailSplitOrder, true, true>(lds + RING_OFF, g, S, E, fresh_tid(wave_s)); }
            STOP_AT(9);
            xcd_barrier(bar, fresh_tid(wave_s));
            { PH_IDS const float* gp = args.in[6] + (size_t)(l * 3 + 1) * DM; const float* bp = args.in[7] + (size_t)(l * 3 + 1) * DM;
              ln_sample<4>(lds + RING_OFF, XB, gp, bp, tid, vcu, G, SLAB, ALPHA, 1.0f); }
            xcd_barrier(bar, fresh_tid(wave_s));
        }
    }
}

extern "C" void kernel_launch(void* const* d_in, const int* in_sizes, int n_in, void* d_out, int out_size, void* d_ws, size_t ws_size, hipStream_t stream) {
    static int grid = 0;
    if (grid == 0) {
        if (n_in != 20 || in_sizes[0] != MP * DM || (size_t)out_size != pg8::O_END || ws_size < WS_END) {
            fprintf(stderr, "kernel_launch: unexpected problem sizes (n_in %d, in0 %d, out %d, ws %zu; need ws >= %zu); nothing launched\n", n_in, n_in > 0 ? in_sizes[0] : -1, out_size, ws_size, (size_t)WS_END); grid = -1; return; }
        int dev = 0, cus = 0;
        if (hipGetDevice(&dev) != hipSuccess || hipDeviceGetAttribute(&cus, hipDeviceAttributeMultiprocessorCount, dev) != hipSuccess) { grid = -1; return; }
        if (hipFuncSetAttribute((const void*)mk_fwd, hipFuncAttributeMaxDynamicSharedMemorySize, LDS_BYTES) != hipSuccess) { fprintf(stderr, "kernel_launch: hipFuncSetAttribute failed\n"); grid = -1; return; }
        int per_cu = 0;
        if (hipOccupancyMaxActiveBlocksPerMultiprocessor(&per_cu, (const void*)mk_fwd, NWAVES * 64, LDS_BYTES) != hipSuccess || per_cu < 1) fprintf(stderr, "kernel_launch: occupancy query reports %d\n", per_cu);
        (void)hipGetLastError();
        grid = cus;
    }
    if (grid < 0) return;
    if (hipMemsetAsync((char*)d_ws + WS_CTL, 0, CTL_ZERO_BYTES, stream) != hipSuccess) return;
    Args a{};
    for (int i = 0; i < 20; ++i) a.in[i] = (const float*)d_in[i];
    a.out = (float*)d_out; a.ws = (unsigned char*)d_ws;
    hipLaunchKernelGGL(mk_fwd, dim3(grid), dim3(NWAVES * 64), LDS_BYTES, stream, a);
}
```

```cpp
#include <hip/hip_runtime.h>
#include <cstdio>
#include <cstdint>
namespace pg8 {
#define PG8_LAS __attribute__((address_space(3)))
typedef unsigned short bf16_t;
typedef short bf16x8 __attribute__((ext_vector_type(8)));
typedef float f32x4 __attribute__((ext_vector_type(4)));
typedef unsigned u32x4 __attribute__((ext_vector_type(4)));
constexpr int BM = 256, BK = 64, HALF = 128, HTB = HALF * BK * 2  , STAGE_BYTES = 8 * HTB, NXCD = 8, WGM = 4;

__host__ __device__ __forceinline__ int lds_byte(int r, int c) { const int st = (r >> 4) * 2 + (c >> 5), rr = r & 15, cc = c & 31, ob = rr * 64 + cc * 2; return st * 1024 + (ob ^ (((ob >> 9) & 1) << 5)); }
__host__ __device__ __forceinline__ void stage_rc(int b, int& R, int& C) { const int st = b / 1024, sb = b % 1024, swz = sb ^ (((sb >> 9) & 1) << 5); R = (st >> 1) * 16 + swz / 64; C = (st & 1) * 32 + (swz % 64) / 2; }
__host__ __device__ __forceinline__ int perm32(int rho) { const int n = rho >> 4, i = rho & 15; return 8 * (i >> 2) + 4 * n + (i & 3); }

struct Unit { int pm, pn, k0, nt, ks; };
struct Gemm { const bf16_t* A; const bf16_t* Bt; int M, N, K, lda, ldb; size_t ksA, ksB, tsA, tsB; };
__host__ __device__ inline Gemm gemm_rowmajor(const bf16_t* A, const bf16_t* Bt, int M, int N, int K, int ld) { return Gemm{A, Bt, M, N, K, ld, ld, (size_t)BK * 2, (size_t)BK * 2, (size_t)BM * ld * 2, (size_t)BM * ld * 2}; }
__host__ __device__ inline Gemm gemm_atiled(const bf16_t* A, const bf16_t* Bt, int M, int N, int K, int ldb) { return Gemm{A, Bt, M, N, K, BK, ldb, (size_t)BM * BK * 2, (size_t)BK * 2, (size_t)(K / BK) * BM * BK * 2, (size_t)BM * ldb * 2}; }

struct StaticOrder {
    int nM, nN, nwg, G, c, ntf, wgm;
    __host__ __device__ void init(int M, int N, int G_, int c_, int K_) { nM = M / BM; nN = N / BM; nwg = nM * nN; G = G_; c = c_; ntf = K_ / BK; wgm = WGM; }
    __host__ __device__ bool next(int i, Unit& u) const {
        const long L = (long)i * G + c; if (L >= nwg) return false;
        int wgid = (int)L; { const int q = nwg / NXCD, r = nwg % NXCD, xcd = wgid % NXCD, off = wgid / NXCD; wgid = (xcd < r ? xcd * (q + 1) : r * (q + 1) + (xcd - r) * q) + off; }
        const int nig = wgm * nN, gid = wgid / nig, fm = gid * wgm, gsz = (nM - fm) < wgm ? (nM - fm) : wgm;
        u.pm = fm + ((wgid % nig) % gsz); u.pn = (wgid % nig) / gsz; u.k0 = 0; u.nt = ntf; u.ks = 0; return true;
    }
    __device__ __forceinline__ void a_ready(const Unit&) const {}
    __device__ __forceinline__ void done(const Unit&) const {}
};

struct TailSplitOrder {
    StaticOrder P; int nwp, nN, nsplit, ntp, ntot, G, c, mp; bool rev;
    __host__ __device__ void init(int Mp, int Mall, int N, int G_, int c_, int K_, int nsplit_) { P.init(Mp, N, G_, c_, K_); nwp = P.nwg; nN = N / BM; nsplit = nsplit_; ntp = K_ / BK / nsplit_; mp = Mp / BM;
        ntot = nwp + ((Mall - Mp) / BM) * nN * nsplit_; G = G_; c = c_; rev = false; }
    __host__ __device__ bool next(int i, Unit& u) const {
        const long L = (long)i * G + c; if (L >= ntot) return false;
        int pm, pn, k0 = 0, nt = P.ntf, ks = 0;
        if (L < nwp) {
            int wgid = (int)L; { const int q = P.nwg / NXCD, r = P.nwg % NXCD, xcd = wgid % NXCD, off = wgid / NXCD; wgid = (xcd < r ? xcd * (q + 1) : r * (q + 1) + (xcd - r) * q) + off; }
            const int nig = P.wgm * P.nN, gid = wgid / nig, fm = gid * P.wgm, gsz = (P.nM - fm) < P.wgm ? (P.nM - fm) : P.wgm;
            pm = fm + ((wgid % nig) % gsz); pn = (wgid % nig) / gsz;
            if (rev) pm = P.nM - 1 - pm;
        } else {
            const int s = (int)(L - nwp), rest = s / nsplit; ks = s % nsplit;
            pn = rest % nN; pm = mp + rest / nN; nt = ntp; k0 = ks * ntp;
        }
        u.pm = pm; u.pn = pn; u.k0 = k0; u.nt = nt; u.ks = ks; return true;
    }
    __device__ __forceinline__ void a_ready(const Unit&) const {}
    __device__ __forceinline__ void done(const Unit&) const {}
};

struct PanelOrder {
    int pm0, np, ntot, NP, c, ntf;
    __host__ __device__ void init(int pm0_, int np_, int N, int NP_, int c_, int K_) { pm0 = pm0_; np = np_; ntot = np_ * (N / BM); NP = NP_; c = c_; ntf = K_ / BK; }
    __host__ __device__ bool next(int i, Unit& u) const {
        const int L = i * NP + c; if (L >= ntot) return false;
        const int pm = pm0 + L % np, pn = L / np;
        u.pm = pm; u.pn = pn; u.k0 = 0; u.nt = ntf; u.ks = 0; return true;
    }
    __device__ __forceinline__ void a_ready(const Unit&) const {}
    __device__ __forceinline__ void done(const Unit&) const {}
};

typedef float f32x2c_t __attribute__((ext_vector_type(2))); typedef __bf16 bf16x2c_t __attribute__((ext_vector_type(2)));
__device__ __forceinline__ unsigned cvt_pk_bf16(float lo, float hi) { f32x2c_t v = {lo, hi}; bf16x2c_t b = __builtin_convertvector(v, bf16x2c_t); return __builtin_bit_cast(unsigned, b); }
typedef float f32x2 __attribute__((ext_vector_type(2)));
constexpr size_t O_Y = 0, O_CONVP = 68157440, O_KP = 68218880, O_VP = 135327744, O_RETP = 202436608, O_CONVS = 202698752, O_KS = 202944512, O_VS = 203993088, O_RETS = 205041664, O_END = 206090240;
__device__ __forceinline__ float sigm(float x) { return __builtin_amdgcn_rcpf(1.0f + __builtin_amdgcn_exp2f(-1.4426950408889634f * x)); }
__device__ __forceinline__ void st8(bf16_t* p, const float (&v)[8]) { u32x4 w; w.x = cvt_pk_bf16(v[0], v[1]); w.y = cvt_pk_bf16(v[2], v[3]); w.z = cvt_pk_bf16(v[4], v[5]); w.w = cvt_pk_bf16(v[6], v[7]); *(u32x4*)p = w; }

struct EpiGU {
    static constexpr bool PERM = true, AFTER_DRAIN = false;
    bf16_t* H; int ldh; int tiled;
    __device__ __forceinline__ void operator()(const f32x4 (&acc)[2][2][4][2], const Unit& u, int wr, int wc, int fr, int fq) const {
        const int row0 = u.pm * BM + wr * 64 + fr, col0 = u.pn * 128 + wc * 32 + 8 * fq;
#pragma unroll
        for (int ai = 0; ai < 2; ++ai)
#pragma unroll
            for (int m = 0; m < 4; ++m) {
                float h[8];
#pragma unroll
                for (int n = 0; n < 2; ++n)
#pragma unroll
                    for (int j = 0; j < 4; ++j) { const float g = acc[ai][0][m][n][j], uu = acc[ai][1][m][n][j]; h[n * 4 + j] = g * sigm(g) * uu; }
                { const int row = row0 + ai * HALF + m * 16; st8(tiled ? H + ((size_t)((row >> 8) * (5632 / 64) + (col0 >> 6)) * 256 + (row & 255)) * 64 + (col0 & 63) : H + (size_t)row * ldh + col0, h); }
            }
    }
};
struct EpiRes {
    static constexpr bool PERM = false, AFTER_DRAIN = false;
    float* X; float alpha, scale;
    __device__ __forceinline__ void operator()(const f32x4 (&acc)[2][2][4][2], const Unit& u, int wr, int wc, int fr, int fq) const {
        const int row0 = u.pm * BM + wr * 64 + fr, col0 = u.pn * BM + wc * 32 + 4 * fq;
#pragma unroll
        for (int ai = 0; ai < 2; ++ai)
#pragma unroll
            for (int m = 0; m < 4; ++m) { float* rp = X + (size_t)(row0 + ai * HALF + m * 16) * 2048 + col0;
#pragma unroll
                for (int bj = 0; bj < 2; ++bj)
#pragma unroll
                    for (int n = 0; n < 2; ++n) { f32x4* q = (f32x4*)(rp + bj * HALF + n * 16); const f32x4 v = *q; *q = v * alpha + acc[ai][bj][m][n] * scale; } }
    }
};
struct EpiResB {
    static constexpr bool PERM = true, AFTER_DRAIN = false;
    bf16_t* XBp; float alpha, scale; float* slab;
    __device__ __forceinline__ void operator()(const f32x4 (&acc)[2][2][4][2], const Unit& u, int wr, int wc, int fr, int fq) const {
        const int row0 = u.pm * BM + wr * 64 + fr, col0 = u.pn * BM + wc * 32 + 8 * fq;
        if (u.pm >= 128) {
#pragma unroll
            for (int ai = 0; ai < 2; ++ai)
#pragma unroll
                for (int m = 0; m < 4; ++m) { float* rp = slab + ((size_t)u.ks * 512 + (row0 - 32768 + ai * HALF + m * 16)) * 2048 + col0;
#pragma unroll
                    for (int bj = 0; bj < 2; ++bj) { *(f32x4*)(rp + bj * HALF) = acc[ai][bj][m][0]; *(f32x4*)(rp + bj * HALF + 4) = acc[ai][bj][m][1]; } }
            return;
        }
        u32x4 res[2][4][2];
#pragma unroll
        for (int ai = 0; ai < 2; ++ai)
#pragma unroll
            for (int m = 0; m < 4; ++m)
#pragma unroll
                for (int bj = 0; bj < 2; ++bj) res[ai][m][bj] = *(const u32x4*)(XBp + (size_t)(row0 + ai * HALF + m * 16) * 2048 + col0 + bj * HALF);
        __builtin_amdgcn_sched_barrier(0);
#pragma unroll
        for (int ai = 0; ai < 2; ++ai)
#pragma unroll
            for (int m = 0; m < 4; ++m) { bf16_t* rp = XBp + (size_t)(row0 + ai * HALF + m * 16) * 2048 + col0;
#pragma unroll
                for (int bj = 0; bj < 2; ++bj) { const u32x4 w = res[ai][m][bj]; float y[8];
#pragma unroll
                    for (int n = 0; n < 2; ++n)
#pragma unroll
                        for (int j = 0; j < 4; ++j) { const unsigned ww = w[n * 2 + (j >> 1)]; const float x = __uint_as_float((j & 1) ? (ww & 0xffff0000u) : (ww << 16)); y[n * 4 + j] = x * alpha + acc[ai][bj][m][n][j] * scale; }
                    st8(rp + bj * HALF, y); } }
    }
};
struct EpiIn {
    static constexpr bool PERM = true, AFTER_DRAIN = false;
    int layer; float* out; bf16_t *U, *Q, *KB, *KS, *RQ, *RV; const float* cs;
    static constexpr size_t D_KV = 64u * 1024u * 1024u / 2u * 2u / 2u, D_S = 66u * 1024u * 1024u / 2u, D_R = 34078720u / 2u;
    __device__ __forceinline__ void operator()(const f32x4 (&acc)[2][2][4][2], const Unit& u, int wr, int wc, int fr, int fq) const {
        const int pn = u.pn, pm = u.pm; const bool smp = pm >= 128; const int cb = wc * 32 + 8 * fq;
        const int rbase = pm * BM + wr * 64 + fr;
#define ROWVARS const int row = rbase + ai * HALF + m * 16; int b, t; if (!smp) { b = row >> 14; t = row & 16383; } else { const int r2 = row - 32768; b = r2 >> 6; t = r2 & 63; }
        if (pn < 4) {
#pragma unroll
            for (int ai = 0; ai < 2; ++ai)
#pragma unroll
                for (int m = 0; m < 4; ++m) { ROWVARS
                    float v[8];
#pragma unroll
                    for (int n = 0; n < 2; ++n)
#pragma unroll
                        for (int j = 0; j < 4; ++j) v[n * 4 + j] = acc[ai][0][m][n][j] * sigm(acc[ai][1][m][n][j]);
                    st8(U + (size_t)row * 512 + pn * 128 + cb, v);
                    int jr; float* cp;
                    if (!smp) { jr = t - (16384 - 30); cp = out + O_CONVP + (size_t)((layer * 2 + b) * 30 + jr) * 512; }
                    else { jr = t - 34; cp = out + O_CONVS + (size_t)((layer * 8 + b) * 30 + jr) * 512; }
                    if (jr >= 0) { cp += pn * 128 + cb; *(f32x4*)cp = (f32x4){v[0], v[1], v[2], v[3]}; *(f32x4*)(cp + 4) = (f32x4){v[4], v[5], v[6], v[7]}; }
                }
        } else if (pn < 8) {
#pragma unroll
            for (int ai = 0; ai < 2; ++ai)
#pragma unroll
                for (int m = 0; m < 4; ++m) { const int row = rbase + ai * HALF + m * 16;
#pragma unroll
                    for (int bj = 0; bj < 2; ++bj) { float v[8];
#pragma unroll
                        for (int n = 0; n < 2; ++n)
#pragma unroll
                            for (int j = 0; j < 4; ++j) v[n * 4 + j] = acc[ai][bj][m][n][j] * 0.18033688011112042f;
                        st8(Q + (size_t)row * 1024 + (pn - 4) * 256 + bj * HALF + cb, v); } }
        } else if (pn < 16) {
            const bool isk = pn < 12; const int cq = ((pn - 8) & 3) * 256 + cb;
#pragma unroll
            for (int ai = 0; ai < 2; ++ai)
#pragma unroll
                for (int m = 0; m < 4; ++m) { ROWVARS
                    float* op; bf16_t* bp;
                    if (!smp) { op = out + O_KP + (isk ? (size_t)0 : O_VP - O_KP) + ((size_t)layer * 32768 + row) * 1024; bp = KB + (isk ? (size_t)0 : D_KV) + (size_t)row * 1024; }
                    else { op = out + O_KS + (isk ? (size_t)0 : O_VS - O_KS) + ((size_t)layer * 512 + (row - 32768)) * 1024; bp = KS + (isk ? (size_t)0 : D_S) + ((size_t)((layer * 8 + b) * 2112 + 2048 + t)) * 1024; }
#pragma unroll
                    for (int bj = 0; bj < 2; ++bj) { float v[8];
#pragma unroll
                        for (int n = 0; n < 2; ++n)
#pragma unroll
                            for (int j = 0; j < 4; ++j) v[n * 4 + j] = acc[ai][bj][m][n][j];
                        float* o2 = op + cq + bj * HALF; __builtin_nontemporal_store(acc[ai][bj][m][0], (f32x4*)o2); __builtin_nontemporal_store(acc[ai][bj][m][1], (f32x4*)(o2 + 4));
                        st8(bp + cq + bj * HALF, v); } }
        } else if (pn < 20) {
            const bool isq = pn < 18; const int hb = ((pn - 16) & 1) * 2;
#pragma unroll
            for (int ai = 0; ai < 2; ++ai) {
            f32x4 cc01[4], cc23[4];
#pragma unroll
                for (int m = 0; m < 4; ++m) { ROWVARS (void)b;
                    const int pos = smp ? 2048 + t : t; const float* c = cs + ((size_t)pos * 64 + (cb >> 1)) * 2;
                    cc01[m] = *(const f32x4*)c; cc23[m] = *(const f32x4*)(c + 4); }
            __builtin_amdgcn_sched_barrier(0);
#pragma unroll
                for (int m = 0; m < 4; ++m) { ROWVARS (void)b;
                    const int il = smp ? t : (row & 255);
                    const f32x4 c01 = cc01[m], c23 = cc23[m];
#pragma unroll
                    for (int bj = 0; bj < 2; ++bj) { const int head = hb + bj;
                        const float lg = head == 0 ? -0.04580368961312479f : head == 1 ? -0.02272007650008353f : head == 2 ? -0.011315313227834146f : -0.005646563141142063f;
                        const float e = (float)(il + 1) * lg; const float sc = isq ? __builtin_amdgcn_exp2f(e) : 0.08838834764831845f * __builtin_amdgcn_exp2f(-e);
                        const f32x4 x = acc[ai][bj][m][0], y = acc[ai][bj][m][1]; float v[8];
                        v[0] = (x[0] * c01[0] - x[1] * c01[1]) * sc; v[1] = (x[0] * c01[1] + x[1] * c01[0]) * sc;
                        v[2] = (x[2] * c01[2] - x[3] * c01[3]) * sc; v[3] = (x[2] * c01[3] + x[3] * c01[2]) * sc;
                        v[4] = (y[0] * c23[0] - y[1] * c23[1]) * sc; v[5] = (y[0] * c23[1] + y[1] * c23[0]) * sc;
                        v[6] = (y[2] * c23[2] - y[3] * c23[3]) * sc; v[7] = (y[2] * c23[3] + y[3] * c23[2]) * sc;
                        st8(RQ + (isq ? (size_t)0 : D_R) + (size_t)row * 512 + head * 128 + cb, v); } } }
        } else {
            const bool isv = pn < 22; const int cq = ((pn - 20) & 1) * 256 + cb;
#pragma unroll
            for (int ai = 0; ai < 2; ++ai)
#pragma unroll
                for (int m = 0; m < 4; ++m) { const int row = rbase + ai * HALF + m * 16;
#pragma unroll
                    for (int bj = 0; bj < 2; ++bj) { float v[8];
#pragma unroll
                        for (int n = 0; n < 2; ++n)
#pragma unroll
                            for (int j = 0; j < 4; ++j) { const float x = acc[ai][bj][m][n][j]; v[n * 4 + j] = isv ? x : x * sigm(x); }
                        st8(RV + (isv ? (size_t)0 : D_R) + (size_t)row * 512 + cq + bj * HALF, v); } }
        }
#undef ROWVARS
    }
};
template <class Epi, class Sched, bool ALIGN_EPI = false, bool SP2 = false>
__device__ __forceinline__ void gemm_phase(PG8_LAS unsigned char* lds, const Gemm g, const Sched& S, const Epi& E, int tid0) {
    int tid_ = tid0; asm volatile("" : "+v"(tid_));
    const int tid = tid_, wid = __builtin_amdgcn_readfirstlane(tid >> 6), lane = tid & 63, wr = wid >> 2, wc = wid & 3, fr = lane & 15, fq = lane >> 4;
    const int lda = g.lda, ldb = g.ldb;
    unsigned voffA[2], voffB[2];
#pragma unroll
    for (int i = 0; i < 2; ++i) { int R, C; stage_rc(tid * 16 + i * 8192, R, C); const int Rb = Epi::PERM ? ((R & ~31) + perm32(R & 31)) : R;
        voffA[i] = (unsigned)(R * lda + C) * 2u; voffB[i] = (unsigned)(Rb * ldb + C) * 2u; }
    const size_t ksA = g.ksA, ksB = g.ksB;
    const size_t hsA = (size_t)HALF * lda * 2, hsB = (size_t)HALF * ldb * 2;
    const size_t tsA = g.tsA, tsB = g.tsB;
    const unsigned ldsw = (unsigned)wid * 1024u;
    const int aoff = lds_byte(wr * 64 + fr, fq * 8), boff = lds_byte(wc * 32 + fr, fq * 8);
#define PG8_SA(b, h) (((b) * 2 + (h)) * HTB)
#define PG8_SB(b, h) ((4 + (b) * 2 + (h)) * HTB)
#define PG8_STAGE(bufoff, gbase, voff) do { _Pragma("unroll") for (int _i = 0; _i < 2; ++_i) \
        __builtin_amdgcn_global_load_lds((const unsigned*)((const char*)(gbase) + (voff)[_i]), (PG8_LAS unsigned*)(lds + (bufoff) + ldsw + _i * 8192), 16, 0, 0); } while (0)
#define PG8_LDA(dst, b, h) do { _Pragma("unroll") for (int m = 0; m < 4; ++m) _Pragma("unroll") for (int k = 0; k < 2; ++k) dst[m][k] = *(const PG8_LAS bf16x8*)(lds + PG8_SA(b, h) + aoff + m * 2048 + k * 1024); } while (0)
#define PG8_LDB(dst, b, h) do { _Pragma("unroll") for (int n = 0; n < 2; ++n) _Pragma("unroll") for (int k = 0; k < 2; ++k) dst[n][k] = *(const PG8_LAS bf16x8*)(lds + PG8_SB(b, h) + boff + n * 2048 + k * 1024); } while (0)
#define PG8_MMA(ai, bj, At, Bt) do { __builtin_amdgcn_s_setprio(1); _Pragma("unroll") for (int m = 0; m < 4; ++m) _Pragma("unroll") for (int n = 0; n < 2; ++n) _Pragma("unroll") for (int k = 0; k < 2; ++k) \
        acc[ai][bj][m][n] = __builtin_amdgcn_mfma_f32_16x16x32_bf16(Bt[n][k], At[m][k], acc[ai][bj][m][n], 0, 0, 0); __builtin_amdgcn_s_setprio(0); } while (0)
#define PG8_WAIT_V(n) asm volatile("s_waitcnt vmcnt(" #n ")" ::: "memory")
#define PG8_WAIT_L(n) asm volatile("s_waitcnt lgkmcnt(" #n ")" ::: "memory")
#define PG8_BAR __builtin_amdgcn_s_barrier()
#define PG8_SCHED __builtin_amdgcn_sched_barrier(0)
    Unit cur, nxt; int ui = 0;
    if (!S.next(0, cur)) return;
    f32x4 acc[2][2][4][2];
#pragma unroll
    for (int a = 0; a < 2; ++a)
#pragma unroll
        for (int b = 0; b < 2; ++b)
#pragma unroll
            for (int m = 0; m < 4; ++m)
#pragma unroll
                for (int n = 0; n < 2; ++n) acc[a][b][m][n] = (f32x4){0.f, 0.f, 0.f, 0.f};
    bf16x8 At[4][2], B0[2][2], B1[2][2];
    const char* cA = (const char*)g.A + (size_t)cur.pm * tsA + (size_t)cur.k0 * ksA; const char* cB = (const char*)g.Bt + (size_t)cur.pn * tsB + (size_t)cur.k0 * ksB;
    S.a_ready(cur);
    if constexpr (SP2) {
        PG8_STAGE(PG8_SB(0, 0), cB, voffB); PG8_STAGE(PG8_SB(0, 1), cB + hsB, voffB); PG8_STAGE(PG8_SA(0, 0), cA, voffA); PG8_STAGE(PG8_SA(0, 1), cA + hsA, voffA);
        if (wr == 1) PG8_BAR;
        PG8_WAIT_V(2); PG8_BAR;
        PG8_STAGE(PG8_SB(1, 0), cB + ksB, voffB); PG8_STAGE(PG8_SA(1, 0), cA + ksA, voffA); PG8_STAGE(PG8_SB(1, 1), cB + hsB + ksB, voffB);
        PG8_WAIT_V(6); PG8_BAR;
    } else {
        PG8_STAGE(PG8_SB(0, 0), cB, voffB); PG8_STAGE(PG8_SA(0, 0), cA, voffA); PG8_STAGE(PG8_SB(0, 1), cB + hsB, voffB); PG8_STAGE(PG8_SA(0, 1), cA + hsA, voffA);
        if (wr == 1) PG8_BAR;
        PG8_WAIT_V(4); PG8_BAR;
        PG8_STAGE(PG8_SB(1, 0), cB + ksB, voffB); PG8_STAGE(PG8_SA(1, 0), cA + ksA, voffA); PG8_STAGE(PG8_SB(1, 1), cB + hsB + ksB, voffB);
        PG8_WAIT_V(6); PG8_BAR;
    }
    for (;;) {
        const bool has_next = S.next(ui + 1, nxt);
        const char* nA = has_next ? (const char*)g.A + (size_t)nxt.pm * tsA + (size_t)nxt.k0 * ksA : cA; const char* nB = has_next ? (const char*)g.Bt + (size_t)nxt.pn * tsB + (size_t)nxt.k0 * ksB : cB;
        const int nt = cur.nt;
        for (int t = 0; t < nt; t += 2) {
            const bool last = (t == nt - 2);
            const char* a1 = cA + (size_t)(t + 1) * ksA;
            const char* a2 = last ? nA : cA + (size_t)(t + 2) * ksA; const char* b2 = last ? nB : cB + (size_t)(t + 2) * ksB;
            const char* a3 = a2 + ksA; const char* b3 = b2 + ksB;
            if (last && has_next) S.a_ready(nxt);
            if constexpr (SP2) {
            PG8_LDB(B0, 0, 0); PG8_LDB(B1, 0, 1); PG8_SCHED; PG8_LDA(At, 0, 0); PG8_STAGE(PG8_SA(1, 1), a1 + hsA, voffA);
            PG8_WAIT_V(8); PG8_WAIT_L(0); PG8_BAR; PG8_MMA(0, 0, At, B0); PG8_MMA(0, 1, At, B1); PG8_BAR; PG8_SCHED;
            PG8_LDA(At, 0, 1); PG8_STAGE(PG8_SB(0, 0), b2, voffB); PG8_STAGE(PG8_SB(0, 1), b2 + hsB, voffB); PG8_STAGE(PG8_SA(0, 0), a2, voffA);
            PG8_WAIT_V(8); PG8_WAIT_L(0); PG8_BAR; PG8_MMA(1, 0, At, B0); PG8_MMA(1, 1, At, B1); PG8_BAR; PG8_SCHED;
            PG8_LDB(B0, 1, 0); PG8_LDB(B1, 1, 1); PG8_SCHED; PG8_LDA(At, 1, 0); PG8_STAGE(PG8_SA(0, 1), a2 + hsA, voffA);
            PG8_WAIT_V(8); PG8_WAIT_L(0); PG8_BAR; PG8_MMA(0, 0, At, B0); PG8_MMA(0, 1, At, B1); PG8_BAR; PG8_SCHED;
            PG8_LDA(At, 1, 1); PG8_STAGE(PG8_SB(1, 0), b3, voffB); PG8_STAGE(PG8_SB(1, 1), b3 + hsB, voffB); PG8_STAGE(PG8_SA(1, 0), a3, voffA);
            PG8_WAIT_V(8); PG8_WAIT_L(0); PG8_BAR; PG8_MMA(1, 0, At, B0); PG8_MMA(1, 1, At, B1); PG8_BAR; PG8_SCHED;
            } else {
            PG8_LDB(B0, 0, 0); PG8_SCHED; PG8_LDA(At, 0, 0); PG8_STAGE(PG8_SA(1, 1), a1 + hsA, voffA);
            PG8_WAIT_L(8); PG8_BAR; PG8_WAIT_L(0); PG8_MMA(0, 0, At, B0); PG8_BAR; PG8_SCHED;
            PG8_LDB(B1, 0, 1); PG8_STAGE(PG8_SB(0, 0), b2, voffB);
            PG8_BAR; PG8_WAIT_L(0); PG8_MMA(0, 1, At, B1); PG8_BAR;
            PG8_LDA(At, 0, 1); PG8_STAGE(PG8_SA(0, 0), a2, voffA);
            PG8_BAR; PG8_WAIT_L(0); PG8_MMA(1, 0, At, B0); PG8_BAR; PG8_SCHED;
            PG8_STAGE(PG8_SB(0, 1), b2 + hsB, voffB);
            PG8_WAIT_V(6); PG8_BAR; PG8_MMA(1, 1, At, B1); PG8_BAR;
            PG8_LDB(B0, 1, 0); PG8_SCHED; PG8_LDA(At, 1, 0); PG8_STAGE(PG8_SA(0, 1), a2 + hsA, voffA);
            PG8_WAIT_L(8); PG8_BAR; PG8_WAIT_L(0); PG8_MMA(0, 0, At, B0); PG8_BAR; PG8_SCHED;
            PG8_LDB(B1, 1, 1); PG8_STAGE(PG8_SB(1, 0), b3, voffB);
            PG8_BAR; PG8_WAIT_L(0); PG8_MMA(0, 1, At, B1); PG8_BAR;
            PG8_LDA(At, 1, 1); PG8_STAGE(PG8_SA(1, 0), a3, voffA);
            PG8_BAR; PG8_WAIT_L(0); PG8_MMA(1, 0, At, B0); PG8_BAR; PG8_SCHED;
            PG8_STAGE(PG8_SB(1, 1), b3 + hsB, voffB);
            PG8_WAIT_V(6); PG8_BAR; PG8_MMA(1, 1, At, B1); PG8_BAR;
            }
        }
        if constexpr (ALIGN_EPI) { if (wr == 0) PG8_BAR; }
        if constexpr (!Epi::AFTER_DRAIN) { E(acc, cur, wr, wc, fr, fq); S.done(cur); }
        if (!has_next) break;
#pragma unroll
        for (int a = 0; a < 2; ++a)
#pragma unroll
            for (int b = 0; b < 2; ++b)
#pragma unroll
                for (int m = 0; m < 4; ++m)
#pragma unroll
                    for (int n = 0; n < 2; ++n) acc[a][b][m][n] = (f32x4){0.f, 0.f, 0.f, 0.f};
        cur = nxt; cA = nA; cB = nB; ++ui;
        if constexpr (ALIGN_EPI) { if (wr == 1) PG8_BAR; }
    }
    PG8_WAIT_V(0);
    if constexpr (!ALIGN_EPI) { if (wr == 0) PG8_BAR; }
    PG8_BAR;
    if constexpr (Epi::AFTER_DRAIN) { E.fused(acc, cur, wr, wc, fr, fq, lds, wid, lane); S.done(cur); }
#undef PG8_SA
#undef PG8_SB
#undef PG8_STAGE
#undef PG8_LDA
#undef PG8_LDB
#undef PG8_MMA
#undef PG8_WAIT_V
#undef PG8_WAIT_L
#undef PG8_BAR
#undef PG8_SCHED
}
}
namespace mx {
#define MLAS __attribute__((address_space(3)))
typedef unsigned short bf16_t;
typedef short bf16x8 __attribute__((ext_vector_type(8)));
typedef short s16x4 __attribute__((ext_vector_type(4)));
typedef short v4i16_t __attribute__((ext_vector_type(4)));
typedef float f32x16 __attribute__((ext_vector_type(16)));
typedef float f32x4 __attribute__((ext_vector_type(4)));
typedef unsigned u32x4 __attribute__((ext_vector_type(4)));
typedef unsigned u32x2 __attribute__((ext_vector_type(2)));
typedef MLAS const char* lds_cptr;
typedef MLAS char* lds_ptr;
__device__ __forceinline__ int crow(int r, int hi) { return (r & 3) + 8 * (r >> 2) + 4 * hi; }
typedef float f32x2_t __attribute__((ext_vector_type(2))); typedef __bf16 bf16x2_t __attribute__((ext_vector_type(2)));
__device__ __forceinline__ unsigned cvtpk(float lo, float hi) { f32x2_t v = {lo, hi}; bf16x2_t b = __builtin_convertvector(v, bf16x2_t); return __builtin_bit_cast(unsigned, b); }
__device__ __forceinline__ float bf2f(unsigned short h) { return __uint_as_float((unsigned)h << 16); }
__device__ __forceinline__ void glds16(const void* g, unsigned lds_base) {
    unsigned sv; asm volatile("s_mov_b32 %0, m0\n\ts_mov_b32 m0, %2\n\ts_nop 0\n\tglobal_load_lds_dwordx4 %1, off\n\ts_mov_b32 m0, %0" : "=&s"(sv) : "v"(g), "s"(lds_base) : "memory"); }
__device__ __forceinline__ s16x4 vtr(lds_cptr p) { return __builtin_bit_cast(s16x4, __builtin_amdgcn_ds_read_tr16_b64_v4i16((MLAS v4i16_t*)p)); }
#define MFMA32(a, b, c) __builtin_amdgcn_mfma_f32_32x32x16_bf16(a, b, c, 0, 0, 0)
#define MX_WAIT_BAR(N) asm volatile("s_waitcnt vmcnt(" #N ") lgkmcnt(0)\n\ts_barrier" ::: "memory")
#define RFL(x) ((unsigned)__builtin_amdgcn_readfirstlane((int)(x)))
#define SBAR() __builtin_amdgcn_sched_barrier(0)

template <int NKD> __device__ __forceinline__ void qkt(f32x16& p0, f32x16& p1, lds_cptr kb, const bf16x8* qr, const f32x16& c0) {
    __builtin_amdgcn_s_setprio(1);
#pragma unroll
    for (int d0 = 0; d0 < NKD; ++d0) {
        const bf16x8 b0 = *(const MLAS bf16x8*)(kb + d0 * 2048), b1 = *(const MLAS bf16x8*)(kb + d0 * 2048 + 512);
        if (d0 == 0) { p0 = MFMA32(b0, qr[0], c0); p1 = MFMA32(b1, qr[0], c0); } else { p0 = MFMA32(b0, qr[d0], p0); p1 = MFMA32(b1, qr[d0], p1); }
    }
    __builtin_amdgcn_s_setprio(0);
}
__device__ __forceinline__ void pv4(f32x16 (&o)[4], lds_cptr vp, const bf16x8 (&pa)[4]) {
    __builtin_amdgcn_s_setprio(1);
#pragma unroll
    for (int e0 = 0; e0 < 4; ++e0)
#pragma unroll
        for (int ks = 0; ks < 4; ++ks) {
            const s16x4 lo = vtr(vp + e0 * 4096 + ks * 1024), hh = vtr(vp + e0 * 4096 + ks * 1024 + 512);
            const bf16x8 vf = {lo[0], lo[1], lo[2], lo[3], hh[0], hh[1], hh[2], hh[3]};
            o[e0] = MFMA32(pa[ks], vf, o[e0]);
        }
    __builtin_amdgcn_s_setprio(0);
}
__device__ __forceinline__ void packP(bf16x8 (&pa)[4], const f32x16& p0, const f32x16& p1) {
    u32x4 w;
    w.x = cvtpk(p0[0], p0[1]); w.y = cvtpk(p0[2], p0[3]); w.z = cvtpk(p0[4], p0[5]); w.w = cvtpk(p0[6], p0[7]); pa[0] = __builtin_bit_cast(bf16x8, w);
    w.x = cvtpk(p0[8], p0[9]); w.y = cvtpk(p0[10], p0[11]); w.z = cvtpk(p0[12], p0[13]); w.w = cvtpk(p0[14], p0[15]); pa[1] = __builtin_bit_cast(bf16x8, w);
    w.x = cvtpk(p1[0], p1[1]); w.y = cvtpk(p1[2], p1[3]); w.z = cvtpk(p1[4], p1[5]); w.w = cvtpk(p1[6], p1[7]); pa[2] = __builtin_bit_cast(bf16x8, w);
    w.x = cvtpk(p1[8], p1[9]); w.y = cvtpk(p1[10], p1[11]); w.z = cvtpk(p1[12], p1[13]); w.w = cvtpk(p1[14], p1[15]); pa[3] = __builtin_bit_cast(bf16x8, w);
}
__device__ __forceinline__ float swapsum(float v) { auto rr = __builtin_amdgcn_permlane32_swap(__float_as_uint(v), __float_as_uint(v), false, false); return __uint_as_float(rr[0]) + __uint_as_float(rr[1]); }
__device__ __forceinline__ float swapmax(float v) { auto rr = __builtin_amdgcn_permlane32_swap(__float_as_uint(v), __float_as_uint(v), false, false); return __builtin_fmaxf(__uint_as_float(rr[0]), __uint_as_float(rr[1])); }
__device__ __forceinline__ float half_sum(float v, int lane) {
#pragma unroll
    for (int o = 1; o < 32; o <<= 1) v += __builtin_bit_cast(float, __builtin_amdgcn_ds_bpermute((lane ^ o) << 2, __builtin_bit_cast(int, v)));
    return v;
}
constexpr int A_K = 0, A_KSLOT = 8192, A_V = 3 * A_KSLOT, A_VSLOT = 16384, A_WS = A_V + 3 * A_VSLOT, A_BT = A_WS + 8 * 256, A_END = A_BT + 320 * 4;
#define MX_PIN(x) asm volatile("" : "+v"(x))
template <int THR>
__device__ __forceinline__ void attn_pass(lds_ptr lds, unsigned lds0, int lane, int wid, const bf16_t* Qw, const bf16_t* Kh, const bf16_t* Vh, int NTwg, int NTw, int qpos_w, f32x16 (&o)[4]) {
    const int r32 = lane & 31, hi = lane >> 5;
    const unsigned koff = (unsigned)(lane * 1024 + wid * 8) * 2u, voff = (unsigned)((16 * (wid & 3) + (lane >> 2)) * 1024 + (wid >> 2) * 32 + (lane & 3) * 8) * 2u;
    const unsigned kdst = lds0 + A_K + wid * 1024, vdst = lds0 + A_V + wid * 1024;
    MLAS float* wsf = (MLAS float*)(lds + A_WS) + wid * 64;
    const MLAS float* BT = (const MLAS float*)(lds + A_BT);
    const int trofs = ((lane >> 4) & 1) * 32 + (lane & 3) * 8 + (4 * hi + ((lane & 15) >> 2)) * 64;
#define MX_DMA_K(t, ko) do { unsigned o_ = koff; asm volatile("" : "+v"(o_)); glds16((const char*)Kh + (size_t)(t) * 131072 + o_, RFL(kdst + (ko))); } while (0)
#define MX_DMA_V(t, vo) do { unsigned o_ = voff; asm volatile("" : "+v"(o_)); const char* vs_ = (const char*)Vh + (size_t)(t) * 131072 + o_; glds16(vs_, RFL(vdst + (vo))); glds16(vs_ + 128, RFL(vdst + (vo) + 8192)); } while (0)
    bf16x8 qr[4];
#pragma unroll
    for (int d0 = 0; d0 < 4; ++d0) qr[d0] = (bf16x8){0, 0, 0, 0, 0, 0, 0, 0};
    if (NTw > 0) {
#pragma unroll
        for (int d0 = 0; d0 < 4; ++d0) qr[d0] = *(const bf16x8*)(Qw + (size_t)r32 * 1024 + d0 * 16 + hi * 8);
    }
    MX_DMA_K(0, 0); MX_DMA_V(0, 0);
    if (NTwg > 1) MX_DMA_K(1, A_KSLOT);
    float l = 0.f; f32x16 negm, pA0, pA1, pB0, pB1; bool resc = false;
#pragma unroll
    for (int r = 0; r < 16; ++r) { negm[r] = 0.f; pA0[r] = 0.f; pA1[r] = 0.f; pB0[r] = 0.f; pB1[r] = 0.f; }
#pragma unroll
    for (int e0 = 0; e0 < 4; ++e0)
#pragma unroll
        for (int r = 0; r < 16; ++r) o[e0][r] = 0.f;
    u32x4 pw0, pw1, pw2, pw3;
#define MX_KLD(ko) const lds_cptr kb_ = (lds_cptr)(lds + A_K + (ko) + hi * 1024 + r32 * 16); bf16x8 kf[8]; \
        _Pragma("unroll") for (int d0 = 0; d0 < 4; ++d0) { kf[2 * d0] = *(const MLAS bf16x8*)(kb_ + d0 * 2048); kf[2 * d0 + 1] = *(const MLAS bf16x8*)(kb_ + d0 * 2048 + 512); } SBAR();
#define MX_GA(MF, P, B, W, X0, X1) do { MF; sacc += (P[B] + P[B + 1]) + (P[B + 2] + P[B + 3]); MX_PIN(sacc); W[X0] = cvtpk(P[B], P[B + 1]); W[X1] = cvtpk(P[B + 2], P[B + 3]); MX_PIN(W); SBAR(); } while (0)
#define MX_PHASE_A(C0, C1, N0, N1, ko, PRE) do { MX_KLD(ko) PRE; SBAR(); float sacc = 0.f; \
        MX_GA(N0 = MFMA32(kf[0], qr[0], negm), C0, 0, pw0, 0, 1);  MX_GA(N1 = MFMA32(kf[1], qr[0], negm), C0, 4, pw0, 2, 3); \
        MX_GA(N0 = MFMA32(kf[2], qr[1], N0),   C0, 8, pw1, 0, 1);  MX_GA(N1 = MFMA32(kf[3], qr[1], N1),   C0, 12, pw1, 2, 3); \
        MX_GA(N0 = MFMA32(kf[4], qr[2], N0),   C1, 0, pw2, 0, 1);  MX_GA(N1 = MFMA32(kf[5], qr[2], N1),   C1, 4, pw2, 2, 3); \
        MX_GA(N0 = MFMA32(kf[6], qr[3], N0),   C1, 8, pw3, 0, 1);  MX_GA(N1 = MFMA32(kf[7], qr[3], N1),   C1, 12, pw3, 2, 3); \
        l += sacc; } while (0)
#define MX_MID(N0, N1, t, FIRST) do { \
        if (64 * (t) + 63 - qpos_w > -128) { const int base = 64 * (t) - (qpos_w + r32) + 255; \
            _Pragma("unroll") for (int r = 0; r < 16; ++r) { N0[r] += BT[base + crow(r, hi)]; N1[r] += BT[base + 32 + crow(r, hi)]; } } \
        float m8_[8]; \
        _Pragma("unroll") for (int q = 0; q < 8; ++q) m8_[q] = __builtin_fmaxf(__builtin_fmaxf(N0[2 * q], N0[2 * q + 1]), __builtin_fmaxf(N1[2 * q], N1[2 * q + 1])); \
        float rm = __builtin_fmaxf(__builtin_fmaxf(__builtin_fmaxf(m8_[0], m8_[1]), __builtin_fmaxf(m8_[2], m8_[3])), __builtin_fmaxf(__builtin_fmaxf(m8_[4], m8_[5]), __builtin_fmaxf(m8_[6], m8_[7])));   \
        rm = swapmax(rm); \
        if (FIRST || __any(rm > (float)THR)) { const float dl = FIRST ? rm : __builtin_fmaxf(rm, 0.f); \
            _Pragma("unroll") for (int r = 0; r < 16; ++r) { N0[r] -= dl; N1[r] -= dl; negm[r] -= dl; } \
            const float f = __builtin_amdgcn_exp2f(-dl); l *= f; if (hi == 0) wsf[r32] = f; resc = !(FIRST); } } while (0)
#define MX_VFRAG(i) do { const s16x4 lo_ = vtr(vp_ + ((i) & 3) * 4096 + ((i) >> 2) * 1024), hh_ = vtr(vp_ + ((i) & 3) * 4096 + ((i) >> 2) * 1024 + 512); vf[(i) & 7] = (bf16x8){lo_[0], lo_[1], lo_[2], lo_[3], hh_[0], hh_[1], hh_[2], hh_[3]}; } while (0)
#define MX_PAF(k) __builtin_bit_cast(bf16x8, pw##k)
#define MX_GB(i, PK, X, B) do { if ((i) + 4 < 16) MX_VFRAG((i) + 4); o[(i) & 3] = MFMA32(PK, vf[(i) & 7], o[(i) & 3]); X[B] = __builtin_amdgcn_exp2f(X[B]); X[B + 1] = __builtin_amdgcn_exp2f(X[B + 1]); MX_PIN(X); SBAR(); } while (0)
#define MX_PHASE_B_PRE(vo) const lds_cptr vp_ = (lds_cptr)(lds + A_V + (vo) + trofs); bf16x8 vf[8]; MX_VFRAG(0); MX_VFRAG(1); MX_VFRAG(2); MX_VFRAG(3); SBAR();
#define MX_PHASE_B(N0, N1, vo, DOEXP) do { MX_PHASE_B_PRE(vo) MX_PHASE_B_BODY(N0, N1); } while (0)
#define MX_PHASE_B_BODY(N0, N1) do { \
        MX_GB(0, MX_PAF(0), N0, 0);  MX_GB(1, MX_PAF(0), N0, 2);  MX_GB(2, MX_PAF(0), N0, 4);  MX_GB(3, MX_PAF(0), N0, 6); \
        MX_GB(4, MX_PAF(1), N0, 8);  MX_GB(5, MX_PAF(1), N0, 10); MX_GB(6, MX_PAF(1), N0, 12); MX_GB(7, MX_PAF(1), N0, 14); \
        MX_GB(8, MX_PAF(2), N1, 0);  MX_GB(9, MX_PAF(2), N1, 2);  MX_GB(10, MX_PAF(2), N1, 4); MX_GB(11, MX_PAF(2), N1, 6); \
        MX_GB(12, MX_PAF(3), N1, 8); MX_GB(13, MX_PAF(3), N1, 10); MX_GB(14, MX_PAF(3), N1, 12); MX_GB(15, MX_PAF(3), N1, 14); \
        if (resc) { resc = false; \
            _Pragma("unroll") for (int r = 0; r < 16; ++r) { const float f = wsf[crow(r, hi)]; \
                _Pragma("unroll") for (int e0 = 0; e0 < 4; ++e0) o[e0][r] *= f; } } } while (0)
#define MX_STEP_WAIT(t) do { if ((t) + 1 < NTwg) MX_WAIT_BAR(3); else MX_WAIT_BAR(2); } while (0)
#define MX_STEP_DMA(t) do { if ((t) + 2 < NTwg) MX_DMA_K((t) + 2, kp); if ((t) + 1 < NTwg) MX_DMA_V((t) + 1, vq); } while (0)
#define MX_STEP_BEGIN(t) do { MX_STEP_WAIT(t); MX_STEP_DMA(t); } while (0)
#define MX_STEP_END() do { const int k_ = kp; kp = kc; kc = kn; kn = k_; const int v_ = vq; vq = vp; vp = vc; vc = v_; } while (0)
#define MX_STEP(C0, C1, N0, N1, t) do { MX_STEP_WAIT(t); MX_PHASE_A(C0, C1, N0, N1, kc, MX_STEP_DMA(t)); MX_PHASE_B_PRE(vp) MX_MID(N0, N1, t, false); MX_PHASE_B_BODY(N0, N1); MX_STEP_END(); } while (0)
#define MX_TAIL(X0, X1) do { float sacc = 0.f; \
        _Pragma("unroll") for (int r = 0; r < 16; ++r) sacc += X0[r] + X1[r]; l += sacc; \
        pw0 = (u32x4){cvtpk(X0[0], X0[1]), cvtpk(X0[2], X0[3]), cvtpk(X0[4], X0[5]), cvtpk(X0[6], X0[7])}; pw1 = (u32x4){cvtpk(X0[8], X0[9]), cvtpk(X0[10], X0[11]), cvtpk(X0[12], X0[13]), cvtpk(X0[14], X0[15])}; \
        pw2 = (u32x4){cvtpk(X1[0], X1[1]), cvtpk(X1[2], X1[3]), cvtpk(X1[4], X1[5]), cvtpk(X1[6], X1[7])}; pw3 = (u32x4){cvtpk(X1[8], X1[9]), cvtpk(X1[10], X1[11]), cvtpk(X1[12], X1[13]), cvtpk(X1[14], X1[15])}; \
        const lds_cptr vp_ = (lds_cptr)(lds + A_V + vp + trofs); bf16x8 vf[8]; \
        _Pragma("unroll") for (int ks = 0; ks < 4; ++ks) { \
            MX_VFRAG(4 * ks); MX_VFRAG(4 * ks + 1); MX_VFRAG(4 * ks + 2); MX_VFRAG(4 * ks + 3); \
            const bf16x8 pk_ = ks == 0 ? MX_PAF(0) : ks == 1 ? MX_PAF(1) : ks == 2 ? MX_PAF(2) : MX_PAF(3); \
            o[0] = MFMA32(pk_, vf[(4 * ks) & 7], o[0]); o[1] = MFMA32(pk_, vf[(4 * ks + 1) & 7], o[1]); o[2] = MFMA32(pk_, vf[(4 * ks + 2) & 7], o[2]); o[3] = MFMA32(pk_, vf[(4 * ks + 3) & 7], o[3]); } } while (0)
    MX_WAIT_BAR(0);
    asm volatile("" : "+v"(qr[0]), "+v"(qr[1]), "+v"(qr[2]), "+v"(qr[3]));
    int kp = 2 * A_KSLOT, kc = 0, kn = A_KSLOT, vq = A_VSLOT, vp = 2 * A_VSLOT, vc = 0;
    int t = 0; bool inA = true;
    if (NTw > 0) {
        if (2 < NTwg) MX_DMA_K(2, kp); if (1 < NTwg) MX_DMA_V(1, vq);
        { MX_KLD(kc) pA0 = MFMA32(kf[0], qr[0], negm); pA1 = MFMA32(kf[1], qr[0], negm);
#pragma unroll
          for (int d0 = 1; d0 < 4; ++d0) { pA0 = MFMA32(kf[2 * d0], qr[d0], pA0); pA1 = MFMA32(kf[2 * d0 + 1], qr[d0], pA1); } }
        MX_MID(pA0, pA1, 0, true);
#pragma unroll
        for (int r = 0; r < 16; ++r) { pA0[r] = __builtin_amdgcn_exp2f(pA0[r]); pA1[r] = __builtin_amdgcn_exp2f(pA1[r]); }
        MX_STEP_END(); t = 1;
        for (; t + 1 < NTw; t += 2) { MX_STEP(pA0, pA1, pB0, pB1, t); MX_STEP(pB0, pB1, pA0, pA1, t + 1); }
        if (t < NTw) { MX_STEP(pA0, pA1, pB0, pB1, t); ++t; inA = false; }
    } else {
        if (2 < NTwg) MX_DMA_K(2, kp); if (1 < NTwg) MX_DMA_V(1, vq);
        MX_STEP_END(); t = 1;
    }
    bool pend = NTw > 0;
    for (; t < NTwg; ++t) {
        MX_STEP_BEGIN(t);
        if (pend) { pend = false; if (inA) MX_TAIL(pA0, pA1); else MX_TAIL(pB0, pB1); }
        MX_STEP_END();
    }
    MX_WAIT_BAR(0);
    if (pend) { if (inA) MX_TAIL(pA0, pA1); else MX_TAIL(pB0, pB1); }
    MX_WAIT_BAR(0);
    if (NTw > 0) {
        l = swapsum(l);
        if (hi == 0) wsf[32 + r32] = l;
#pragma unroll
        for (int r = 0; r < 16; ++r) { const float rl = __builtin_amdgcn_rcpf(wsf[32 + crow(r, hi)]);
#pragma unroll
            for (int e0 = 0; e0 < 4; ++e0) o[e0][r] *= rl; }
    }
#undef MX_DMA_K
#undef MX_DMA_V
#undef MX_KLD
#undef MX_GA
#undef MX_PHASE_A
#undef MX_MID
#undef MX_VFRAG
#undef MX_PAF
#undef MX_GB
#undef MX_PHASE_B
#undef MX_PHASE_B_PRE
#undef MX_PHASE_B_BODY
#undef MX_STEP_BEGIN
#undef MX_STEP_WAIT
#undef MX_STEP_DMA
#undef MX_STEP_END
#undef MX_STEP
#undef MX_TAIL
}
__device__ __forceinline__ void attn_unit(lds_ptr lds, unsigned lds0, int tid, const bf16_t* Q, const bf16_t* Kseq, const bf16_t* Vseq, int qrow0, int pos0, int NTwg, int nact, int h,
                                          const float* BTg, int layer, const float* subg, float* scr, bf16_t* MIX) {
    asm volatile("" : "+v"(tid));
    const int lane = tid & 63, wid = __builtin_amdgcn_readfirstlane(tid >> 6), r32 = lane & 31, hi = lane >> 5;
    if (tid < 320) ((MLAS float*)(lds + A_BT))[tid] = BTg[h * 320 + tid];
    const int NTw = wid < nact ? (pos0 + 32 * wid) / 64 + 1 : 0, qpos_w = pos0 + 32 * wid;
    const bf16_t* Qw = Q + (size_t)(qrow0 + 32 * (wid < nact ? wid : 0)) * 1024 + h * 128;
    float* myscr = scr + (size_t)wid * 4096 + lane * 64;
    f32x16 o[4];
    attn_pass<8>(lds, lds0, lane, wid, Qw, Kseq + h * 128, Vseq + h * 128, NTwg, NTw, qpos_w, o);
    if (NTw > 0) {
#pragma unroll
        for (int e0 = 0; e0 < 4; ++e0)
#pragma unroll
            for (int r = 0; r < 16; r += 4) *(f32x4*)(myscr + e0 * 16 + r) = (f32x4){o[e0][r], o[e0][r + 1], o[e0][r + 2], o[e0][r + 3]};
    }
    asm volatile("s_waitcnt vmcnt(0)" ::: "memory");
    attn_pass<8>(lds, lds0, lane, wid, Qw + 64, Kseq + h * 128 + 64, Vseq + h * 128, NTwg, NTw, qpos_w, o);
    if (NTw > 0) {
        const float lam = __builtin_bit_cast(float, __builtin_amdgcn_readfirstlane(__builtin_bit_cast(int, BTg[2560 + layer]))), oml = BTg[2562 + layer];
        float ss[16];
#pragma unroll
        for (int r = 0; r < 16; ++r) ss[r] = 0.f;
        f32x4 sv[16];
        asm volatile("global_load_dwordx4 %0, %16, off sc1\n\tglobal_load_dwordx4 %1, %16, off offset:16 sc1\n\tglobal_load_dwordx4 %2, %16, off offset:32 sc1\n\tglobal_load_dwordx4 %3, %16, off offset:48 sc1\n\t"
                     "global_load_dwordx4 %4, %16, off offset:64 sc1\n\tglobal_load_dwordx4 %5, %16, off offset:80 sc1\n\tglobal_load_dwordx4 %6, %16, off offset:96 sc1\n\tglobal_load_dwordx4 %7, %16, off offset:112 sc1\n\t"
                     "global_load_dwordx4 %8, %16, off offset:128 sc1\n\tglobal_load_dwordx4 %9, %16, off offset:144 sc1\n\tglobal_load_dwordx4 %10, %16, off offset:160 sc1\n\tglobal_load_dwordx4 %11, %16, off offset:176 sc1\n\t"
                     "global_load_dwordx4 %12, %16, off offset:192 sc1\n\tglobal_load_dwordx4 %13, %16, off offset:208 sc1\n\tglobal_load_dwordx4 %14, %16, off offset:224 sc1\n\tglobal_load_dwordx4 %15, %16, off offset:240 sc1\n\t"
                     "s_waitcnt vmcnt(0)"
                     : "=&v"(sv[0]), "=&v"(sv[1]), "=&v"(sv[2]), "=&v"(sv[3]), "=&v"(sv[4]), "=&v"(sv[5]), "=&v"(sv[6]), "=&v"(sv[7]),
                       "=&v"(sv[8]), "=&v"(sv[9]), "=&v"(sv[10]), "=&v"(sv[11]), "=&v"(sv[12]), "=&v"(sv[13]), "=&v"(sv[14]), "=&v"(sv[15])
                     : "v"(myscr) : "memory");
#pragma unroll
        for (int e0 = 0; e0 < 4; ++e0)
#pragma unroll
            for (int r = 0; r < 16; ++r) { const float d = sv[e0 * 4 + (r >> 2)][r & 3] - lam * o[e0][r]; o[e0][r] = d; ss[r] += d * d; }
#pragma unroll
        for (int r = 0; r < 16; ++r) ss[r] = oml * __builtin_amdgcn_rsqf(half_sum(ss[r], lane) * (1.0f / 128.0f) + 1e-5f);
        bf16_t* mp = MIX + (size_t)(qrow0 + 32 * wid + 4 * hi) * 2048 + 512 + h * 128 + r32;
        const float sg0 = subg[r32], sg1 = subg[32 + r32], sg2 = subg[64 + r32], sg3 = subg[96 + r32];
#pragma unroll
        for (int r = 0; r < 16; ++r) { int z_ = 0; asm volatile("" : "+v"(z_)); bf16_t* mr = mp + (size_t)crow(r, 0) * 2048 + z_;
#pragma unroll
            for (int e0 = 0; e0 < 4; ++e0) { const unsigned w = cvtpk(o[e0][r] * ss[r] * (e0 == 0 ? sg0 : e0 == 1 ? sg1 : e0 == 2 ? sg2 : sg3), 0.f); mr[e0 * 32] = (bf16_t)(w & 0xffffu); } }
    }
    asm volatile("s_waitcnt vmcnt(0)" ::: "memory");
}
__device__ __forceinline__ void ret_kv_unit(lds_ptr lds, unsigned lds0, int tid, const bf16_t* RKh, const bf16_t* RVh, int ntile, float* KVTu) {
    asm volatile("" : "+v"(tid));
    const int lane = tid & 63, wid = __builtin_amdgcn_readfirstlane(tid >> 6), r32 = lane & 31, hi = lane >> 5;
    const int trofs = ((lane >> 4) & 1) * 32 + (lane & 3) * 8 + (4 * hi + ((lane & 15) >> 2)) * 64;
    const size_t so = (size_t)(16 * (wid & 3) + (lane >> 2)) * 512 + (wid >> 2) * 32 + (lane & 3) * 8;
    for (int jt = 0; jt < ntile; ++jt) {
        const bf16_t* ks = RKh + (size_t)jt * 64 * 512 + so; const bf16_t* vs = RVh + (size_t)jt * 64 * 512 + so;
        glds16(ks, RFL(lds0 + jt * 16384 + wid * 1024)); glds16(ks + 64, RFL(lds0 + jt * 16384 + 8192 + wid * 1024));
        glds16(vs, RFL(lds0 + 65536 + jt * 16384 + wid * 1024)); glds16(vs + 64, RFL(lds0 + 65536 + jt * 16384 + 8192 + wid * 1024));
    }
    MX_WAIT_BAR(0);
    const int e0 = wid >> 1, d0a = 2 * (wid & 1);
    f32x16 acc[2];
#pragma unroll
    for (int i = 0; i < 2; ++i)
#pragma unroll
        for (int r = 0; r < 16; ++r) acc[i][r] = 0.f;
    for (int jt = 0; jt < ntile; ++jt) {
#pragma unroll
        for (int ks = 0; ks < 4; ++ks) {
            const lds_cptr vp = (lds_cptr)(lds + 65536 + jt * 16384 + e0 * 4096 + ks * 1024 + trofs);
            const s16x4 alo = vtr(vp), ahi = vtr(vp + 512);
            const bf16x8 af = {alo[0], alo[1], alo[2], alo[3], ahi[0], ahi[1], ahi[2], ahi[3]};
#pragma unroll
            for (int i = 0; i < 2; ++i) {
                const lds_cptr kp = (lds_cptr)(lds + jt * 16384 + (d0a + i) * 4096 + ks * 1024 + trofs);
                const s16x4 blo = vtr(kp), bhi = vtr(kp + 512);
                const bf16x8 bfr = {blo[0], blo[1], blo[2], blo[3], bhi[0], bhi[1], bhi[2], bhi[3]};
                acc[i] = MFMA32(af, bfr, acc[i]);
            }
        }
    }
    float* kp0 = KVTu + (32 * e0 + 4 * hi) * 128 + 32 * d0a + r32;
#pragma unroll
    for (int r = 0; r < 16; ++r) { int z_ = 0; asm volatile("" : "+v"(z_)); float* kr = kp0 + crow(r, 0) * 128 + z_; kr[0] = acc[0][r]; kr[32] = acc[1][r]; }
    MX_WAIT_BAR(0);
}
__device__ __forceinline__ void ret_out_unit(lds_ptr lds, unsigned lds0, int tid, const bf16_t* RQh, const bf16_t* RKh, const bf16_t* RVh, const bf16_t* RGh, const bf16_t* SPu,
                                             int ntile, int nact, bf16_t* MIXh) {
    asm volatile("" : "+v"(tid));
    const int lane = tid & 63, wid = __builtin_amdgcn_readfirstlane(tid >> 6), r32 = lane & 31, hi = lane >> 5;
    const int trofs = ((lane >> 4) & 1) * 32 + (lane & 3) * 8 + (4 * hi + ((lane & 15) >> 2)) * 64;
    const size_t so = (size_t)(16 * (wid & 3) + (lane >> 2)) * 512 + (wid >> 2) * 32 + (lane & 3) * 8;
    for (int jt = 0; jt < ntile; ++jt) {
        const bf16_t* ks = RKh + (size_t)(jt * 64 + lane) * 512 + wid * 8; const bf16_t* vs = RVh + (size_t)jt * 64 * 512 + so;
        glds16(ks, RFL(lds0 + jt * 16384 + wid * 1024)); glds16(ks + 64, RFL(lds0 + jt * 16384 + 8192 + wid * 1024));
        glds16(vs, RFL(lds0 + 65536 + jt * 16384 + wid * 1024)); glds16(vs + 64, RFL(lds0 + 65536 + jt * 16384 + 8192 + wid * 1024));
    }
    const bool act = wid < nact;
    bf16x8 qr[8]; f32x16 o[4];
#pragma unroll
    for (int e0 = 0; e0 < 4; ++e0)
#pragma unroll
        for (int r = 0; r < 16; ++r) o[e0][r] = 0.f;
    if (act) {
#pragma unroll
        for (int kd = 0; kd < 8; ++kd) qr[kd] = *(const bf16x8*)(RQh + (size_t)(32 * wid + r32) * 512 + kd * 16 + hi * 8);
#pragma unroll
        for (int e0 = 0; e0 < 4; ++e0) { bf16x8 sf[8];
#pragma unroll
            for (int kd = 0; kd < 8; ++kd) sf[kd] = *(const bf16x8*)(SPu + (size_t)(32 * e0 + r32) * 128 + 16 * kd + 8 * hi);
            SBAR();
#pragma unroll
            for (int kd = 0; kd < 8; ++kd) o[e0] = MFMA32(qr[kd], sf[kd], o[e0]);
            SBAR(); }
    } else {
#pragma unroll
        for (int kd = 0; kd < 8; ++kd) qr[kd] = (bf16x8){0, 0, 0, 0, 0, 0, 0, 0};
    }
    MX_WAIT_BAR(0);
    if (act) {
        const int jd = wid >> 1; f32x16 zero;
#pragma unroll
        for (int r = 0; r < 16; ++r) zero[r] = 0.f;

#ifndef RO_SKIP_INNER
#define RO_SKIP_INNER 0
#endif
        if (!RO_SKIP_INNER) for (int jt = 0; jt <= jd; ++jt) {
            f32x16 p0, p1;
#ifndef RO_CONST_P
            qkt<8>(p0, p1, (lds_cptr)(lds + jt * 16384 + hi * 1024 + r32 * 16), qr, zero);
#else
            for (int r = 0; r < 16; ++r) { p0[r] = 1.0f; p1[r] = 0.5f; }
#endif
            if (jt == jd) { const int q = 32 * wid + r32;
#pragma unroll
                for (int r = 0; r < 16; ++r) { const int k0 = 64 * jt + crow(r, hi); p0[r] = (k0 <= q) ? p0[r] : 0.f; p1[r] = (k0 + 32 <= q) ? p1[r] : 0.f; } }
            bf16x8 pa[4]; packP(pa, p0, p1);
            pv4(o, (lds_cptr)(lds + 65536 + jt * 16384 + trofs), pa);
        }
        float mu[16];
#pragma unroll
        for (int r = 0; r < 16; ++r) { mu[r] = half_sum((o[0][r] + o[1][r]) + (o[2][r] + o[3][r]), lane) * (1.0f / 128.0f); }
        float rs[16];
#pragma unroll
        for (int r = 0; r < 16; ++r) { float q = 0.f;
#pragma unroll
            for (int e0 = 0; e0 < 4; ++e0) { const float d = o[e0][r] - mu[r]; o[e0][r] = d; q += d * d; }
            rs[r] = __builtin_amdgcn_rsqf(half_sum(q, lane) * (1.0f / 128.0f) + 1e-5f); }
        const bf16_t* gp0 = RGh + (size_t)(32 * wid + 4 * hi) * 512 + r32; bf16_t* mp0 = MIXh + (size_t)(32 * wid + 4 * hi) * 2048 + r32;
        unsigned short gv[16][4];
#pragma unroll
        for (int r = 0; r < 16; ++r) { int z_ = 0; asm volatile("" : "+v"(z_)); const bf16_t* gr = gp0 + (size_t)crow(r, 0) * 512 + z_;
#pragma unroll
            for (int e0 = 0; e0 < 4; ++e0) gv[r][e0] = gr[e0 * 32]; }
        SBAR();
#pragma unroll
        for (int r = 0; r < 16; ++r) { int z_ = 0; asm volatile("" : "+v"(z_)); bf16_t* mr = mp0 + (size_t)crow(r, 0) * 2048 + z_;
#pragma unroll
            for (int e0 = 0; e0 < 4; ++e0) { const unsigned w = cvtpk(o[e0][r] * rs[r] * bf2f(gv[r][e0]), 0.f); mr[e0 * 32] = (bf16_t)(w & 0xffffu); } }
    }
    MX_WAIT_BAR(0);
}
#undef RFL
}
constexpr int NWAVES = 8;
constexpr int DM = 2048, MP = 32768, MS = 512, M = MP + MS, DFF = 5632, DIN = 6144;
#ifndef H_PITCH
#define H_PITCH 5696
#endif
constexpr int HP = H_PITCH;
constexpr float ALPHA = 1.4142135623730951f, LN_EPS = 1e-5f;
constexpr size_t HMiB = 512u * 1024u;
constexpr size_t WS_CTL = 0, CTL_ZERO_BYTES = 2 * HMiB;
constexpr size_t WS_TAB = 2 * HMiB;
constexpr size_t WS_CS = 4 * HMiB;
constexpr size_t WS_WGU = 20 * HMiB;
constexpr size_t WS_WD = WS_WGU + 352 * HMiB;
constexpr size_t WS_WIN = WS_WD + 180 * HMiB;
constexpr size_t WS_WOUT = WS_WIN + 96 * HMiB;
constexpr size_t WS_XB = WS_WOUT + 32 * HMiB;
constexpr size_t WS_KS = WS_XB + 260 * HMiB;
constexpr size_t WS_VS = WS_KS + 132 * HMiB;
constexpr size_t WS_R = WS_VS + 132 * HMiB;
constexpr size_t WS_H = WS_R;
constexpr size_t WS_U = WS_R, WS_Q = WS_U + 65 * HMiB, WS_KB = WS_Q + 130 * HMiB, WS_VB = WS_KB + 128 * HMiB, WS_RQ = WS_VB + 128 * HMiB, WS_RK = WS_RQ + 65 * HMiB,
                 WS_RV = WS_RK + 65 * HMiB, WS_RG = WS_RV + 65 * HMiB, WS_KVT = WS_RG + 65 * HMiB, WS_SP = WS_KVT + 68 * HMiB, WS_ASCR = WS_SP + 34 * HMiB, WS_END = WS_ASCR + 64 * HMiB;
constexpr size_t WS_SLAB = WS_R + 740 * HMiB;
static_assert(WS_SLAB >= WS_H + (size_t)M * HP * 2 && WS_SLAB + (size_t)11 * 512 * 2048 * 4 <= WS_END && WS_WD + (size_t)4 * DM * HP * 2 <= WS_WIN, "slab / down-copy placement");
static_assert(WS_H + (size_t)M * HP * 2 <= WS_END, "H fits the shared region");
constexpr int CW_TMO = 0, CW_CODE = 1, CW_BAR = 4096, CW_Q = 8192;
constexpr int RING_OFF = 0, RING_BYTES = 131072, LDSCTL_OFF = RING_BYTES, MISC_OFF = LDSCTL_OFF + 320, LDS_BYTES = 147456;

#define GAS __attribute__((address_space(1)))
#define LAS __attribute__((address_space(3)))
typedef unsigned short bf16;
typedef unsigned v4u __attribute__((ext_vector_type(4)));
typedef unsigned v2u __attribute__((ext_vector_type(2)));
typedef float f32x4 __attribute__((ext_vector_type(4)));
typedef GAS unsigned gu32;
#define RLX_AGENT __ATOMIC_RELAXED, __HIP_MEMORY_SCOPE_AGENT
#define LDS_WAIT() asm volatile("s_waitcnt lgkmcnt(0)" ::: "memory")
#define VM_WAIT() asm volatile("s_waitcnt vmcnt(0)" ::: "memory")
__device__ __forceinline__ unsigned pk2(float lo, float hi) { return pg8::cvt_pk_bf16(lo, hi); }
static_assert(WS_VB - WS_KB == pg8::EpiIn::D_KV * 2 && WS_VS - WS_KS == pg8::EpiIn::D_S * 2 && WS_RK - WS_RQ == pg8::EpiIn::D_R * 2 && WS_RG - WS_RV == pg8::EpiIn::D_R * 2, "EpiIn's pointer deltas match the workspace map");
#define XB_TMO      128
#define XB_XCNT(j)  (256  + 64 * (j))
#define XB_XSUB(j)  (1280 + 64 * (j))
#define XB_XGEN(j)  (2304 + 64 * (j))
#define XB_TOP      3328
#define XB_TOPGEN   3392
#define XCD_BAR_WORDS 3456
#define XB_SPIN_CAP (1u << 22)

__device__ __forceinline__ unsigned xb_ld(unsigned* p)              { return __hip_atomic_load(p, __ATOMIC_RELAXED, __HIP_MEMORY_SCOPE_AGENT); }
__device__ __forceinline__ unsigned xb_add(unsigned* p, unsigned v) { return __hip_atomic_fetch_add(p, v, __ATOMIC_RELAXED, __HIP_MEMORY_SCOPE_AGENT); }
__device__ __forceinline__ unsigned xb_xcc_id() { return (unsigned)__builtin_amdgcn_s_getreg((3 << 11) | 20) & 0xFu; }
#define XB_SPIN(cond, bar) do { unsigned _sp = 0; while (cond) { __builtin_amdgcn_s_sleep(1); \
    if ((++_sp & 255u) == 0u) { if (xb_ld(&(bar)[XB_TMO])) break; if (_sp > XB_SPIN_CAP) { atomicAdd(&(bar)[XB_TMO], 1u); break; } } } } while (0)

struct XcdBarrier {
    unsigned* bar; unsigned x;
    volatile LAS unsigned* st;
};

__device__ __forceinline__ XcdBarrier xcd_barrier_post(unsigned* bar, volatile LAS unsigned* st) {
    XcdBarrier b; b.bar = bar; b.x = xb_xcc_id(); b.st = st;
    if (threadIdx.x == 0) (void)xb_add(&bar[XB_XCNT(b.x)], 1u);
    return b;
}
__device__ __forceinline__ void xcd_barrier_complete(unsigned* bar, unsigned x, unsigned& nloc, unsigned& nx) {
    const unsigned G = gridDim.x * gridDim.y * gridDim.z;
    unsigned sum, cnt, mine, sp = 0u;
    for (;;) {
        sum = 0u; cnt = 0u; mine = 0u;
#pragma unroll
        for (unsigned j = 0; j < 16; ++j) { const unsigned c = xb_ld(&bar[XB_XCNT(j)]); sum += c; cnt += (c > 0u) ? 1u : 0u; mine = (j == x) ? c : mine; }
        if (sum == G) break;
        __builtin_amdgcn_s_sleep(1);
        if ((++sp & 255u) == 0u) { if (xb_ld(&bar[XB_TMO])) break; if (sp > XB_SPIN_CAP) { atomicAdd(&bar[XB_TMO], 1u); break; } }
    }
    nloc = mine > 0u ? mine : 1u; nx = cnt > 0u ? cnt : 1u;
}

__device__ __forceinline__ void xcd_barrier(const XcdBarrier& b, int tid_x  ) {
    asm volatile("s_waitcnt vmcnt(0)" ::: "memory");
    __syncthreads();
    if (tid_x == 0) {
        unsigned* bar = b.bar;
        unsigned bx_ = b.x; asm volatile("" : "+s"(bx_));
#define BX_ bx_
        __builtin_amdgcn_s_waitcnt(0);
        unsigned nloc = b.st[0], nx = b.st[1];
        if (nloc == 0u) { xcd_barrier_complete(bar, BX_, nloc, nx); b.st[0] = nloc; b.st[1] = nx; }
        const unsigned old = xb_add(&bar[XB_XSUB(BX_)], 1u);
        const unsigned gen = old / nloc;
        if (old + 1u == (gen + 1u) * nloc) {
            __builtin_amdgcn_fence(__ATOMIC_RELEASE, "agent");
            asm volatile("s_waitcnt vmcnt(0)" ::: "memory");
            const unsigned og = xb_add(&bar[XB_TOP], 1u);
            const unsigned tg = og / nx;
            if (og + 1u == (tg + 1u) * nx) xb_add(&bar[XB_TOPGEN], 1u);
            else XB_SPIN(xb_ld(&bar[XB_TOPGEN]) == tg, bar);
            __builtin_amdgcn_fence(__ATOMIC_ACQUIRE, "agent");
            xb_add(&bar[XB_XGEN(BX_)], 1u);
            asm volatile("s_waitcnt vmcnt(0)" ::: "memory");
        } else {
            XB_SPIN(xb_ld(&bar[XB_XGEN(BX_)]) == gen, bar);
            __builtin_amdgcn_fence(__ATOMIC_ACQUIRE, "agent");
            asm volatile("s_waitcnt vmcnt(0)" ::: "memory");
        }
    }
    __syncthreads();
}
__device__ __forceinline__ float wave_sum(float v, int lane) {
#pragma unroll
    for (int o = 1; o < 64; o <<= 1) v += __builtin_bit_cast(float, __builtin_amdgcn_ds_bpermute((lane ^ o) << 2, __builtin_bit_cast(int, v)));
    return v;
}
__device__ __forceinline__ int map_row(int code, int n) {
    if (code == 0) return n;
    if (code == 1) return ((n >> 7) << 8) + (n & 127);
    if (code == 2) return ((n >> 7) << 8) + 128 + (n & 127);
    if (n < 512) return ((n >> 7) << 8) + (n & 127);
    if (n < 1024) { const int m = n - 512; return ((m >> 7) << 8) + 128 + (m & 127); }
    if (n >= 4096 && n < 5120) { const int d = n & 127; return (n & ~127) + (d < 64 ? 2 * d : 2 * (d - 64) + 1); }
    return n;
}
__device__ __forceinline__ void p0_transpose_item(const float* W, int K, int N, bf16* WT, int code, LAS float* scr, int item, int lane, int ldw = 0) {
    if (ldw == 0) ldw = K;
    const int nblk = N / 32, kb = item / nblk, nb = item % nblk, k0 = 64 * kb, n0 = 32 * nb;
#pragma unroll 8
    for (int i = 0; i < 32; ++i) { const int kk = 2 * i + (lane >> 5); scr[kk * 33 + (lane & 31)] = W[(size_t)(k0 + kk) * N + n0 + (lane & 31)]; }
    LDS_WAIT(); asm volatile("" ::: "memory");
    const int c = lane & 7;
#pragma unroll
    for (int j = 0; j < 4; ++j) { const int n = (lane >> 3) + 8 * j; const LAS float* s = scr + (8 * c) * 33 + n;
        v4u o; o.x = pk2(s[0 * 33], s[1 * 33]); o.y = pk2(s[2 * 33], s[3 * 33]); o.z = pk2(s[4 * 33], s[5 * 33]); o.w = pk2(s[6 * 33], s[7 * 33]);
        *(GAS v4u*)(WT + (size_t)map_row(code, n0 + n) * ldw + k0 + 8 * c) = o; }
    LDS_WAIT(); asm volatile("" ::: "memory");
}
__device__ __forceinline__ void ln_pass(bf16* XBp, float* fout_base, const float* g, const float* b, int lane, int gw, int NGW, const float* slab, int nsplit, float alpha, float scale, int m_end) {
    f32x4 gg[8], bb[8];
#pragma unroll
    for (int j = 0; j < 4; ++j) { const int c0 = lane * 8 + 512 * j; gg[2 * j] = *(const GAS f32x4*)(g + c0); gg[2 * j + 1] = *(const GAS f32x4*)(g + c0 + 4); bb[2 * j] = *(const GAS f32x4*)(b + c0); bb[2 * j + 1] = *(const GAS f32x4*)(b + c0 + 4); }
    v4u cur[4];
    if (gw < m_end) {
#pragma unroll
        for (int j = 0; j < 4; ++j) cur[j] = ((const GAS v4u*)(XBp + (size_t)gw * DM) + lane)[64 * j];
    }
    for (int m = gw; m < m_end; m += NGW) {
        v4u nx[4]; const int mn = m + NGW;
        if (mn < m_end) {
#pragma unroll
            for (int j = 0; j < 4; ++j) nx[j] = ((const GAS v4u*)(XBp + (size_t)mn * DM) + lane)[64 * j];
        }
        float v[32]; float s = 0.f;
#pragma unroll
        for (int j = 0; j < 4; ++j)
#pragma unroll
            for (int q = 0; q < 4; ++q) { v[j * 8 + 2 * q] = __uint_as_float(cur[j][q] << 16); v[j * 8 + 2 * q + 1] = __uint_as_float(cur[j][q] & 0xffff0000u); }
        if (m >= MP) { const float* part = slab + (size_t)(m - MP) * DM;
            f32x4 a[8];
#pragma unroll
            for (int q = 0; q < 8; ++q) a[q] = (f32x4){0.f, 0.f, 0.f, 0.f};
            for (int ks = 0; ks < nsplit; ++ks) { const float* pp = part + (size_t)ks * 512 * 2048 + lane * 8; f32x4 t8[8];
#pragma unroll
                for (int j = 0; j < 4; ++j) { t8[2 * j] = *(const GAS f32x4*)(pp + 512 * j); t8[2 * j + 1] = *(const GAS f32x4*)(pp + 512 * j + 4); }
                __builtin_amdgcn_sched_barrier(0);
#pragma unroll
                for (int q = 0; q < 8; ++q) a[q] += t8[q]; }
#pragma unroll
            for (int j = 0; j < 4; ++j)
#pragma unroll
                for (int q = 0; q < 4; ++q) { v[j * 8 + q] = v[j * 8 + q] * alpha + a[2 * j][q] * scale; v[j * 8 + 4 + q] = v[j * 8 + 4 + q] * alpha + a[2 * j + 1][q] * scale; }
        }
#pragma unroll
        for (int i = 0; i < 32; ++i) s += v[i];
        const float mean = wave_sum(s, lane) * (1.f / DM); float s2 = 0.f;
#pragma unroll
        for (int i = 0; i < 32; ++i) { v[i] -= mean; s2 += v[i] * v[i]; }
        const float rstd = 1.f / sqrtf(wave_sum(s2, lane) * (1.f / DM) + LN_EPS);
        GAS v4u* xr = (GAS v4u*)(XBp + (size_t)m * DM) + lane;
#pragma unroll
        for (int j = 0; j < 4; ++j) { const int c0 = lane * 8 + 512 * j; f32x4 o0, o1;
#pragma unroll
            for (int q = 0; q < 4; ++q) { o0[q] = v[j * 8 + q] * rstd * gg[2 * j][q] + bb[2 * j][q]; o1[q] = v[j * 8 + 4 + q] * rstd * gg[2 * j + 1][q] + bb[2 * j + 1][q]; }
            if (fout_base) { float* fo = fout_base + (size_t)m * DM + c0; __builtin_nontemporal_store(o0, (GAS f32x4*)fo); __builtin_nontemporal_store(o1, (GAS f32x4*)(fo + 4)); }
            else { v4u w; w.x = pk2(o0[0], o0[1]); w.y = pk2(o0[2], o0[3]); w.z = pk2(o1[0], o1[1]); w.w = pk2(o1[2], o1[3]); xr[64 * j] = w; } }
#pragma unroll
        for (int j = 0; j < 4; ++j) cur[j] = nx[j];
    }
}
template <int NS>
__device__ __forceinline__ void ln_sample(LAS unsigned char* lds, bf16* XBp, const float* g, const float* b, int tid, int vcu, int G, const float* slab, float alpha, float scale) {
    const int lane = tid & 63, wave = tid >> 6, q = wave & 3, rs = wave >> 2, c0 = q * 512 + lane * 8;
    LAS float* ex = (LAS float*)lds;
    const f32x4 g0 = *(const GAS f32x4*)(g + c0), g1 = *(const GAS f32x4*)(g + c0 + 4), b0 = *(const GAS f32x4*)(b + c0), b1 = *(const GAS f32x4*)(b + c0 + 4);
    for (int r2 = vcu; r2 < MS / 2; r2 += G) {
        const int ms = r2 * 2 + rs;
        GAS v4u* xp = (GAS v4u*)(XBp + (size_t)(MP + ms) * DM + c0);
        const v4u xv = *xp;
        const float* pp = slab + (size_t)ms * DM + c0;
        f32x4 t[2 * NS];
#pragma unroll
        for (int ks = 0; ks < NS; ++ks) { t[2 * ks] = *(const GAS f32x4*)(pp + (size_t)ks * 512 * 2048); t[2 * ks + 1] = *(const GAS f32x4*)(pp + (size_t)ks * 512 * 2048 + 4); }
        __builtin_amdgcn_sched_barrier(0);
        f32x4 a0 = (f32x4){0.f, 0.f, 0.f, 0.f}, a1 = a0;
#pragma unroll
        for (int ks = 0; ks < NS; ++ks) { a0 += t[2 * ks]; a1 += t[2 * ks + 1]; }
        float v[8]; float s = 0.f;
#pragma unroll
        for (int i = 0; i < 4; ++i) { v[2 * i] = __uint_as_float(xv[i] << 16); v[2 * i + 1] = __uint_as_float(xv[i] & 0xffff0000u); }
#pragma unroll
        for (int i = 0; i < 4; ++i) { v[i] = v[i] * alpha + a0[i] * scale; v[4 + i] = v[4 + i] * alpha + a1[i] * scale; }
#pragma unroll
        for (int i = 0; i < 8; ++i) s += v[i];
        const float ws1 = wave_sum(s, lane);
        if (lane == 0) ex[rs * 4 + q] = ws1;
        __syncthreads();
        const float mean = (((ex[rs * 4] + ex[rs * 4 + 1]) + ex[rs * 4 + 2]) + ex[rs * 4 + 3]) * (1.f / DM); float s2 = 0.f;
#pragma unroll
        for (int i = 0; i < 8; ++i) { v[i] -= mean; s2 += v[i] * v[i]; }
        const float ws2 = wave_sum(s2, lane);
        if (lane == 0) ex[8 + rs * 4 + q] = ws2;
        __syncthreads();
        const float rstd = 1.f / sqrtf((((ex[8 + rs * 4] + ex[8 + rs * 4 + 1]) + ex[8 + rs * 4 + 2]) + ex[8 + rs * 4 + 3]) * (1.f / DM) + LN_EPS);
        f32x4 o0, o1;
#pragma unroll
        for (int i = 0; i < 4; ++i) { o0[i] = v[i] * rstd * g0[i] + b0[i]; o1[i] = v[4 + i] * rstd * g1[i] + b1[i]; }
        v4u w; w.x = pk2(o0[0], o0[1]); w.y = pk2(o0[2], o0[3]); w.z = pk2(o1[0], o1[1]); w.w = pk2(o1[2], o1[3]);
        *xp = w;
        __syncthreads();
    }
}
__device__ __forceinline__ void conv_item(LAS unsigned char* lds, int tid, int item, int l, const bf16* U, const float* cache_conv, const float* cw, const float* cbias, const float* cg, const float* cbeta, bf16* MIX) {
    asm volatile("" : "+v"(tid));
    const int lane = tid & 63, wid = tid >> 6;
    int b, t0, urow0; const float* hist = nullptr;
    if (item < 1024) { b = item >> 9; t0 = (item & 511) * 32; urow0 = b * 16384; }
    else { const int i2 = item - 1024; b = i2 >> 1; t0 = (i2 & 1) * 32; urow0 = 32768 + b * 64; hist = cache_conv + (size_t)((l * 8 + b) * 30) * 512; }
    { v4u st[8];
#pragma unroll
      for (int q = 0; q < 8; ++q) { const int idx = tid + 512 * q, lr = idx >> 6, ch = idx & 63, t = t0 - 30 + lr; v4u v = (v4u){0u, 0u, 0u, 0u};
        if (idx < 62 * 64) {
          if (t >= 0) v = *(const GAS v4u*)(U + (size_t)(urow0 + t) * 512 + ch * 8);
          else if (hist) { const float* hp = hist + (size_t)(30 + t) * 512 + ch * 8; const f32x4 a = *(const GAS f32x4*)hp, c = *(const GAS f32x4*)(hp + 4);
            v.x = pk2(a.x, a.y); v.y = pk2(a.z, a.w); v.z = pk2(c.x, c.y); v.w = pk2(c.z, c.w); } }
        st[q] = v; }
      __builtin_amdgcn_sched_barrier(0);
#pragma unroll
      for (int q = 0; q < 8; ++q) { const int idx = tid + 512 * q, lr = idx >> 6, ch = idx & 63; if (idx < 62 * 64) *(LAS v4u*)(lds + (size_t)(lr * 512 + ch * 8) * 2) = st[q]; } }
    __syncthreads();
    const int c = tid;
    float w[31];
    { const float* wp = cw + (size_t)l * 31 * 512 + c;
#pragma unroll
      for (int j = 0; j < 31; ++j) { int z_ = 0; asm volatile("" : "+v"(z_)); w[j] = wp[j * 512 + z_]; } }
    float y[32]; const float bias = cbias[l * 512 + c];
#pragma unroll
    for (int i = 0; i < 32; ++i) y[i] = bias;
    const LAS unsigned short* tile = (const LAS unsigned short*)lds;
#pragma unroll
    for (int k = 0; k < 62; ++k) { const float v = __uint_as_float((unsigned)tile[k * 512 + c] << 16);
#pragma unroll
        for (int i = 0; i < 32; ++i) if (k - i >= 0 && k - i <= 30) y[i] += w[k - i] * v; }
    LAS float* yb = (LAS float*)(lds + 65536);
#pragma unroll
    for (int i = 0; i < 32; ++i) yb[i * 512 + c] = y[i];
    __syncthreads();
    float cgv[8], cbv[8];
#pragma unroll
    for (int k8 = 0; k8 < 8; ++k8) { cgv[k8] = cg[l * 512 + lane + 64 * k8]; cbv[k8] = cbeta[l * 512 + lane + 64 * k8]; }
#pragma unroll
    for (int rr = 0; rr < 4; ++rr) { const int i = wid * 4 + rr; float v[8]; float s = 0.f;
#pragma unroll
        for (int k = 0; k < 8; ++k) { v[k] = yb[i * 512 + lane + 64 * k]; s += v[k]; }
        const float mean = wave_sum(s, lane) * (1.f / 512.f); float q = 0.f;
#pragma unroll
        for (int k = 0; k < 8; ++k) { v[k] -= mean; q += v[k] * v[k]; }
        const float rstd = 1.f / sqrtf(wave_sum(q, lane) * (1.f / 512.f) + LN_EPS);
        int z_ = 0; asm volatile("" : "+v"(z_)); bf16* mr = MIX + (size_t)(urow0 + t0 + i) * 2048 + lane + z_;
#pragma unroll
        for (int k = 0; k < 8; ++k) { float z = v[k] * rstd * cgv[k] + cbv[k]; z = z * pg8::sigm(z);
            mr[64 * k] = (bf16)(pk2(z, 0.f) & 0xffffu); } }
    __syncthreads();
}

#define DERIVE_PTRS(WSV, OUTV) \
    unsigned char* ws = (WSV); float* out = (OUTV); \
    gu32* ctl = (gu32*)(ws + WS_CTL); \
    float* TAB = (float*)(ws + WS_TAB); float* CS = (float*)(ws + WS_CS); \
    bf16* WGU = (bf16*)(ws + WS_WGU); bf16* WD = (bf16*)(ws + WS_WD); bf16* WIN = (bf16*)(ws + WS_WIN); bf16* WOUT = (bf16*)(ws + WS_WOUT); \
    bf16* XB = (bf16*)(ws + WS_XB); bf16* KS = (bf16*)(ws + WS_KS); bf16* VS = (bf16*)(ws + WS_VS); bf16* HB = (bf16*)(ws + WS_H); \
    bf16* U = (bf16*)(ws + WS_U); bf16* Q = (bf16*)(ws + WS_Q); bf16* KB = (bf16*)(ws + WS_KB); bf16* VB = (bf16*)(ws + WS_VB); \
    bf16* RQ = (bf16*)(ws + WS_RQ); bf16* RK = (bf16*)(ws + WS_RK); bf16* RV = (bf16*)(ws + WS_RV); bf16* RG = (bf16*)(ws + WS_RG); \
    float* KVT = (float*)(ws + WS_KVT); bf16* SP = (bf16*)(ws + WS_SP); float* ASCR = (float*)(ws + WS_ASCR); \
    bf16* MIXB = (bf16*)out; float* SLAB = (float*)(ws + WS_SLAB);
__device__ __forceinline__ int fresh_tid(int wave_s) { int l_; asm volatile("v_mbcnt_lo_u32_b32 %0, -1, 0\n\tv_mbcnt_hi_u32_b32 %0, -1, %0" : "=v"(l_)); return (wave_s << 6) | l_; }
#define PH_IDS const int tid = fresh_tid(wave_s); const int lane = tid & 63; const int wave = __builtin_amdgcn_readfirstlane(tid >> 6); const int gw = vcu * NWAVES + wave; (void)lane; (void)gw;
#define SPLIT_IDS(NSU) const int nx_ = (G % 8 == 0) ? 8 : 1, cpx_ = G / nx_, xx_ = (int)blockIdx.x % nx_, xr_ = (int)blockIdx.x / nx_, per0_ = ((NSU) + nx_ - 1) / nx_, per_ = per0_ < cpx_ - 1 ? per0_ : cpx_ - 1; \
    const bool gemm_cu_ = xr_ < per_; const int NP_ = per_ * nx_, pidx_ = xx_ * per_ + xr_, NL_ = nx_ * (cpx_ - per_), lnidx_ = xx_ * (cpx_ - per_) + (xr_ - per_);
#ifndef STOP_IT
#define STOP_IT -1
#define STOP_PH -1
#endif
#define STOP_AT(ph) do { if (STOP_IT == it && STOP_PH == (ph)) return; } while (0)
#ifndef H_TILED
#define H_TILED 1
#endif
#ifndef GU_WGM
#define GU_WGM 4
#endif
struct Args { const float* in[20]; float* out; unsigned char* ws; };
__global__ void __launch_bounds__(NWAVES * 64, 2) mk_fwd(Args args) {
    extern __shared__ __attribute__((aligned(16))) unsigned char lds_raw[];
    LAS unsigned char* lds = (LAS unsigned char*)lds_raw;
    volatile LAS unsigned* MISC = (volatile LAS unsigned*)(lds + MISC_OFF);
    const int wave_s = __builtin_amdgcn_readfirstlane((int)threadIdx.x >> 6);
    const int G = gridDim.x; const int vcu = (G % 8 == 0) ? ((int)blockIdx.x % 8) * (G / 8) + (int)blockIdx.x / 8 : (int)blockIdx.x;
    DERIVE_PTRS(args.ws, args.out)
    for (int u = fresh_tid(wave_s); u < (LDS_BYTES - LDSCTL_OFF) / 4; u += NWAVES * 64) ((LAS unsigned*)(lds + LDSCTL_OFF))[u] = 0u;
    __syncthreads();
    XcdBarrier bar = xcd_barrier_post((unsigned*)(ctl + CW_BAR), MISC + 8);
    const int NGW = G * NWAVES;
    const unsigned lds0 = (unsigned)(size_t)lds;

#ifndef REP_P0
#define REP_P0 1
#endif
    for (int rep_ = 0; rep_ < REP_P0; ++rep_) { PH_IDS
        LAS float* scr = (LAS float*)(lds + RING_OFF + wave * 16384);
        constexpr int I_F = 5632, I_IN = 6144, I_OUT = 2048, NITEMS = 12 * I_F + 2 * I_IN + 2 * I_OUT;
        for (int it = gw; it < NITEMS; it += NGW) {
            int r = it;
            if (r < 12 * I_F) { const int mtx = r / I_F, k3 = mtx % 3, li = mtx / 3; r -= mtx * I_F;
                if (k3 == 0) p0_transpose_item(args.in[8] + (size_t)li * DM * DFF, DM, DFF, WGU + (size_t)li * 2 * DFF * DM, 1, scr, r, lane);
                else if (k3 == 1) p0_transpose_item(args.in[9] + (size_t)li * DM * DFF, DM, DFF, WGU + (size_t)li * 2 * DFF * DM, 2, scr, r, lane);
                else p0_transpose_item(args.in[10] + (size_t)li * DFF * DM, DFF, DM, WD + (size_t)li * DM * HP, 0, scr, r, lane, HP);
                continue; }
            r -= 12 * I_F;
            if (r < 2 * I_IN) { const int li = r / I_IN; r -= li * I_IN; p0_transpose_item(args.in[11] + (size_t)li * DM * DIN, DM, DIN, WIN + (size_t)li * DIN * DM, 3, scr, r, lane); continue; }
            r -= 2 * I_IN;
            { const int li = r / I_OUT; r -= li * I_OUT; p0_transpose_item(args.in[12] + (size_t)li * DM * DM, DM, DM, WOUT + (size_t)li * DM * DM, 0, scr, r, lane); }
        }
        for (int m = gw; m < M; m += NGW) {
            const float* src = m < MP ? args.in[0] + (size_t)m * DM : args.in[1] + (size_t)(m - MP) * DM;
            const GAS f32x4* xr = (const GAS f32x4*)src + lane; GAS v2u* o8 = (GAS v2u*)(XB + (size_t)m * DM) + lane;
            f32x4 v8[8];
#pragma unroll
            for (int j = 0; j < 8; ++j) v8[j] = xr[64 * j];
            __builtin_amdgcn_sched_barrier(0);
#pragma unroll
            for (int j = 0; j < 8; ++j) { v2u w; w.x = pk2(v8[j].x, v8[j].y); w.y = pk2(v8[j].z, v8[j].w); o8[64 * j] = w; }
        }
        for (int r = gw; r < 65536; r += NGW) {
            const int which = r >> 15, rr = r & 32767, lb = rr >> 11, t = rr & 2047;
            const GAS f32x4* xr = (const GAS f32x4*)(args.in[3 + which] + (size_t)rr * 1024) + lane;
            GAS v2u* o8 = (GAS v2u*)((which ? VS : KS) + ((size_t)lb * 2112 + t) * 1024) + lane;
            f32x4 v4[4];
#pragma unroll
            for (int j = 0; j < 4; ++j) v4[j] = xr[64 * j];
            __builtin_amdgcn_sched_barrier(0);
#pragma unroll
            for (int j = 0; j < 4; ++j) { v2u w; w.x = pk2(v4[j].x, v4[j].y); w.y = pk2(v4[j].z, v4[j].w); o8[64 * j] = w; }
        }
        for (int i = vcu * 512 + tid; i < 16384 * 64; i += G * 512) {
            const int pos = i >> 6, k = i & 63;
            const float p = (float)exp2((double)k * (13.287712379549449 / 64.0)); const float inv = 1.0f / p; const float ang = (float)pos * inv;
            const double a = (double)ang; const double n = rint(a * 0.15915494309189535); const float red = (float)(a - n * 6.283185307179586);
            CS[2 * (size_t)i] = cosf(red); CS[2 * (size_t)i + 1] = sinf(red);
        }
        if (blockIdx.x == 0) {
            const float* rb = args.in[19];
            for (int i = tid; i < 8 * 320; i += 512) { const int h = i / 320, rel = (i % 320) - 255, n = rel < 0 ? -rel : rel;
                int bk = n < 8 ? n : 8 + (n >= 12) + (n >= 16) + (n >= 23) + (n >= 32) + (n >= 46) + (n >= 64) + (n >= 91);
                bk += rel > 0 ? 16 : 0;
                TAB[i] = (rb[bk * 8 + h] - rb[15 * 8 + h]) * 1.4426950408889634f; }
            if (tid < 2) { const float* lf = args.in[17] + tid * 256; float a = 0.f, c = 0.f;
                for (int i = 0; i < 64; ++i) { a += lf[i] * lf[64 + i]; c += lf[128 + i] * lf[192 + i]; }
                TAB[2560 + tid] = expf(a) - expf(c) + (tid == 0 ? 0.2f : 0.35550906759096934f); TAB[2562 + tid] = tid == 0 ? 0.8f : 0.64449093240903066f; }
        }
    }
    xcd_barrier(bar, fresh_tid(wave_s));

    for (int it = 0; it < 4; ++it) {
        const int l = it >> 1, j = it & 1;
        size_t zoff; asm volatile("s_mov_b64 %0, 0" : "=s"(zoff));
        unsigned char* ws_l = args.ws + zoff; float* out_l = args.out + zoff;
        DERIVE_PTRS(ws_l, out_l)
        if (it > 0) { PH_IDS SPLIT_IDS(2 * (2 * DFF / 256))
            if (gemm_cu_) { const pg8::Gemm g = pg8::gemm_rowmajor(XB, WGU + (size_t)it * 2 * DFF * DM, M, 2 * DFF, DM, DM); pg8::PanelOrder S; S.init(MP / 256, MS / 256, 2 * DFF, NP_, pidx_, DM);
                pg8::EpiGU E{HB, HP, H_TILED};
                pg8::gemm_phase<pg8::EpiGU, pg8::PanelOrder, true, true>(lds + RING_OFF, g, S, E, fresh_tid(wave_s)); }
            else { const int pi = j == 0 ? (l - 1) * 3 + 2 : l * 3 + 1; const float* gp = args.in[6] + (size_t)pi * DM; const float* bp = args.in[7] + (size_t)pi * DM;
                ln_pass(XB, (float*)nullptr, gp, bp, lane, lnidx_ * NWAVES + wave, NL_ * NWAVES, SLAB, 0, ALPHA, 0.f, MP); }
        }
        if (it > 0) xcd_barrier(bar, fresh_tid(wave_s));
#ifndef REP_GU
#define REP_GU 1
#endif
        for (int rep_ = 0; rep_ < REP_GU; ++rep_)
        { const int Mg = it == 0 ? M : MP; const pg8::Gemm g = pg8::gemm_rowmajor(XB, WGU + (size_t)it * 2 * DFF * DM, Mg, 2 * DFF, DM, DM); pg8::StaticOrder S; S.init(Mg, 2 * DFF, G, (int)blockIdx.x, DM); S.wgm = GU_WGM;
          pg8::EpiGU E{HB, HP, H_TILED};
          pg8::gemm_phase<pg8::EpiGU, pg8::StaticOrder, true, true>(lds + RING_OFF, g, S, E, fresh_tid(wave_s)); }
        STOP_AT(2);
        xcd_barrier(bar, fresh_tid(wave_s));
#ifndef REP_DOWN
#define REP_DOWN 1
#endif
        for (int rep_ = 0; rep_ < REP_DOWN; ++rep_)
        { const pg8::Gemm g = H_TILED ? pg8::gemm_atiled(HB, WD + (size_t)it * DM * HP, M, DM, DFF, HP) : pg8::gemm_rowmajor(HB, WD + (size_t)it * DM * HP, M, DM, DFF, HP); pg8::TailSplitOrder S; S.init(MP, M, DM, G, (int)blockIdx.x, DFF, 11); S.rev = true;
          pg8::EpiResB E{XB, rep_ + 1 < REP_DOWN ? 1.0f : ALPHA, rep_ + 1 < REP_DOWN ? 0.0f : 0.5f, SLAB};
          pg8::gemm_phase<pg8::EpiResB, pg8::TailSplitOrder, true, true>(lds + RING_OFF, g, S, E, fresh_tid(wave_s)); }
        STOP_AT(3);
        xcd_barrier(bar, fresh_tid(wave_s));
        { PH_IDS const float* gp = args.in[6] + (size_t)(l * 3 + 2 * j) * DM; const float* bp = args.in[7] + (size_t)(l * 3 + 2 * j) * DM;
          if (it == 3) ln_pass(XB, out, gp, bp, lane, gw, NGW, SLAB, 11, ALPHA, 0.5f, M);
          else ln_sample<11>(lds + RING_OFF, XB, gp, bp, tid, vcu, G, SLAB, ALPHA, 0.5f); }
        if (it == 3) break;
        STOP_AT(4);
        xcd_barrier(bar, fresh_tid(wave_s));
        if (j == 0) {
            { PH_IDS SPLIT_IDS(2 * (DIN / 256))
              if (gemm_cu_) { const pg8::Gemm g = pg8::gemm_rowmajor(XB, WIN + (size_t)l * DIN * DM, M, DIN, DM, DM); pg8::PanelOrder S; S.init(MP / 256, MS / 256, DIN, NP_, pidx_, DM);
                  pg8::EpiIn E{l, out, U, Q, KB, KS, RQ, RV, CS};
                  pg8::gemm_phase<pg8::EpiIn, pg8::PanelOrder, true, true>(lds + RING_OFF, g, S, E, fresh_tid(wave_s)); }
              else { const float* gp = args.in[6] + (size_t)(l * 3) * DM; const float* bp = args.in[7] + (size_t)(l * 3) * DM;
                  ln_pass(XB, (float*)nullptr, gp, bp, lane, lnidx_ * NWAVES + wave, NL_ * NWAVES, SLAB, 0, ALPHA, 0.f, MP); }
            }
            xcd_barrier(bar, fresh_tid(wave_s));
#ifndef REP_IN
#define REP_IN 1
#endif
            for (int rep_ = 0; rep_ < REP_IN; ++rep_)
            { const pg8::Gemm g = pg8::gemm_rowmajor(XB, WIN + (size_t)l * DIN * DM, MP, DIN, DM, DM); pg8::StaticOrder S; S.init(MP, DIN, G, (int)blockIdx.x, DM);
              pg8::EpiIn E{l, out, U, Q, KB, KS, RQ, RV, CS};
              pg8::gemm_phase<pg8::EpiIn, pg8::StaticOrder, true, true>(lds + RING_OFF, g, S, E, fresh_tid(wave_s)); }
            STOP_AT(5);
            xcd_barrier(bar, fresh_tid(wave_s));
#ifndef REP_M1
#define REP_M1 1
#endif
            for (int rep_ = 0; rep_ < REP_M1; ++rep_) { PH_IDS
                const float* subg = args.in[18] + l * 128;
                float* scr = ASCR + (size_t)blockIdx.x * 32768;
#ifndef SKIP_ATTN
#define SKIP_ATTN 0
#endif
#ifndef SKIP_CONV
#define SKIP_CONV 0
#endif
#ifndef SKIP_RET
#define SKIP_RET 0
#endif
                if (!SKIP_ATTN) for (int p = vcu; p < 512; p += G) { const int bh = p >> 5, s = p & 31, b = bh >> 3, h = bh & 7;
                    for (int k = 0; k < 2; ++k) { const int qb = k == 0 ? 63 - s : s;
                        mx::attn_unit((mx::lds_ptr)lds, lds0, fresh_tid(wave_s), Q, KB + (size_t)b * 16384 * 1024, VB + (size_t)b * 16384 * 1024, b * 16384 + 256 * qb, 256 * qb, 4 * qb + 4, 8, h, TAB, l, subg, scr, MIXB); } }
                for (;;) {
                    __syncthreads(); if (tid == 0) MISC[0] = __hip_atomic_fetch_add(ctl + CW_Q + 64 * l, 1u, RLX_AGENT); __syncthreads();
                    const int item = (int)MISC[0];
                    if (item >= 64 + 544 + 1040) break;
                    if (item < 64) { const int b = item >> 3, h = item & 7; const size_t so = (size_t)((l * 8 + b) * 2112) * 1024;
                        mx::attn_unit((mx::lds_ptr)lds, lds0, fresh_tid(wave_s), Q, KS + so, VS + so, MP + 64 * b, 2048, 33, 2, h, TAB, l, subg, scr, MIXB); }
                    else if (item < 608) { const int u = item - 64; int row0, h, nt;
                        if (u < 512) { row0 = (u >> 8) * 16384 + ((u >> 2) & 63) * 256; h = u & 3; nt = 4; } else { const int s = u - 512; row0 = MP + (s >> 2) * 64; h = s & 3; nt = 1; }
                        mx::ret_kv_unit((mx::lds_ptr)lds, lds0, fresh_tid(wave_s), RK + (size_t)row0 * 512 + h * 128, RV + (size_t)row0 * 512 + h * 128, nt, KVT + (size_t)u * 16384); }
                    else if (!SKIP_CONV) conv_item(lds, fresh_tid(wave_s), item - 608, l, U, args.in[2], args.in[13], args.in[14], args.in[15], args.in[16], MIXB);
                }
            }
            STOP_AT(6);
            xcd_barrier(bar, fresh_tid(wave_s));
#ifndef REP_M23
#define REP_M23 1
#endif
            for (int rep23_ = 0; rep23_ < REP_M23; ++rep23_) {
            { PH_IDS
            for (int i = vcu; i < 256 + 1024; i += G) {
                const bool pr = i < 256; const int jj = pr ? i : i - 256, chain = jj >> 5, slab = jj & 31, idx = slab * 512 + tid, b = chain >> 2, h = chain & 3;
                const int e = idx >> 7, d = idx & 127, dnat = (d >> 1) + 64 * (d & 1);
                const float lg = h == 0 ? -0.04580368961312479f : h == 1 ? -0.02272007650008353f : h == 2 ? -0.011315313227834146f : -0.005646563141142063f;
                if (pr) { const float gL = __builtin_amdgcn_exp2f(256.f * lg); float S = 0.f;
                    for (int n0 = 0; n0 < 64; n0 += 8) { float kv8[8];
#pragma unroll
                        for (int j = 0; j < 8; ++j) kv8[j] = KVT[(size_t)((b * 64 + n0 + j) * 4 + h) * 16384 + idx];
                        __builtin_amdgcn_sched_barrier(0);
#pragma unroll
                        for (int j = 0; j < 8; ++j) { const size_t uo = (size_t)((b * 64 + n0 + j) * 4 + h) * 16384 + idx; SP[uo] = (bf16)(pk2(S, 0.f) & 0xffffu); S = gL * (S + kv8[j]); } }
                    out[pg8::O_RETP + ((size_t)((l * 2 + b) * 4 + h) * 128 + dnat) * 128 + e] = S; }
                else { const float gL = __builtin_amdgcn_exp2f(64.f * lg); const size_t uo = (size_t)(512 + b * 4 + h) * 16384 + idx; const size_t so = ((size_t)((l * 8 + b) * 4 + h) * 128 + dnat) * 128 + e;
                    const float S0 = args.in[5][so]; SP[uo] = (bf16)(pk2(S0, 0.f) & 0xffffu); out[pg8::O_RETS + so] = gL * (S0 + KVT[uo]); }
            } }
#ifdef DUMP_KVT
            xcd_barrier(bar, fresh_tid(wave_s));
            for (size_t i = (size_t)blockIdx.x * 512 + fresh_tid(wave_s); i < (size_t)544 * 16384; i += (size_t)G * 512) { out[pg8::O_KP + i] = KVT[i]; out[pg8::O_VP + i] = __uint_as_float((unsigned)SP[i] << 16); }
#endif
            STOP_AT(7);
            xcd_barrier(bar, fresh_tid(wave_s));
            { PH_IDS
            if (!SKIP_RET) for (int u = vcu; u < 544; u += G) { int row0, h, nt, na;
                if (u < 512) { row0 = (u >> 8) * 16384 + ((u >> 2) & 63) * 256; h = u & 3; nt = 4; na = 8; } else { const int s = u - 512; row0 = MP + (s >> 2) * 64; h = s & 3; nt = 1; na = 2; }
                const size_t ro = (size_t)row0 * 512 + h * 128;
                mx::ret_out_unit((mx::lds_ptr)lds, lds0, fresh_tid(wave_s), RQ + ro, RK + ro, RV + ro, RG + ro, SP + (size_t)u * 16384, nt, na, MIXB + (size_t)row0 * 2048 + 1536 + h * 128); } }
#ifdef DUMP_MIX
            xcd_barrier(bar, fresh_tid(wave_s));
            for (size_t i = (size_t)blockIdx.x * 512 + fresh_tid(wave_s); i < (size_t)M * 2048; i += (size_t)G * 512) out[pg8::O_KP + i] = __uint_as_float((unsigned)MIXB[i] << 16);
#endif
            STOP_AT(8);
            xcd_barrier(bar, fresh_tid(wave_s));
            }
            { const pg8::Gemm g = pg8::gemm_rowmajor(MIXB, WOUT + (size_t)l * DM * DM, M, DM, DM, DM); pg8::TailSplitOrder S; S.init(MP, M, DM, G, (int)blockIdx.x, DM, 4);
              pg8::EpiResB E{XB, ALPHA, 1.0f, SLAB};
              pg8::gemm_phase<pg8::EpiResB, pg8::TailSplitOrder, true, true>(lds + RING_OFF, g, S, E, fresh_tid(wave_s)); }
            STOP_AT(9);
            xcd_barrier(bar, fresh_tid(wave_s));
            { PH_IDS const float* gp = args.in[6] + (size_t)(l * 3 + 1) * DM; const float* bp = args.in[7] + (size_t)(l * 3 + 1) * DM;
              ln_sample<4>(lds + RING_OFF, XB, gp, bp, tid, vcu, G, SLAB, ALPHA, 1.0f); }
            xcd_barrier(bar, fresh_tid(wave_s));
        }
    }
}

extern "C" void kernel_launch(void* const* d_in, const int* in_sizes, int n_in, void* d_out, int out_size, void* d_ws, size_t ws_size, hipStream_t stream) {
    static int grid = 0;
    if (grid == 0) {
        if (n_in != 20 || in_sizes[0] != MP * DM || (size_t)out_size != pg8::O_END || ws_size < WS_END) {
            fprintf(stderr, "kernel_launch: unexpected problem sizes (n_in %d, in0 %d, out %d, ws %zu; need ws >= %zu); nothing launched\n", n_in, n_in > 0 ? in_sizes[0] : -1, out_size, ws_size, (size_t)WS_END); grid = -1; return; }
        int dev = 0, cus = 0;
        if (hipGetDevice(&dev) != hipSuccess || hipDeviceGetAttribute(&cus, hipDeviceAttributeMultiprocessorCount, dev) != hipSuccess) { grid = -1; return; }
        if (hipFuncSetAttribute((const void*)mk_fwd, hipFuncAttributeMaxDynamicSharedMemorySize, LDS_BYTES) != hipSuccess) { fprintf(stderr, "kernel_launch: hipFuncSetAttribute failed\n"); grid = -1; return; }
        int per_cu = 0;
        if (hipOccupancyMaxActiveBlocksPerMultiprocessor(&per_cu, (const void*)mk_fwd, NWAVES * 64, LDS_BYTES) != hipSuccess || per_cu < 1) fprintf(stderr, "kernel_launch: occupancy query reports %d\n", per_cu);
        (void)hipGetLastError();
        grid = cus;
    }
    if (grid < 0) return;
    if (hipMemsetAsync((char*)d_ws + WS_CTL, 0, CTL_ZERO_BYTES, stream) != hipSuccess) return;
    Args a{};
    for (int i = 0; i < 20; ++i) a.in[i] = (const float*)d_in[i];
    a.out = (float*)d_out; a.ws = (unsigned char*)d_ws;
    hipLaunchKernelGGL(mk_fwd, dim3(grid), dim3(NWAVES * 64), LDS_BYTES, stream, a);
}
```

```cpp
#include <hip/hip_runtime.h>
#include <cstdio>
#include <cstdint>
namespace pg8 {
#define PG8_LAS __attribute__((address_space(3)))
typedef unsigned short bf16_t;
typedef short bf16x8 __attribute__((ext_vector_type(8)));
typedef float f32x4 __attribute__((ext_vector_type(4)));
typedef unsigned u32x4 __attribute__((ext_vector_type(4)));
constexpr int BM = 256, BK = 64, HALF = 128, HTB = HALF * BK * 2  , STAGE_BYTES = 8 * HTB, NXCD = 8, WGM = 4;

__host__ __device__ __forceinline__ int lds_byte(int r, int c) { const int st = (r >> 4) * 2 + (c >> 5), rr = r & 15, cc = c & 31, ob = rr * 64 + cc * 2; return st * 1024 + (ob ^ (((ob >> 9) & 1) << 5)); }
__host__ __device__ __forceinline__ void stage_rc(int b, int& R, int& C) { const int st = b / 1024, sb = b % 1024, swz = sb ^ (((sb >> 9) & 1) << 5); R = (st >> 1) * 16 + swz / 64; C = (st & 1) * 32 + (swz % 64) / 2; }
__host__ __device__ __forceinline__ int perm32(int rho) { const int n = rho >> 4, i = rho & 15; return 8 * (i >> 2) + 4 * n + (i & 3); }

struct Unit { int pm, pn, k0, nt, ks; };
struct Gemm { const bf16_t* A; const bf16_t* Bt; int M, N, K, lda, ldb; size_t ksA, ksB, tsA, tsB; };
__host__ __device__ inline Gemm gemm_rowmajor(const bf16_t* A, const bf16_t* Bt, int M, int N, int K, int ld) { return Gemm{A, Bt, M, N, K, ld, ld, (size_t)BK * 2, (size_t)BK * 2, (size_t)BM * ld * 2, (size_t)BM * ld * 2}; }
__host__ __device__ inline Gemm gemm_atiled(const bf16_t* A, const bf16_t* Bt, int M, int N, int K, int ldb) { return Gemm{A, Bt, M, N, K, BK, ldb, (size_t)BM * BK * 2, (size_t)BK * 2, (size_t)(K / BK) * BM * BK * 2, (size_t)BM * ldb * 2}; }

struct StaticOrder {
    int nM, nN, nwg, G, c, ntf, wgm;
    __host__ __device__ void init(int M, int N, int G_, int c_, int K_) { nM = M / BM; nN = N / BM; nwg = nM * nN; G = G_; c = c_; ntf = K_ / BK; wgm = WGM; }
    __host__ __device__ bool next(int i, Unit& u) const {
        const long L = (long)i * G + c; if (L >= nwg) return false;
        int wgid = (int)L; { const int q = nwg / NXCD, r = nwg % NXCD, xcd = wgid % NXCD, off = wgid / NXCD; wgid = (xcd < r ? xcd * (q + 1) : r * (q + 1) + (xcd - r) * q) + off; }
        const int nig = wgm * nN, gid = wgid / nig, fm = gid * wgm, gsz = (nM - fm) < wgm ? (nM - fm) : wgm;
        u.pm = fm + ((wgid % nig) % gsz); u.pn = (wgid % nig) / gsz; u.k0 = 0; u.nt = ntf; u.ks = 0; return true;
    }
    __device__ __forceinline__ void a_ready(const Unit&) const {}
    __device__ __forceinline__ void done(const Unit&) const {}
};

struct TailSplitOrder {
    StaticOrder P; int nwp, nN, nsplit, ntp, ntot, G, c, mp; bool rev;
    __host__ __device__ void init(int Mp, int Mall, int N, int G_, int c_, int K_, int nsplit_) { P.init(Mp, N, G_, c_, K_); nwp = P.nwg; nN = N / BM; nsplit = nsplit_; ntp = K_ / BK / nsplit_; mp = Mp / BM;
        ntot = nwp + ((Mall - Mp) / BM) * nN * nsplit_; G = G_; c = c_; rev = false; }
    __host__ __device__ bool next(int i, Unit& u) const {
        const long L = (long)i * G + c; if (L >= ntot) return false;
        int pm, pn, k0 = 0, nt = P.ntf, ks = 0;
        if (L < nwp) {
            int wgid = (int)L; { const int q = P.nwg / NXCD, r = P.nwg % NXCD, xcd = wgid % NXCD, off = wgid / NXCD; wgid = (xcd < r ? xcd * (q + 1) : r * (q + 1) + (xcd - r) * q) + off; }
            const int nig = P.wgm * P.nN, gid = wgid / nig, fm = gid * P.wgm, gsz = (P.nM - fm) < P.wgm ? (P.nM - fm) : P.wgm;
            pm = fm + ((wgid % nig) % gsz); pn = (wgid % nig) / gsz;
            if (rev) pm = P.nM - 1 - pm;
        } else {
            const int s = (int)(L - nwp), rest = s / nsplit; ks = s % nsplit;
            pn = rest % nN; pm = mp + rest / nN; nt = ntp; k0 = ks * ntp;
        }
        u.pm = pm; u.pn = pn; u.k0 = k0; u.nt = nt; u.ks = ks; return true;
    }
    __device__ __forceinline__ void a_ready(const Unit&) const {}
    __device__ __forceinline__ void done(const Unit&) const {}
};

struct PanelOrder {
    int pm0, np, ntot, NP, c, ntf;
    __host__ __device__ void init(int pm0_, int np_, int N, int NP_, int c_, int K_) { pm0 = pm0_; np = np_; ntot = np_ * (N / BM); NP = NP_; c = c_; ntf = K_ / BK; }
    __host__ __device__ bool next(int i, Unit& u) const {
        const int L = i * NP + c; if (L >= ntot) return false;
        const int pm = pm0 + L % np, pn = L / np;
        u.pm = pm; u.pn = pn; u.k0 = 0; u.nt = ntf; u.ks = 0; return true;
    }
    __device__ __forceinline__ void a_ready(const Unit&) const {}
    __device__ __forceinline__ void done(const Unit&) const {}
};

typedef float f32x2c_t __attribute__((ext_vector_type(2))); typedef __bf16 bf16x2c_t __attribute__((ext_vector_type(2)));
__device__ __forceinline__ unsigned cvt_pk_bf16(float lo, float hi) { f32x2c_t v = {lo, hi}; bf16x2c_t b = __builtin_convertvector(v, bf16x2c_t); return __builtin_bit_cast(unsigned, b); }
typedef float f32x2 __attribute__((ext_vector_type(2)));
constexpr size_t O_Y = 0, O_CONVP = 68157440, O_KP = 68218880, O_VP = 135327744, O_RETP = 202436608, O_CONVS = 202698752, O_KS = 202944512, O_VS = 203993088, O_RETS = 205041664, O_END = 206090240;
__device__ __forceinline__ float sigm(float x) { return __builtin_amdgcn_rcpf(1.0f + __builtin_amdgcn_exp2f(-1.4426950408889634f * x)); }
__device__ __forceinline__ void st8(bf16_t* p, const float (&v)[8]) { u32x4 w; w.x = cvt_pk_bf16(v[0], v[1]); w.y = cvt_pk_bf16(v[2], v[3]); w.z = cvt_pk_bf16(v[4], v[5]); w.w = cvt_pk_bf16(v[6], v[7]); *(u32x4*)p = w; }

struct EpiGU {
    static constexpr bool PERM = true, AFTER_DRAIN = false;
    bf16_t* H; int ldh; int tiled;
    __device__ __forceinline__ void operator()(const f32x4 (&acc)[2][2][4][2], const Unit& u, int wr, int wc, int fr, int fq) const {
        const int row0 = u.pm * BM + wr * 64 + fr, col0 = u.pn * 128 + wc * 32 + 8 * fq;
#pragma unroll
        for (int ai = 0; ai < 2; ++ai)
#pragma unroll
            for (int m = 0; m < 4; ++m) {
                float h[8];
#pragma unroll
                for (int n = 0; n < 2; ++n)
#pragma unroll
                    for (int j = 0; j < 4; ++j) { const float g = acc[ai][0][m][n][j], uu = acc[ai][1][m][n][j]; h[n * 4 + j] = g * sigm(g) * uu; }
                { const int row = row0 + ai * HALF + m * 16; st8(tiled ? H + ((size_t)((row >> 8) * (5632 / 64) + (col0 >> 6)) * 256 + (row & 255)) * 64 + (col0 & 63) : H + (size_t)row * ldh + col0, h); }
            }
    }
};
struct EpiRes {
    static constexpr bool PERM = false, AFTER_DRAIN = false;
    float* X; float alpha, scale;
    __device__ __forceinline__ void operator()(const f32x4 (&acc)[2][2][4][2], const Unit& u, int wr, int wc, int fr, int fq) const {
        const int row0 = u.pm * BM + wr * 64 + fr, col0 = u.pn * BM + wc * 32 + 4 * fq;
#pragma unroll
        for (int ai = 0; ai < 2; ++ai)
#pragma unroll
            for (int m = 0; m < 4; ++m) { float* rp = X + (size_t)(row0 + ai * HALF + m * 16) * 2048 + col0;
#pragma unroll
                for (int bj = 0; bj < 2; ++bj)
#pragma unroll
                    for (int n = 0; n < 2; ++n) { f32x4* q = (f32x4*)(rp + bj * HALF + n * 16); const f32x4 v = *q; *q = v * alpha + acc[ai][bj][m][n] * scale; } }
    }
};
struct EpiResB {
    static constexpr bool PERM = true, AFTER_DRAIN = false;
    bf16_t* XBp; float alpha, scale; float* slab;
    __device__ __forceinline__ void operator()(const f32x4 (&acc)[2][2][4][2], const Unit& u, int wr, int wc, int fr, int fq) const {
        const int row0 = u.pm * BM + wr * 64 + fr, col0 = u.pn * BM + wc * 32 + 8 * fq;
        if (u.pm >= 128) {
#pragma unroll
            for (int ai = 0; ai < 2; ++ai)
#pragma unroll
                for (int m = 0; m < 4; ++m) { float* rp = slab + ((size_t)u.ks * 512 + (row0 - 32768 + ai * HALF + m * 16)) * 2048 + col0;
#pragma unroll
                    for (int bj = 0; bj < 2; ++bj) { *(f32x4*)(rp + bj * HALF) = acc[ai][bj][m][0]; *(f32x4*)(rp + bj * HALF + 4) = acc[ai][bj][m][1]; } }
            return;
        }
        u32x4 res[2][4][2];
#pragma unroll
        for (int ai = 0; ai < 2; ++ai)
#pragma unroll
            for (int m = 0; m < 4; ++m)
#pragma unroll
                for (int bj = 0; bj < 2; ++bj) res[ai][m][bj] = *(const u32x4*)(XBp + (size_t)(row0 + ai * HALF + m * 16) * 2048 + col0 + bj * HALF);
        __builtin_amdgcn_sched_barrier(0);
#pragma unroll
        for (int ai = 0; ai < 2; ++ai)
#pragma unroll
            for (int m = 0; m < 4; ++m) { bf16_t* rp = XBp + (size_t)(row0 + ai * HALF + m * 16) * 2048 + col0;
#pragma unroll
                for (int bj = 0; bj < 2; ++bj) { const u32x4 w = res[ai][m][bj]; float y[8];
#pragma unroll
                    for (int n = 0; n < 2; ++n)
#pragma unroll
                        for (int j = 0; j < 4; ++j) { const unsigned ww = w[n * 2 + (j >> 1)]; const float x = __uint_as_float((j & 1) ? (ww & 0xffff0000u) : (ww << 16)); y[n * 4 + j] = x * alpha + acc[ai][bj][m][n][j] * scale; }
                    st8(rp + bj * HALF, y); } }
    }
};
struct EpiIn {
    static constexpr bool PERM = true, AFTER_DRAIN = false;
    int layer; float* out; bf16_t *U, *Q, *KB, *KS, *RQ, *RV; const float* cs;
    static constexpr size_t D_KV = 64u * 1024u * 1024u / 2u * 2u / 2u, D_S = 66u * 1024u * 1024u / 2u, D_R = 34078720u / 2u;
    __device__ __forceinline__ void operator()(const f32x4 (&acc)[2][2][4][2], const Unit& u, int wr, int wc, int fr, int fq) const {
        const int pn = u.pn, pm = u.pm; const bool smp = pm >= 128; const int cb = wc * 32 + 8 * fq;
        const int rbase = pm * BM + wr * 64 + fr;
#define ROWVARS const int row = rbase + ai * HALF + m * 16; int b, t; if (!smp) { b = row >> 14; t = row & 16383; } else { const int r2 = row - 32768; b = r2 >> 6; t = r2 & 63; }
        if (pn < 4) {
#pragma unroll
            for (int ai = 0; ai < 2; ++ai)
#pragma unroll
                for (int m = 0; m < 4; ++m) { ROWVARS
                    float v[8];
#pragma unroll
                    for (int n = 0; n < 2; ++n)
#pragma unroll
                        for (int j = 0; j < 4; ++j) v[n * 4 + j] = acc[ai][0][m][n][j] * sigm(acc[ai][1][m][n][j]);
                    st8(U + (size_t)row * 512 + pn * 128 + cb, v);
                    int jr; float* cp;
                    if (!smp) { jr = t - (16384 - 30); cp = out + O_CONVP + (size_t)((layer * 2 + b) * 30 + jr) * 512; }
                    else { jr = t - 34; cp = out + O_CONVS + (size_t)((layer * 8 + b) * 30 + jr) * 512; }
                    if (jr >= 0) { cp += pn * 128 + cb; *(f32x4*)cp = (f32x4){v[0], v[1], v[2], v[3]}; *(f32x4*)(cp + 4) = (f32x4){v[4], v[5], v[6], v[7]}; }
                }
        } else if (pn < 8) {
#pragma unroll
            for (int ai = 0; ai < 2; ++ai)
#pragma unroll
                for (int m = 0; m < 4; ++m) { const int row = rbase + ai * HALF + m * 16;
#pragma unroll
                    for (int bj = 0; bj < 2; ++bj) { float v[8];
#pragma unroll
                        for (int n = 0; n < 2; ++n)
#pragma unroll
                            for (int j = 0; j < 4; ++j) v[n * 4 + j] = acc[ai][bj][m][n][j] * 0.18033688011112042f;
                        st8(Q + (size_t)row * 1024 + (pn - 4) * 256 + bj * HALF + cb, v); } }
        } else if (pn < 16) {
            const bool isk = pn < 12; const int cq = ((pn - 8) & 3) * 256 + cb;
#pragma unroll
            for (int ai = 0; ai < 2; ++ai)
#pragma unroll
                for (int m = 0; m < 4; ++m) { ROWVARS
                    float* op; bf16_t* bp;
                    if (!smp) { op = out + O_KP + (isk ? (size_t)0 : O_VP - O_KP) + ((size_t)layer * 32768 + row) * 1024; bp = KB + (isk ? (size_t)0 : D_KV) + (size_t)row * 1024; }
                    else { op = out + O_KS + (isk ? (size_t)0 : O_VS - O_KS) + ((size_t)layer * 512 + (row - 32768)) * 1024; bp = KS + (isk ? (size_t)0 : D_S) + ((size_t)((layer * 8 + b) * 2112 + 2048 + t)) * 1024; }
#pragma unroll
                    for (int bj = 0; bj < 2; ++bj) { float v[8];
#pragma unroll
                        for (int n = 0; n < 2; ++n)
#pragma unroll
                            for (int j = 0; j < 4; ++j) v[n * 4 + j] = acc[ai][bj][m][n][j];
                        float* o2 = op + cq + bj * HALF; __builtin_nontemporal_store(acc[ai][bj][m][0], (f32x4*)o2); __builtin_nontemporal_store(acc[ai][bj][m][1], (f32x4*)(o2 + 4));
                        st8(bp + cq + bj * HALF, v); } }
        } else if (pn < 20) {
            const bool isq = pn < 18; const int hb = ((pn - 16) & 1) * 2;
#pragma unroll
            for (int ai = 0; ai < 2; ++ai) {
            f32x4 cc01[4], cc23[4];
#pragma unroll
                for (int m = 0; m < 4; ++m) { ROWVARS (void)b;
                    const int pos = smp ? 2048 + t : t; const float* c = cs + ((size_t)pos * 64 + (cb >> 1)) * 2;
                    cc01[m] = *(const f32x4*)c; cc23[m] = *(const f32x4*)(c + 4); }
            __builtin_amdgcn_sched_barrier(0);
#pragma unroll
                for (int m = 0; m < 4; ++m) { ROWVARS (void)b;
                    const int il = smp ? t : (row & 255);
                    const f32x4 c01 = cc01[m], c23 = cc23[m];
#pragma unroll
                    for (int bj = 0; bj < 2; ++bj) { const int head = hb + bj;
                        const float lg = head == 0 ? -0.04580368961312479f : head == 1 ? -0.02272007650008353f : head == 2 ? -0.011315313227834146f : -0.005646563141142063f;
                        const float e = (float)(il + 1) * lg; const float sc = isq ? __builtin_amdgcn_exp2f(e) : 0.08838834764831845f * __builtin_amdgcn_exp2f(-e);
                        const f32x4 x = acc[ai][bj][m][0], y = acc[ai][bj][m][1]; float v[8];
                        v[0] = (x[0] * c01[0] - x[1] * c01[1]) * sc; v[1] = (x[0] * c01[1] + x[1] * c01[0]) * sc;
                        v[2] = (x[2] * c01[2] - x[3] * c01[3]) * sc; v[3] = (x[2] * c01[3] + x[3] * c01[2]) * sc;
                        v[4] = (y[0] * c23[0] - y[1] * c23[1]) * sc; v[5] = (y[0] * c23[1] + y[1] * c23[0]) * sc;
                        v[6] = (y[2] * c23[2] - y[3] * c23[3]) * sc; v[7] = (y[2] * c23[3] + y[3] * c23[2]) * sc;
                        st8(RQ + (isq ? (size_t)0 : D_R) + (size_t)row * 512 + head * 128 + cb, v); } } }
        } else {
            const bool isv = pn < 22; const int cq = ((pn - 20) & 1) * 256 + cb;
#pragma unroll
            for (int ai = 0; ai < 2; ++ai)
#pragma unroll
                for (int m = 0; m < 4; ++m) { const int row = rbase + ai * HALF + m * 16;
#pragma unroll
                    for (int bj = 0; bj < 2; ++bj) { float v[8];
#pragma unroll
                        for (int n = 0; n < 2; ++n)
#pragma unroll
                            for (int j = 0; j < 4; ++j) { const float x = acc[ai][bj][m][n][j]; v[n * 4 + j] = isv ? x : x * sigm(x); }
                        st8(RV + (isv ? (size_t)0 : D_R) + (size_t)row * 512 + cq + bj * HALF, v); } }
        }
#undef ROWVARS
    }
};
template <class Epi, class Sched, bool ALIGN_EPI = false, bool SP2 = false>
__device__ __forceinline__ void gemm_phase(PG8_LAS unsigned char* lds, const Gemm g, const Sched& S, const Epi& E, int tid0) {
    int tid_ = tid0; asm volatile("" : "+v"(tid_));
    const int tid = tid_, wid = __builtin_amdgcn_readfirstlane(tid >> 6), lane = tid & 63, wr = wid >> 2, wc = wid & 3, fr = lane & 15, fq = lane >> 4;
    const int lda = g.lda, ldb = g.ldb;
    unsigned voffA[2], voffB[2];
#pragma unroll
    for (int i = 0; i < 2; ++i) { int R, C; stage_rc(tid * 16 + i * 8192, R, C); const int Rb = Epi::PERM ? ((R & ~31) + perm32(R & 31)) : R;
        voffA[i] = (unsigned)(R * lda + C) * 2u; voffB[i] = (unsigned)(Rb * ldb + C) * 2u; }
    const size_t ksA = g.ksA, ksB = g.ksB;
    const size_t hsA = (size_t)HALF * lda * 2, hsB = (size_t)HALF * ldb * 2;
    const size_t tsA = g.tsA, tsB = g.tsB;
    const unsigned ldsw = (unsigned)wid * 1024u;
    const int aoff = lds_byte(wr * 64 + fr, fq * 8), boff = lds_byte(wc * 32 + fr, fq * 8);
#define PG8_SA(b, h) (((b) * 2 + (h)) * HTB)
#define PG8_SB(b, h) ((4 + (b) * 2 + (h)) * HTB)
#define PG8_STAGE(bufoff, gbase, voff) do { _Pragma("unroll") for (int _i = 0; _i < 2; ++_i) \
        __builtin_amdgcn_global_load_lds((const unsigned*)((const char*)(gbase) + (voff)[_i]), (PG8_LAS unsigned*)(lds + (bufoff) + ldsw + _i * 8192), 16, 0, 0); } while (0)
#define PG8_LDA(dst, b, h) do { _Pragma("unroll") for (int m = 0; m < 4; ++m) _Pragma("unroll") for (int k = 0; k < 2; ++k) dst[m][k] = *(const PG8_LAS bf16x8*)(lds + PG8_SA(b, h) + aoff + m * 2048 + k * 1024); } while (0)
#define PG8_LDB(dst, b, h) do { _Pragma("unroll") for (int n = 0; n < 2; ++n) _Pragma("unroll") for (int k = 0; k < 2; ++k) dst[n][k] = *(const PG8_LAS bf16x8*)(lds + PG8_SB(b, h) + boff + n * 2048 + k * 1024); } while (0)
#define PG8_MMA(ai, bj, At, Bt) do { __builtin_amdgcn_s_setprio(1); _Pragma("unroll") for (int m = 0; m < 4; ++m) _Pragma("unroll") for (int n = 0; n < 2; ++n) _Pragma("unroll") for (int k = 0; k < 2; ++k) \
        acc[ai][bj][m][n] = __builtin_amdgcn_mfma_f32_16x16x32_bf16(Bt[n][k], At[m][k], acc[ai][bj][m][n], 0, 0, 0); __builtin_amdgcn_s_setprio(0); } while (0)
#define PG8_WAIT_V(n) asm volatile("s_waitcnt vmcnt(" #n ")" ::: "memory")
#define PG8_WAIT_L(n) asm volatile("s_waitcnt lgkmcnt(" #n ")" ::: "memory")
#define PG8_BAR __builtin_amdgcn_s_barrier()
#define PG8_SCHED __builtin_amdgcn_sched_barrier(0)
    Unit cur, nxt; int ui = 0;
    if (!S.next(0, cur)) return;
    f32x4 acc[2][2][4][2];
#pragma unroll
    for (int a = 0; a < 2; ++a)
#pragma unroll
        for (int b = 0; b < 2; ++b)
#pragma unroll
            for (int m = 0; m < 4; ++m)
#pragma unroll
                for (int n = 0; n < 2; ++n) acc[a][b][m][n] = (f32x4){0.f, 0.f, 0.f, 0.f};
    bf16x8 At[4][2], B0[2][2], B1[2][2];
    const char* cA = (const char*)g.A + (size_t)cur.pm * tsA + (size_t)cur.k0 * ksA; const char* cB = (const char*)g.Bt + (size_t)cur.pn * tsB + (size_t)cur.k0 * ksB;
    S.a_ready(cur);
    if constexpr (SP2) {
        PG8_STAGE(PG8_SB(0, 0), cB, voffB); PG8_STAGE(PG8_SB(0, 1), cB + hsB, voffB); PG8_STAGE(PG8_SA(0, 0), cA, voffA); PG8_STAGE(PG8_SA(0, 1), cA + hsA, voffA);
        if (wr == 1) PG8_BAR;
        PG8_WAIT_V(2); PG8_BAR;
        PG8_STAGE(PG8_SB(1, 0), cB + ksB, voffB); PG8_STAGE(PG8_SA(1, 0), cA + ksA, voffA); PG8_STAGE(PG8_SB(1, 1), cB + hsB + ksB, voffB);
        PG8_WAIT_V(6); PG8_BAR;
    } else {
        PG8_STAGE(PG8_SB(0, 0), cB, voffB); PG8_STAGE(PG8_SA(0, 0), cA, voffA); PG8_STAGE(PG8_SB(0, 1), cB + hsB, voffB); PG8_STAGE(PG8_SA(0, 1), cA + hsA, voffA);
        if (wr == 1) PG8_BAR;
        PG8_WAIT_V(4); PG8_BAR;
        PG8_STAGE(PG8_SB(1, 0), cB + ksB, voffB); PG8_STAGE(PG8_SA(1, 0), cA + ksA, voffA); PG8_STAGE(PG8_SB(1, 1), cB + hsB + ksB, voffB);
        PG8_WAIT_V(6); PG8_BAR;
    }
    for (;;) {
        const bool has_next = S.next(ui + 1, nxt);
        const char* nA = has_next ? (const char*)g.A + (size_t)nxt.pm * tsA + (size_t)nxt.k0 * ksA : cA; const char* nB = has_next ? (const char*)g.Bt + (size_t)nxt.pn * tsB + (size_t)nxt.k0 * ksB : cB;
        const int nt = cur.nt;
        for (int t = 0; t < nt; t += 2) {
            const bool last = (t == nt - 2);
            const char* a1 = cA + (size_t)(t + 1) * ksA;
            const char* a2 = last ? nA : cA + (size_t)(t + 2) * ksA; const char* b2 = last ? nB : cB + (size_t)(t + 2) * ksB;
            const char* a3 = a2 + ksA; const char* b3 = b2 + ksB;
            if (last && has_next) S.a_ready(nxt);
            if constexpr (SP2) {
            PG8_LDB(B0, 0, 0); PG8_LDB(B1, 0, 1); PG8_SCHED; PG8_LDA(At, 0, 0); PG8_STAGE(PG8_SA(1, 1), a1 + hsA, voffA);
            PG8_WAIT_V(8); PG8_WAIT_L(0); PG8_BAR; PG8_MMA(0, 0, At, B0); PG8_MMA(0, 1, At, B1); PG8_BAR; PG8_SCHED;
            PG8_LDA(At, 0, 1); PG8_STAGE(PG8_SB(0, 0), b2, voffB); PG8_STAGE(PG8_SB(0, 1), b2 + hsB, voffB); PG8_STAGE(PG8_SA(0, 0), a2, voffA);
            PG8_WAIT_V(8); PG8_WAIT_L(0); PG8_BAR; PG8_MMA(1, 0, At, B0); PG8_MMA(1, 1, At, B1); PG8_BAR; PG8_SCHED;
            PG8_LDB(B0, 1, 0); PG8_LDB(B1, 1, 1); PG8_SCHED; PG8_LDA(At, 1, 0); PG8_STAGE(PG8_SA(0, 1), a2 + hsA, voffA);
            PG8_WAIT_V(8); PG8_WAIT_L(0); PG8_BAR; PG8_MMA(0, 0, At, B0); PG8_MMA(0, 1, At, B1); PG8_BAR; PG8_SCHED;
            PG8_LDA(At, 1, 1); PG8_STAGE(PG8_SB(1, 0), b3, voffB); PG8_STAGE(PG8_SB(1, 1), b3 + hsB, voffB); PG8_STAGE(PG8_SA(1, 0), a3, voffA);
            PG8_WAIT_V(8); PG8_WAIT_L(0); PG8_BAR; PG8_MMA(1, 0, At, B0); PG8_MMA(1, 1, At, B1); PG8_BAR; PG8_SCHED;
            } else {
            PG8_LDB(B0, 0, 0); PG8_SCHED; PG8_LDA(At, 0, 0); PG8_STAGE(PG8_SA(1, 1), a1 + hsA, voffA);
            PG8_WAIT_L(8); PG8_BAR; PG8_WAIT_L(0); PG8_MMA(0, 0, At, B0); PG8_BAR; PG8_SCHED;
            PG8_LDB(B1, 0, 1); PG8_STAGE(PG8_SB(0, 0), b2, voffB);
            PG8_BAR; PG8_WAIT_L(0); PG8_MMA(0, 1, At, B1); PG8_BAR;
            PG8_LDA(At, 0, 1); PG8_STAGE(PG8_SA(0, 0), a2, voffA);
            PG8_BAR; PG8_WAIT_L(0); PG8_MMA(1, 0, At, B0); PG8_BAR; PG8_SCHED;
            PG8_STAGE(PG8_SB(0, 1), b2 + hsB, voffB);
            PG8_WAIT_V(6); PG8_BAR; PG8_MMA(1, 1, At, B1); PG8_BAR;
            PG8_LDB(B0, 1, 0); PG8_SCHED; PG8_LDA(At, 1, 0); PG8_STAGE(PG8_SA(0, 1), a2 + hsA, voffA);
            PG8_WAIT_L(8); PG8_BAR; PG8_WAIT_L(0); PG8_MMA(0, 0, At, B0); PG8_BAR; PG8_SCHED;
            PG8_LDB(B1, 1, 1); PG8_STAGE(PG8_SB(1, 0), b3, voffB);
            PG8_BAR; PG8_WAIT_L(0); PG8_MMA(0, 1, At, B1); PG8_BAR;
            PG8_LDA(At, 1, 1); PG8_STAGE(PG8_SA(1, 0), a3, voffA);
            PG8_BAR; PG8_WAIT_L(0); PG8_MMA(1, 0, At, B0); PG8_BAR; PG8_SCHED;
            PG8_STAGE(PG8_SB(1, 1), b3 + hsB, voffB);
            PG8_WAIT_V(6); PG8_BAR; PG8_MMA(1, 1, At, B1); PG8_BAR;
            }
        }
        if constexpr (ALIGN_EPI) { if (wr == 0) PG8_BAR; }
        if constexpr (!Epi::AFTER_DRAIN) { E(acc, cur, wr, wc, fr, fq); S.done(cur); }
        if (!has_next) break;
#pragma unroll
        for (int a = 0; a < 2; ++a)
#pragma unroll
            for (int b = 0; b < 2; ++b)
#pragma unroll
                for (int m = 0; m < 4; ++m)
#pragma unroll
                    for (int n = 0; n < 2; ++n) acc[a][b][m][n] = (f32x4){0.f, 0.f, 0.f, 0.f};
        cur = nxt; cA = nA; cB = nB; ++ui;
        if constexpr (ALIGN_EPI) { if (wr == 1) PG8_BAR; }
    }
    PG8_WAIT_V(0);
    if constexpr (!ALIGN_EPI) { if (wr == 0) PG8_BAR; }
    PG8_BAR;
    if constexpr (Epi::AFTER_DRAIN) { E.fused(acc, cur, wr, wc, fr, fq, lds, wid, lane); S.done(cur); }
#undef PG8_SA
#undef PG8_SB
#undef PG8_STAGE
#undef PG8_LDA
#undef PG8_LDB
#undef PG8_MMA
#undef PG8_WAIT_V
#undef PG8_WAIT_L
#undef PG8_BAR
#undef PG8_SCHED
}
}
namespace mx {
#define MLAS __attribute__((address_space(3)))
typedef unsigned short bf16_t;
typedef short bf16x8 __attribute__((ext_vector_type(8)));
typedef short s16x4 __attribute__((ext_vector_type(4)));
typedef short v4i16_t __attribute__((ext_vector_type(4)));
typedef float f32x16 __attribute__((ext_vector_type(16)));
typedef float f32x4 __attribute__((ext_vector_type(4)));
typedef unsigned u32x4 __attribute__((ext_vector_type(4)));
typedef unsigned u32x2 __attribute__((ext_vector_type(2)));
typedef MLAS const char* lds_cptr;
typedef MLAS char* lds_ptr;
__device__ __forceinline__ int crow(int r, int hi) { return (r & 3) + 8 * (r >> 2) + 4 * hi; }
typedef float f32x2_t __attribute__((ext_vector_type(2))); typedef __bf16 bf16x2_t __attribute__((ext_vector_type(2)));
__device__ __forceinline__ unsigned cvtpk(float lo, float hi) { f32x2_t v = {lo, hi}; bf16x2_t b = __builtin_convertvector(v, bf16x2_t); return __builtin_bit_cast(unsigned, b); }
__device__ __forceinline__ float bf2f(unsigned short h) { return __uint_as_float((unsigned)h << 16); }
__device__ __forceinline__ void glds16(const void* g, unsigned lds_base) {
    unsigned sv; asm volatile("s_mov_b32 %0, m0\n\ts_mov_b32 m0, %2\n\ts_nop 0\n\tglobal_load_lds_dwordx4 %1, off\n\ts_mov_b32 m0, %0" : "=&s"(sv) : "v"(g), "s"(lds_base) : "memory"); }
__device__ __forceinline__ s16x4 vtr(lds_cptr p) { return __builtin_bit_cast(s16x4, __builtin_amdgcn_ds_read_tr16_b64_v4i16((MLAS v4i16_t*)p)); }
#define MFMA32(a, b, c) __builtin_amdgcn_mfma_f32_32x32x16_bf16(a, b, c, 0, 0, 0)
#define MX_WAIT_BAR(N) asm volatile("s_waitcnt vmcnt(" #N ") lgkmcnt(0)\n\ts_barrier" ::: "memory")
#define RFL(x) ((unsigned)__builtin_amdgcn_readfirstlane((int)(x)))
#define SBAR() __builtin_amdgcn_sched_barrier(0)

template <int NKD> __device__ __forceinline__ void qkt(f32x16& p0, f32x16& p1, lds_cptr kb, const bf16x8* qr, const f32x16& c0) {
    __builtin_amdgcn_s_setprio(1);
#pragma unroll
    for (int d0 = 0; d0 < NKD; ++d0) {
        const bf16x8 b0 = *(const MLAS bf16x8*)(kb + d0 * 2048), b1 = *(const MLAS bf16x8*)(kb + d0 * 2048 + 512);
        if (d0 == 0) { p0 = MFMA32(b0, qr[0], c0); p1 = MFMA32(b1, qr[0], c0); } else { p0 = MFMA32(b0, qr[d0], p0); p1 = MFMA32(b1, qr[d0], p1); }
    }
    __builtin_amdgcn_s_setprio(0);
}
__device__ __forceinline__ void pv4(f32x16 (&o)[4], lds_cptr vp, const bf16x8 (&pa)[4]) {
    __builtin_amdgcn_s_setprio(1);
#pragma unroll
    for (int e0 = 0; e0 < 4; ++e0)
#pragma unroll
        for (int ks = 0; ks < 4; ++ks) {
            const s16x4 lo = vtr(vp + e0 * 4096 + ks * 1024), hh = vtr(vp + e0 * 4096 + ks * 1024 + 512);
            const bf16x8 vf = {lo[0], lo[1], lo[2], lo[3], hh[0], hh[1], hh[2], hh[3]};
            o[e0] = MFMA32(pa[ks], vf, o[e0]);
        }
    __builtin_amdgcn_s_setprio(0);
}
__device__ __forceinline__ void packP(bf16x8 (&pa)[4], const f32x16& p0, const f32x16& p1) {
    u32x4 w;
    w.x = cvtpk(p0[0], p0[1]); w.y = cvtpk(p0[2], p0[3]); w.z = cvtpk(p0[4], p0[5]); w.w = cvtpk(p0[6], p0[7]); pa[0] = __builtin_bit_cast(bf16x8, w);
    w.x = cvtpk(p0[8], p0[9]); w.y = cvtpk(p0[10], p0[11]); w.z = cvtpk(p0[12], p0[13]); w.w = cvtpk(p0[14], p0[15]); pa[1] = __builtin_bit_cast(bf16x8, w);
    w.x = cvtpk(p1[0], p1[1]); w.y = cvtpk(p1[2], p1[3]); w.z = cvtpk(p1[4], p1[5]); w.w = cvtpk(p1[6], p1[7]); pa[2] = __builtin_bit_cast(bf16x8, w);
    w.x = cvtpk(p1[8], p1[9]); w.y = cvtpk(p1[10], p1[11]); w.z = cvtpk(p1[12], p1[13]); w.w = cvtpk(p1[14], p1[15]); pa[3] = __builtin_bit_cast(bf16x8, w);
}
__device__ __forceinline__ float swapsum(float v) { auto rr = __builtin_amdgcn_permlane32_swap(__float_as_uint(v), __float_as_uint(v), false, false); return __uint_as_float(rr[0]) + __uint_as_float(rr[1]); }
__device__ __forceinline__ float swapmax(float v) { auto rr = __builtin_amdgcn_permlane32_swap(__float_as_uint(v), __float_as_uint(v), false, false); return __builtin_fmaxf(__uint_as_float(rr[0]), __uint_as_float(rr[1])); }
__device__ __forceinline__ float half_sum(float v, int lane) {
#pragma unroll
    for (int o = 1; o < 32; o <<= 1) v += __builtin_bit_cast(float, __builtin_amdgcn_ds_bpermute((lane ^ o) << 2, __builtin_bit_cast(int, v)));
    return v;
}
constexpr int A_K = 0, A_KSLOT = 8192, A_V = 3 * A_KSLOT, A_VSLOT = 16384, A_WS = A_V + 3 * A_VSLOT, A_BT = A_WS + 8 * 256, A_END = A_BT + 320 * 4;
#define MX_PIN(x) asm volatile("" : "+v"(x))
template <int THR>
__device__ __forceinline__ void attn_pass(lds_ptr lds, unsigned lds0, int lane, int wid, const bf16_t* Qw, const bf16_t* Kh, const bf16_t* Vh, int NTwg, int NTw, int qpos_w, f32x16 (&o)[4]) {
    const int r32 = lane & 31, hi = lane >> 5;
    const unsigned koff = (unsigned)(lane * 1024 + wid * 8) * 2u, voff = (unsigned)((16 * (wid & 3) + (lane >> 2)) * 1024 + (wid >> 2) * 32 + (lane & 3) * 8) * 2u;
    const unsigned kdst = lds0 + A_K + wid * 1024, vdst = lds0 + A_V + wid * 1024;
    MLAS float* wsf = (MLAS float*)(lds + A_WS) + wid * 64;
    const MLAS float* BT = (const MLAS float*)(lds + A_BT);
    const int trofs = ((lane >> 4) & 1) * 32 + (lane & 3) * 8 + (4 * hi + ((lane & 15) >> 2)) * 64;
#define MX_DMA_K(t, ko) do { unsigned o_ = koff; asm volatile("" : "+v"(o_)); glds16((const char*)Kh + (size_t)(t) * 131072 + o_, RFL(kdst + (ko))); } while (0)
#define MX_DMA_V(t, vo) do { unsigned o_ = voff; asm volatile("" : "+v"(o_)); const char* vs_ = (const char*)Vh + (size_t)(t) * 131072 + o_; glds16(vs_, RFL(vdst + (vo))); glds16(vs_ + 128, RFL(vdst + (vo) + 8192)); } while (0)
    bf16x8 qr[4];
#pragma unroll
    for (int d0 = 0; d0 < 4; ++d0) qr[d0] = (bf16x8){0, 0, 0, 0, 0, 0, 0, 0};
    if (NTw > 0) {
#pragma unroll
        for (int d0 = 0; d0 < 4; ++d0) qr[d0] = *(const bf16x8*)(Qw + (size_t)r32 * 1024 + d0 * 16 + hi * 8);
    }
    MX_DMA_K(0, 0); MX_DMA_V(0, 0);
    if (NTwg > 1) MX_DMA_K(1, A_KSLOT);
    float l = 0.f; f32x16 negm, pA0, pA1, pB0, pB1; bool resc = false;
#pragma unroll
    for (int r = 0; r < 16; ++r) { negm[r] = 0.f; pA0[r] = 0.f; pA1[r] = 0.f; pB0[r] = 0.f; pB1[r] = 0.f; }
#pragma unroll
    for (int e0 = 0; e0 < 4; ++e0)
#pragma unroll
        for (int r = 0; r < 16; ++r) o[e0][r] = 0.f;
    u32x4 pw0, pw1, pw2, pw3;
#define MX_KLD(ko) const lds_cptr kb_ = (lds_cptr)(lds + A_K + (ko) + hi * 1024 + r32 * 16); bf16x8 kf[8]; \
        _Pragma("unroll") for (int d0 = 0; d0 < 4; ++d0) { kf[2 * d0] = *(const MLAS bf16x8*)(kb_ + d0 * 2048); kf[2 * d0 + 1] = *(const MLAS bf16x8*)(kb_ + d0 * 2048 + 512); } SBAR();
#define MX_GA(MF, P, B, W, X0, X1) do { MF; sacc += (P[B] + P[B + 1]) + (P[B + 2] + P[B + 3]); MX_PIN(sacc); W[X0] = cvtpk(P[B], P[B + 1]); W[X1] = cvtpk(P[B + 2], P[B + 3]); MX_PIN(W); SBAR(); } while (0)
#define MX_PHASE_A(C0, C1, N0, N1, ko, PRE) do { MX_KLD(ko) PRE; SBAR(); float sacc = 0.f; \
        MX_GA(N0 = MFMA32(kf[0], qr[0], negm), C0, 0, pw0, 0, 1);  MX_GA(N1 = MFMA32(kf[1], qr[0], negm), C0, 4, pw0, 2, 3); \
        MX_GA(N0 = MFMA32(kf[2], qr[1], N0),   C0, 8, pw1, 0, 1);  MX_GA(N1 = MFMA32(kf[3], qr[1], N1),   C0, 12, pw1, 2, 3); \
        MX_GA(N0 = MFMA32(kf[4], qr[2], N0),   C1, 0, pw2, 0, 1);  MX_GA(N1 = MFMA32(kf[5], qr[2], N1),   C1, 4, pw2, 2, 3); \
        MX_GA(N0 = MFMA32(kf[6], qr[3], N0),   C1, 8, pw3, 0, 1);  MX_GA(N1 = MFMA32(kf[7], qr[3], N1),   C1, 12, pw3, 2, 3); \
        l += sacc; } while (0)
#define MX_MID(N0, N1, t, FIRST) do { \
        if (64 * (t) + 63 - qpos_w > -128) { const int base = 64 * (t) - (qpos_w + r32) + 255; \
            _Pragma("unroll") for (int r = 0; r < 16; ++r) { N0[r] += BT[base + crow(r, hi)]; N1[r] += BT[base + 32 + crow(r, hi)]; } } \
        float m8_[8]; \
        _Pragma("unroll") for (int q = 0; q < 8; ++q) m8_[q] = __builtin_fmaxf(__builtin_fmaxf(N0[2 * q], N0[2 * q + 1]), __builtin_fmaxf(N1[2 * q], N1[2 * q + 1])); \
        float rm = __builtin_fmaxf(__builtin_fmaxf(__builtin_fmaxf(m8_[0], m8_[1]), __builtin_fmaxf(m8_[2], m8_[3])), __builtin_fmaxf(__builtin_fmaxf(m8_[4], m8_[5]), __builtin_fmaxf(m8_[6], m8_[7])));   \
        rm = swapmax(rm); \
        if (FIRST || __any(rm > (float)THR)) { const float dl = FIRST ? rm : __builtin_fmaxf(rm, 0.f); \
            _Pragma("unroll") for (int r = 0; r < 16; ++r) { N0[r] -= dl; N1[r] -= dl; negm[r] -= dl; } \
            const float f = __builtin_amdgcn_exp2f(-dl); l *= f; if (hi == 0) wsf[r32] = f; resc = !(FIRST); } } while (0)
#define MX_VFRAG(i) do { const s16x4 lo_ = vtr(vp_ + ((i) & 3) * 4096 + ((i) >> 2) * 1024), hh_ = vtr(vp_ + ((i) & 3) * 4096 + ((i) >> 2) * 1024 + 512); vf[(i) & 7] = (bf16x8){lo_[0], lo_[1], lo_[2], lo_[3], hh_[0], hh_[1], hh_[2], hh_[3]}; } while (0)
#define MX_PAF(k) __builtin_bit_cast(bf16x8, pw##k)
#define MX_GB(i, PK, X, B) do { if ((i) + 4 < 16) MX_VFRAG((i) + 4); o[(i) & 3] = MFMA32(PK, vf[(i) & 7], o[(i) & 3]); X[B] = __builtin_amdgcn_exp2f(X[B]); X[B + 1] = __builtin_amdgcn_exp2f(X[B + 1]); MX_PIN(X); SBAR(); } while (0)
#define MX_PHASE_B_PRE(vo) const lds_cptr vp_ = (lds_cptr)(lds + A_V + (vo) + trofs); bf16x8 vf[8]; MX_VFRAG(0); MX_VFRAG(1); MX_VFRAG(2); MX_VFRAG(3); SBAR();
#define MX_PHASE_B(N0, N1, vo, DOEXP) do { MX_PHASE_B_PRE(vo) MX_PHASE_B_BODY(N0, N1); } while (0)
#define MX_PHASE_B_BODY(N0, N1) do { \
        MX_GB(0, MX_PAF(0), N0, 0);  MX_GB(1, MX_PAF(0), N0, 2);  MX_GB(2, MX_PAF(0), N0, 4);  MX_GB(3, MX_PAF(0), N0, 6); \
        MX_GB(4, MX_PAF(1), N0, 8);  MX_GB(5, MX_PAF(1), N0, 10); MX_GB(6, MX_PAF(1), N0, 12); MX_GB(7, MX_PAF(1), N0, 14); \
        MX_GB(8, MX_PAF(2), N1, 0);  MX_GB(9, MX_PAF(2), N1, 2);  MX_GB(10, MX_PAF(2), N1, 4); MX_GB(11, MX_PAF(2), N1, 6); \
        MX_GB(12, MX_PAF(3), N1, 8); MX_GB(13, MX_PAF(3), N1, 10); MX_GB(14, MX_PAF(3), N1, 12); MX_GB(15, MX_PAF(3), N1, 14); \
        if (resc) { resc = false; \
            _Pragma("unroll") for (int r = 0; r < 16; ++r) { const float f = wsf[crow(r, hi)]; \
                _Pragma("unroll") for (int e0 = 0; e0 < 4; ++e0) o[e0][r] *= f; } } } while (0)
#define MX_STEP_WAIT(t) do { if ((t) + 1 < NTwg) MX_WAIT_BAR(3); else MX_WAIT_BAR(2); } while (0)
#define MX_STEP_DMA(t) do { if ((t) + 2 < NTwg) MX_DMA_K((t) + 2, kp); if ((t) + 1 < NTwg) MX_DMA_V((t) + 1, vq); } while (0)
#define MX_STEP_BEGIN(t) do { MX_STEP_WAIT(t); MX_STEP_DMA(t); } while (0)
#define MX_STEP_END() do { const int k_ = kp; kp = kc; kc = kn; kn = k_; const int v_ = vq; vq = vp; vp = vc; vc = v_; } while (0)
#define MX_STEP(C0, C1, N0, N1, t) do { MX_STEP_WAIT(t); MX_PHASE_A(C0, C1, N0, N1, kc, MX_STEP_DMA(t)); MX_PHASE_B_PRE(vp) MX_MID(N0, N1, t, false); MX_PHASE_B_BODY(N0, N1); MX_STEP_END(); } while (0)
#define MX_TAIL(X0, X1) do { float sacc = 0.f; \
        _Pragma("unroll") for (int r = 0; r < 16; ++r) sacc += X0[r] + X1[r]; l += sacc; \
        pw0 = (u32x4){cvtpk(X0[0], X0[1]), cvtpk(X0[2], X0[3]), cvtpk(X0[4], X0[5]), cvtpk(X0[6], X0[7])}; pw1 = (u32x4){cvtpk(X0[8], X0[9]), cvtpk(X0[10], X0[11]), cvtpk(X0[12], X0[13]), cvtpk(X0[14], X0[15])}; \
        pw2 = (u32x4){cvtpk(X1[0], X1[1]), cvtpk(X1[2], X1[3]), cvtpk(X1[4], X1[5]), cvtpk(X1[6], X1[7])}; pw3 = (u32x4){cvtpk(X1[8], X1[9]), cvtpk(X1[10], X1[11]), cvtpk(X1[12], X1[13]), cvtpk(X1[14], X1[15])}; \
        const lds_cptr vp_ = (lds_cptr)(lds + A_V + vp + trofs); bf16x8 vf[8]; \
        _Pragma("unroll") for (int ks = 0; ks < 4; ++ks) { \
            MX_VFRAG(4 * ks); MX_VFRAG(4 * ks + 1); MX_VFRAG(4 * ks + 2); MX_VFRAG(4 * ks + 3); \
            const bf16x8 pk_ = ks == 0 ? MX_PAF(0) : ks == 1 ? MX_PAF(1) : ks == 2 ? MX_PAF(2) : MX_PAF(3); \
            o[0] = MFMA32(pk_, vf[(4 * ks) & 7], o[0]); o[1] = MFMA32(pk_, vf[(4 * ks + 1) & 7], o[1]); o[2] = MFMA32(pk_, vf[(4 * ks + 2) & 7], o[2]); o[3] = MFMA32(pk_, vf[(4 * ks + 3) & 7], o[3]); } } while (0)
    MX_WAIT_BAR(0);
    asm volatile("" : "+v"(qr[0]), "+v"(qr[1]), "+v"(qr[2]), "+v"(qr[3]));
    int kp = 2 * A_KSLOT, kc = 0, kn = A_KSLOT, vq = A_VSLOT, vp = 2 * A_VSLOT, vc = 0;
    int t = 0; bool inA = true;
    if (NTw > 0) {
        if (2 < NTwg) MX_DMA_K(2, kp); if (1 < NTwg) MX_DMA_V(1, vq);
        { MX_KLD(kc) pA0 = MFMA32(kf[0], qr[0], negm); pA1 = MFMA32(kf[1], qr[0], negm);
#pragma unroll
          for (int d0 = 1; d0 < 4; ++d0) { pA0 = MFMA32(kf[2 * d0], qr[d0], pA0); pA1 = MFMA32(kf[2 * d0 + 1], qr[d0], pA1); } }
        MX_MID(pA0, pA1, 0, true);
#pragma unroll
        for (int r = 0; r < 16; ++r) { pA0[r] = __builtin_amdgcn_exp2f(pA0[r]); pA1[r] = __builtin_amdgcn_exp2f(pA1[r]); }
        MX_STEP_END(); t = 1;
        for (; t + 1 < NTw; t += 2) { MX_STEP(pA0, pA1, pB0, pB1, t); MX_STEP(pB0, pB1, pA0, pA1, t + 1); }
        if (t < NTw) { MX_STEP(pA0, pA1, pB0, pB1, t); ++t; inA = false; }
    } else {
        if (2 < NTwg) MX_DMA_K(2, kp); if (1 < NTwg) MX_DMA_V(1, vq);
        MX_STEP_END(); t = 1;
    }
    bool pend = NTw > 0;
    for (; t < NTwg; ++t) {
        MX_STEP_BEGIN(t);
        if (pend) { pend = false; if (inA) MX_TAIL(pA0, pA1); else MX_TAIL(pB0, pB1); }
        MX_STEP_END();
    }
    MX_WAIT_BAR(0);
    if (pend) { if (inA) MX_TAIL(pA0, pA1); else MX_TAIL(pB0, pB1); }
    MX_WAIT_BAR(0);
    if (NTw > 0) {
        l = swapsum(l);
        if (hi == 0) wsf[32 + r32] = l;
#pragma unroll
        for (int r = 0; r < 16; ++r) { const float rl = __builtin_amdgcn_rcpf(wsf[32 + crow(r, hi)]);
#pragma unroll
            for (int e0 = 0; e0 < 4; ++e0) o[e0][r] *= rl; }
    }
#undef MX_DMA_K
#undef MX_DMA_V
#undef MX_KLD
#undef MX_GA
#undef MX_PHASE_A
#undef MX_MID
#undef MX_VFRAG
#undef MX_PAF
#undef MX_GB
#undef MX_PHASE_B
#undef MX_PHASE_B_PRE
#undef MX_PHASE_B_BODY
#undef MX_STEP_BEGIN
#undef MX_STEP_WAIT
#undef MX_STEP_DMA
#undef MX_STEP_END
#undef MX_STEP
#undef MX_TAIL
}
__device__ __forceinline__ void attn_unit(lds_ptr lds, unsigned lds0, int tid, const bf16_t* Q, const bf16_t* Kseq, const bf16_t* Vseq, int qrow0, int pos0, int NTwg, int nact, int h,
                                          const float* BTg, int layer, const float* subg, float* scr, bf16_t* MIX) {
    asm volatile("" : "+v"(tid));
    const int lane = tid & 63, wid = __builtin_amdgcn_readfirstlane(tid >> 6), r32 = lane & 31, hi = lane >> 5;
    if (tid < 320) ((MLAS float*)(lds + A_BT))[tid] = BTg[h * 320 + tid];
    const int NTw = wid < nact ? (pos0 + 32 * wid) / 64 + 1 : 0, qpos_w = pos0 + 32 * wid;
    const bf16_t* Qw = Q + (size_t)(qrow0 + 32 * (wid < nact ? wid : 0)) * 1024 + h * 128;
    float* myscr = scr + (size_t)wid * 4096 + lane * 64;
    f32x16 o[4];
    attn_pass<8>(lds, lds0, lane, wid, Qw, Kseq + h * 128, Vseq + h * 128, NTwg, NTw, qpos_w, o);
    if (NTw > 0) {
#pragma unroll
        for (int e0 = 0; e0 < 4; ++e0)
#pragma unroll
            for (int r = 0; r < 16; r += 4) *(f32x4*)(myscr + e0 * 16 + r) = (f32x4){o[e0][r], o[e0][r + 1], o[e0][r + 2], o[e0][r + 3]};
    }
    asm volatile("s_waitcnt vmcnt(0)" ::: "memory");
    attn_pass<8>(lds, lds0, lane, wid, Qw + 64, Kseq + h * 128 + 64, Vseq + h * 128, NTwg, NTw, qpos_w, o);
    if (NTw > 0) {
        const float lam = __builtin_bit_cast(float, __builtin_amdgcn_readfirstlane(__builtin_bit_cast(int, BTg[2560 + layer]))), oml = BTg[2562 + layer];
        float ss[16];
#pragma unroll
        for (int r = 0; r < 16; ++r) ss[r] = 0.f;
        f32x4 sv[16];
        asm volatile("global_load_dwordx4 %0, %16, off sc1\n\tglobal_load_dwordx4 %1, %16, off offset:16 sc1\n\tglobal_load_dwordx4 %2, %16, off offset:32 sc1\n\tglobal_load_dwordx4 %3, %16, off offset:48 sc1\n\t"
                     "global_load_dwordx4 %4, %16, off offset:64 sc1\n\tglobal_load_dwordx4 %5, %16, off offset:80 sc1\n\tglobal_load_dwordx4 %6, %16, off offset:96 sc1\n\tglobal_load_dwordx4 %7, %16, off offset:112 sc1\n\t"
                     "global_load_dwordx4 %8, %16, off offset:128 sc1\n\tglobal_load_dwordx4 %9, %16, off offset:144 sc1\n\tglobal_load_dwordx4 %10, %16, off offset:160 sc1\n\tglobal_load_dwordx4 %11, %16, off offset:176 sc1\n\t"
                     "global_load_dwordx4 %12, %16, off offset:192 sc1\n\tglobal_load_dwordx4 %13, %16, off offset:208 sc1\n\tglobal_load_dwordx4 %14, %16, off offset:224 sc1\n\tglobal_load_dwordx4 %15, %16, off offset:240 sc1\n\t"
                     "s_waitcnt vmcnt(0)"
                     : "=&v"(sv[0]), "=&v"(sv[1]), "=&v"(sv[2]), "=&v"(sv[3]), "=&v"(sv[4]), "=&v"(sv[5]), "=&v"(sv[6]), "=&v"(sv[7]),
                       "=&v"(sv[8]), "=&v"(sv[9]), "=&v"(sv[10]), "=&v"(sv[11]), "=&v"(sv[12]), "=&v"(sv[13]), "=&v"(sv[14]), "=&v"(sv[15])
                     : "v"(myscr) : "memory");
#pragma unroll
        for (int e0 = 0; e0 < 4; ++e0)
#pragma unroll
            for (int r = 0; r < 16; ++r) { const float d = sv[e0 * 4 + (r >> 2)][r & 3] - lam * o[e0][r]; o[e0][r] = d; ss[r] += d * d; }
#pragma unroll
        for (int r = 0; r < 16; ++r) ss[r] = oml * __builtin_amdgcn_rsqf(half_sum(ss[r], lane) * (1.0f / 128.0f) + 1e-5f);
        bf16_t* mp = MIX + (size_t)(qrow0 + 32 * wid + 4 * hi) * 2048 + 512 + h * 128 + r32;
        const float sg0 = subg[r32], sg1 = subg[32 + r32], sg2 = subg[64 + r32], sg3 = subg[96 + r32];
#pragma unroll
        for (int r = 0; r < 16; ++r) { int z_ = 0; asm volatile("" : "+v"(z_)); bf16_t* mr = mp + (size_t)crow(r, 0) * 2048 + z_;
#pragma unroll
            for (int e0 = 0; e0 < 4; ++e0) { const unsigned w = cvtpk(o[e0][r] * ss[r] * (e0 == 0 ? sg0 : e0 == 1 ? sg1 : e0 == 2 ? sg2 : sg3), 0.f); mr[e0 * 32] = (bf16_t)(w & 0xffffu); } }
    }
    asm volatile("s_waitcnt vmcnt(0)" ::: "memory");
}
__device__ __forceinline__ void ret_kv_unit(lds_ptr lds, unsigned lds0, int tid, const bf16_t* RKh, const bf16_t* RVh, int ntile, float* KVTu) {
    asm volatile("" : "+v"(tid));
    const int lane = tid & 63, wid = __builtin_amdgcn_readfirstlane(tid >> 6), r32 = lane & 31, hi = lane >> 5;
    const int trofs = ((lane >> 4) & 1) * 32 + (lane & 3) * 8 + (4 * hi + ((lane & 15) >> 2)) * 64;
    const size_t so = (size_t)(16 * (wid & 3) + (lane >> 2)) * 512 + (wid >> 2) * 32 + (lane & 3) * 8;
    for (int jt = 0; jt < ntile; ++jt) {
        const bf16_t* ks = RKh + (size_t)jt * 64 * 512 + so; const bf16_t* vs = RVh + (size_t)jt * 64 * 512 + so;
        glds16(ks, RFL(lds0 + jt * 16384 + wid * 1024)); glds16(ks + 64, RFL(lds0 + jt * 16384 + 8192 + wid * 1024));
        glds16(vs, RFL(lds0 + 65536 + jt * 16384 + wid * 1024)); glds16(vs + 64, RFL(lds0 + 65536 + jt * 16384 + 8192 + wid * 1024));
    }
    MX_WAIT_BAR(0);
    const int e0 = wid >> 1, d0a = 2 * (wid & 1);
    f32x16 acc[2];
#pragma unroll
    for (int i = 0; i < 2; ++i)
#pragma unroll
        for (int r = 0; r < 16; ++r) acc[i][r] = 0.f;
    for (int jt = 0; jt < ntile; ++jt) {
#pragma unroll
        for (int ks = 0; ks < 4; ++ks) {
            const lds_cptr vp = (lds_cptr)(lds + 65536 + jt * 16384 + e0 * 4096 + ks * 1024 + trofs);
            const s16x4 alo = vtr(vp), ahi = vtr(vp + 512);
            const bf16x8 af = {alo[0], alo[1], alo[2], alo[3], ahi[0], ahi[1], ahi[2], ahi[3]};
#pragma unroll
            for (int i = 0; i < 2; ++i) {
                const lds_cptr kp = (lds_cptr)(lds + jt * 16384 + (d0a + i) * 4096 + ks * 1024 + trofs);
                const s16x4 blo = vtr(kp), bhi = vtr(kp + 512);
                const bf16x8 bfr = {blo[0], blo[1], blo[2], blo[3], bhi[0], bhi[1], bhi[2], bhi[3]};
                acc[i] = MFMA32(af, bfr, acc[i]);
            }
        }
    }
    float* kp0 = KVTu + (32 * e0 + 4 * hi) * 128 + 32 * d0a + r32;
#pragma unroll
    for (int r = 0; r < 16; ++r) { int z_ = 0; asm volatile("" : "+v"(z_)); float* kr = kp0 + crow(r, 0) * 128 + z_; kr[0] = acc[0][r]; kr[32] = acc[1][r]; }
    MX_WAIT_BAR(0);
}
__device__ __forceinline__ void ret_out_unit(lds_ptr lds, unsigned lds0, int tid, const bf16_t* RQh, const bf16_t* RKh, const bf16_t* RVh, const bf16_t* RGh, const bf16_t* SPu,
                                             int ntile, int nact, bf16_t* MIXh) {
    asm volatile("" : "+v"(tid));
    const int lane = tid & 63, wid = __builtin_amdgcn_readfirstlane(tid >> 6), r32 = lane & 31, hi = lane >> 5;
    const int trofs = ((lane >> 4) & 1) * 32 + (lane & 3) * 8 + (4 * hi + ((lane & 15) >> 2)) * 64;
    const size_t so = (size_t)(16 * (wid & 3) + (lane >> 2)) * 512 + (wid >> 2) * 32 + (lane & 3) * 8;
    for (int jt = 0; jt < ntile; ++jt) {
        const bf16_t* ks = RKh + (size_t)(jt * 64 + lane) * 512 + wid * 8; const bf16_t* vs = RVh + (size_t)jt * 64 * 512 + so;
        glds16(ks, RFL(lds0 + jt * 16384 + wid * 1024)); glds16(ks + 64, RFL(lds0 + jt * 16384 + 8192 + wid * 1024));
        glds16(vs, RFL(lds0 + 65536 + jt * 16384 + wid * 1024)); glds16(vs + 64, RFL(lds0 + 65536 + jt * 16384 + 8192 + wid * 1024));
    }
    const bool act = wid < nact;
    bf16x8 qr[8]; f32x16 o[4];
#pragma unroll
    for (int e0 = 0; e0 < 4; ++e0)
#pragma unroll
        for (int r = 0; r < 16; ++r) o[e0][r] = 0.f;
    if (act) {
#pragma unroll
        for (int kd = 0; kd < 8; ++kd) qr[kd] = *(const bf16x8*)(RQh + (size_t)(32 * wid + r32) * 512 + kd * 16 + hi * 8);
#pragma unroll
        for (int e0 = 0; e0 < 4; ++e0) { bf16x8 sf[8];
#pragma unroll
            for (int kd = 0; kd < 8; ++kd) sf[kd] = *(const bf16x8*)(SPu + (size_t)(32 * e0 + r32) * 128 + 16 * kd + 8 * hi);
            SBAR();
#pragma unroll
            for (int kd = 0; kd < 8; ++kd) o[e0] = MFMA32(qr[kd], sf[kd], o[e0]);
            SBAR(); }
    } else {
#pragma unroll
        for (int kd = 0; kd < 8; ++kd) qr[kd] = (bf16x8){0, 0, 0, 0, 0, 0, 0, 0};
    }
    MX_WAIT_BAR(0);
    if (act) {
        const int jd = wid >> 1; f32x16 zero;
#pragma unroll
        for (int r = 0; r < 16; ++r) zero[r] = 0.f;

#ifndef RO_SKIP_INNER
#define RO_SKIP_INNER 0
#endif
        if (!RO_SKIP_INNER) for (int jt = 0; jt <= jd; ++jt) {
            f32x16 p0, p1;
#ifndef RO_CONST_P
            qkt<8>(p0, p1, (lds_cptr)(lds + jt * 16384 + hi * 1024 + r32 * 16), qr, zero);
#else
            for (int r = 0; r < 16; ++r) { p0[r] = 1.0f; p1[r] = 0.5f; }
#endif
            if (jt == jd) { const int q = 32 * wid + r32;
#pragma unroll
                for (int r = 0; r < 16; ++r) { const int k0 = 64 * jt + crow(r, hi); p0[r] = (k0 <= q) ? p0[r] : 0.f; p1[r] = (k0 + 32 <= q) ? p1[r] : 0.f; } }
            bf16x8 pa[4]; packP(pa, p0, p1);
            pv4(o, (lds_cptr)(lds + 65536 + jt * 16384 + trofs), pa);
        }
        float mu[16];
#pragma unroll
        for (int r = 0; r < 16; ++r) { mu[r] = half_sum((o[0][r] + o[1][r]) + (o[2][r] + o[3][r]), lane) * (1.0f / 128.0f); }
        float rs[16];
#pragma unroll
        for (int r = 0; r < 16; ++r) { float q = 0.f;
#pragma unroll
            for (int e0 = 0; e0 < 4; ++e0) { const float d = o[e0][r] - mu[r]; o[e0][r] = d; q += d * d; }
            rs[r] = __builtin_amdgcn_rsqf(half_sum(q, lane) * (1.0f / 128.0f) + 1e-5f); }
        const bf16_t* gp0 = RGh + (size_t)(32 * wid + 4 * hi) * 512 + r32; bf16_t* mp0 = MIXh + (size_t)(32 * wid + 4 * hi) * 2048 + r32;
        unsigned short gv[16][4];
#pragma unroll
        for (int r = 0; r < 16; ++r) { int z_ = 0; asm volatile("" : "+v"(z_)); const bf16_t* gr = gp0 + (size_t)crow(r, 0) * 512 + z_;
#pragma unroll
            for (int e0 = 0; e0 < 4; ++e0) gv[r][e0] = gr[e0 * 32]; }
        SBAR();
#pragma unroll
        for (int r = 0; r < 16; ++r) { int z_ = 0; asm volatile("" : "+v"(z_)); bf16_t* mr = mp0 + (size_t)crow(r, 0) * 2048 + z_;
#pragma unroll
            for (int e0 = 0; e0 < 4; ++e0) { const unsigned w = cvtpk(o[e0][r] * rs[r] * bf2f(gv[r][e0]), 0.f); mr[e0 * 32] = (bf16_t)(w & 0xffffu); } }
    }
    MX_WAIT_BAR(0);
}
#undef RFL
}
constexpr int NWAVES = 8;
constexpr int DM = 2048, MP = 32768, MS = 512, M = MP + MS, DFF = 5632, DIN = 6144;
#ifndef H_PITCH
#define H_PITCH 5696
#endif
constexpr int HP = H_PITCH;
constexpr float ALPHA = 1.4142135623730951f, LN_EPS = 1e-5f;
constexpr size_t HMiB = 512u * 1024u;
constexpr size_t WS_CTL = 0, CTL_ZERO_BYTES = 2 * HMiB;
constexpr size_t WS_TAB = 2 * HMiB;
constexpr size_t WS_CS = 4 * HMiB;
constexpr size_t WS_WGU = 20 * HMiB;
constexpr size_t WS_WD = WS_WGU + 352 * HMiB;
constexpr size_t WS_WIN = WS_WD + 180 * HMiB;
constexpr size_t WS_WOUT = WS_WIN + 96 * HMiB;
constexpr size_t WS_XB = WS_WOUT + 32 * HMiB;
constexpr size_t WS_KS = WS_XB + 260 * HMiB;
constexpr size_t WS_VS = WS_KS + 132 * HMiB;
constexpr size_t WS_R = WS_VS + 132 * HMiB;
constexpr size_t WS_H = WS_R;
constexpr size_t WS_U = WS_R, WS_Q = WS_U + 65 * HMiB, WS_KB = WS_Q + 130 * HMiB, WS_VB = WS_KB + 128 * HMiB, WS_RQ = WS_VB + 128 * HMiB, WS_RK = WS_RQ + 65 * HMiB,
                 WS_RV = WS_RK + 65 * HMiB, WS_RG = WS_RV + 65 * HMiB, WS_KVT = WS_RG + 65 * HMiB, WS_SP = WS_KVT + 68 * HMiB, WS_ASCR = WS_SP + 34 * HMiB, WS_END = WS_ASCR + 64 * HMiB;
constexpr size_t WS_SLAB = WS_R + 740 * HMiB;
static_assert(WS_SLAB >= WS_H + (size_t)M * HP * 2 && WS_SLAB + (size_t)11 * 512 * 2048 * 4 <= WS_END && WS_WD + (size_t)4 * DM * HP * 2 <= WS_WIN, "slab / down-copy placement");
static_assert(WS_H + (size_t)M * HP * 2 <= WS_END, "H fits the shared region");
constexpr int CW_TMO = 0, CW_CODE = 1, CW_BAR = 4096, CW_Q = 8192;
constexpr int RING_OFF = 0, RING_BYTES = 131072, LDSCTL_OFF = RING_BYTES, MISC_OFF = LDSCTL_OFF + 320, LDS_BYTES = 147456;

#define GAS __attribute__((address_space(1)))
#define LAS __attribute__((address_space(3)))
typedef unsigned short bf16;
typedef unsigned v4u __attribute__((ext_vector_type(4)));
typedef unsigned v2u __attribute__((ext_vector_type(2)));
typedef float f32x4 __attribute__((ext_vector_type(4)));
typedef GAS unsigned gu32;
#define RLX_AGENT __ATOMIC_RELAXED, __HIP_MEMORY_SCOPE_AGENT
#define LDS_WAIT() asm volatile("s_waitcnt lgkmcnt(0)" ::: "memory")
#define VM_WAIT() asm volatile("s_waitcnt vmcnt(0)" ::: "memory")
__device__ __forceinline__ unsigned pk2(float lo, float hi) { return pg8::cvt_pk_bf16(lo, hi); }
static_assert(WS_VB - WS_KB == pg8::EpiIn::D_KV * 2 && WS_VS - WS_KS == pg8::EpiIn::D_S * 2 && WS_RK - WS_RQ == pg8::EpiIn::D_R * 2 && WS_RG - WS_RV == pg8::EpiIn::D_R * 2, "EpiIn's pointer deltas match the workspace map");
#define XB_TMO      128
#define XB_XCNT(j)  (256  + 64 * (j))
#define XB_XSUB(j)  (1280 + 64 * (j))
#define XB_XGEN(j)  (2304 + 64 * (j))
#define XB_TOP      3328
#define XB_TOPGEN   3392
#define XCD_BAR_WORDS 3456
#define XB_SPIN_CAP (1u << 22)

__device__ __forceinline__ unsigned xb_ld(unsigned* p)              { return __hip_atomic_load(p, __ATOMIC_RELAXED, __HIP_MEMORY_SCOPE_AGENT); }
__device__ __forceinline__ unsigned xb_add(unsigned* p, unsigned v) { return __hip_atomic_fetch_add(p, v, __ATOMIC_RELAXED, __HIP_MEMORY_SCOPE_AGENT); }
__device__ __forceinline__ unsigned xb_xcc_id() { return (unsigned)__builtin_amdgcn_s_getreg((3 << 11) | 20) & 0xFu; }
#define XB_SPIN(cond, bar) do { unsigned _sp = 0; while (cond) { __builtin_amdgcn_s_sleep(1); \
    if ((++_sp & 255u) == 0u) { if (xb_ld(&(bar)[XB_TMO])) break; if (_sp > XB_SPIN_CAP) { atomicAdd(&(bar)[XB_TMO], 1u); break; } } } } while (0)

struct XcdBarrier {
    unsigned* bar; unsigned x;
    volatile LAS unsigned* st;
};

__device__ __forceinline__ XcdBarrier xcd_barrier_post(unsigned* bar, volatile LAS unsigned* st) {
    XcdBarrier b; b.bar = bar; b.x = xb_xcc_id(); b.st = st;
    if (threadIdx.x == 0) (void)xb_add(&bar[XB_XCNT(b.x)], 1u);
    return b;
}
__device__ __forceinline__ void xcd_barrier_complete(unsigned* bar, unsigned x, unsigned& nloc, unsigned& nx) {
    const unsigned G = gridDim.x * gridDim.y * gridDim.z;
    unsigned sum, cnt, mine, sp = 0u;
    for (;;) {
        sum = 0u; cnt = 0u; mine = 0u;
#pragma unroll
        for (unsigned j = 0; j < 16; ++j) { const unsigned c = xb_ld(&bar[XB_XCNT(j)]); sum += c; cnt += (c > 0u) ? 1u : 0u; mine = (j == x) ? c : mine; }
        if (sum == G) break;
        __builtin_amdgcn_s_sleep(1);
        if ((++sp & 255u) == 0u) { if (xb_ld(&bar[XB_TMO])) break; if (sp > XB_SPIN_CAP) { atomicAdd(&bar[XB_TMO], 1u); break; } }
    }
    nloc = mine > 0u ? mine : 1u; nx = cnt > 0u ? cnt : 1u;
}

__device__ __forceinline__ void xcd_barrier(const XcdBarrier& b, int tid_x  ) {
    asm volatile("s_waitcnt vmcnt(0)" ::: "memory");
    __syncthreads();
    if (tid_x == 0) {
        unsigned* bar = b.bar;
        unsigned bx_ = b.x; asm volatile("" : "+s"(bx_));
#define BX_ bx_
        __builtin_amdgcn_s_waitcnt(0);
        unsigned nloc = b.st[0], nx = b.st[1];
        if (nloc == 0u) { xcd_barrier_complete(bar, BX_, nloc, nx); b.st[0] = nloc; b.st[1] = nx; }
        const unsigned old = xb_add(&bar[XB_XSUB(BX_)], 1u);
        const unsigned gen = old / nloc;
        if (old + 1u == (gen + 1u) * nloc) {
            __builtin_amdgcn_fence(__ATOMIC_RELEASE, "agent");
            asm volatile("s_waitcnt vmcnt(0)" ::: "memory");
            const unsigned og = xb_add(&bar[XB_TOP], 1u);
            const unsigned tg = og / nx;
            if (og + 1u == (tg + 1u) * nx) xb_add(&bar[XB_TOPGEN], 1u);
            else XB_SPIN(xb_ld(&bar[XB_TOPGEN]) == tg, bar);
            __builtin_amdgcn_fence(__ATOMIC_ACQUIRE, "agent");
            xb_add(&bar[XB_XGEN(BX_)], 1u);
            asm volatile("s_waitcnt vmcnt(0)" ::: "memory");
        } else {
            XB_SPIN(xb_ld(&bar[XB_XGEN(BX_)]) == gen, bar);
            __builtin_amdgcn_fence(__ATOMIC_ACQUIRE, "agent");
            asm volatile("s_waitcnt vmcnt(0)" ::: "memory");
        }
    }
    __syncthreads();
}
__device__ __forceinline__ float wave_sum(float v, int lane) {
#pragma unroll
    for (int o = 1; o < 64; o <<= 1) v += __builtin_bit_cast(float, __builtin_amdgcn_ds_bpermute((lane ^ o) << 2, __builtin_bit_cast(int, v)));
    return v;
}
__device__ __forceinline__ int map_row(int code, int n) {
    if (code == 0) return n;
    if (code == 1) return ((n >> 7) << 8) + (n & 127);
    if (code == 2) return ((n >> 7) << 8) + 128 + (n & 127);
    if (n < 512) return ((n >> 7) << 8) + (n & 127);
    if (n < 1024) { const int m = n - 512; return ((m >> 7) << 8) + 128 + (m & 127); }
    if (n >= 4096 && n < 5120) { const int d = n & 127; return (n & ~127) + (d < 64 ? 2 * d : 2 * (d - 64) + 1); }
    return n;
}
__device__ __forceinline__ void p0_transpose_item(const float* W, int K, int N, bf16* WT, int code, LAS float* scr, int item, int lane, int ldw = 0) {
    if (ldw == 0) ldw = K;
    const int nblk = N / 32, kb = item / nblk, nb = item % nblk, k0 = 64 * kb, n0 = 32 * nb;
#pragma unroll 8
    for (int i = 0; i < 32; ++i) { const int kk = 2 * i + (lane >> 5); scr[kk * 33 + (lane & 31)] = W[(size_t)(k0 + kk) * N + n0 + (lane & 31)]; }
    LDS_WAIT(); asm volatile("" ::: "memory");
    const int c = lane & 7;
#pragma unroll
    for (int j = 0; j < 4; ++j) { const int n = (lane >> 3) + 8 * j; const LAS float* s = scr + (8 * c) * 33 + n;
        v4u o; o.x = pk2(s[0 * 33], s[1 * 33]); o.y = pk2(s[2 * 33], s[3 * 33]); o.z = pk2(s[4 * 33], s[5 * 33]); o.w = pk2(s[6 * 33], s[7 * 33]);
        *(GAS v4u*)(WT + (size_t)map_row(code, n0 + n) * ldw + k0 + 8 * c) = o; }
    LDS_WAIT(); asm volatile("" ::: "memory");
}
__device__ __forceinline__ void ln_pass(bf16* XBp, float* fout_base, const float* g, const float* b, int lane, int gw, int NGW, const float* slab, int nsplit, float alpha, float scale, int m_end, int m0 = 0) {
    gw += m0;
    f32x4 gg[8], bb[8];
#pragma unroll
    for (int j = 0; j < 4; ++j) { const int c0 = lane * 8 + 512 * j; gg[2 * j] = *(const GAS f32x4*)(g + c0); gg[2 * j + 1] = *(const GAS f32x4*)(g + c0 + 4); bb[2 * j] = *(const GAS f32x4*)(b + c0); bb[2 * j + 1] = *(const GAS f32x4*)(b + c0 + 4); }
    v4u cur[4];
    if (gw < m_end) {
#pragma unroll
        for (int j = 0; j < 4; ++j) cur[j] = ((const GAS v4u*)(XBp + (size_t)gw * DM) + lane)[64 * j];
    }
    for (int m = gw; m < m_end; m += NGW) {
        v4u nx[4]; const int mn = m + NGW;
        if (mn < m_end) {
#pragma unroll
            for (int j = 0; j < 4; ++j) nx[j] = ((const GAS v4u*)(XBp + (size_t)mn * DM) + lane)[64 * j];
        }
        float v[32]; float s = 0.f;
#pragma unroll
        for (int j = 0; j < 4; ++j)
#pragma unroll
            for (int q = 0; q < 4; ++q) { v[j * 8 + 2 * q] = __uint_as_float(cur[j][q] << 16); v[j * 8 + 2 * q + 1] = __uint_as_float(cur[j][q] & 0xffff0000u); }
        if (m >= MP) { const float* part = slab + (size_t)(m - MP) * DM;
            f32x4 a[8];
#pragma unroll
            for (int q = 0; q < 8; ++q) a[q] = (f32x4){0.f, 0.f, 0.f, 0.f};
            for (int ks = 0; ks < nsplit; ++ks) { const float* pp = part + (size_t)ks * 512 * 2048 + lane * 8; f32x4 t8[8];
#pragma unroll
                for (int j = 0; j < 4; ++j) { t8[2 * j] = *(const GAS f32x4*)(pp + 512 * j); t8[2 * j + 1] = *(const GAS f32x4*)(pp + 512 * j + 4); }
                __builtin_amdgcn_sched_barrier(0);
#pragma unroll
                for (int q = 0; q < 8; ++q) a[q] += t8[q]; }
#pragma unroll
            for (int j = 0; j < 4; ++j)
#pragma unroll
                for (int q = 0; q < 4; ++q) { v[j * 8 + q] = v[j * 8 + q] * alpha + a[2 * j][q] * scale; v[j * 8 + 4 + q] = v[j * 8 + 4 + q] * alpha + a[2 * j + 1][q] * scale; }
        }
#pragma unroll
        for (int i = 0; i < 32; ++i) s += v[i];
        const float mean = wave_sum(s, lane) * (1.f / DM); float s2 = 0.f;
#pragma unroll
        for (int i = 0; i < 32; ++i) { v[i] -= mean; s2 += v[i] * v[i]; }
        const float rstd = 1.f / sqrtf(wave_sum(s2, lane) * (1.f / DM) + LN_EPS);
        GAS v4u* xr = (GAS v4u*)(XBp + (size_t)m * DM) + lane;
#pragma unroll
        for (int j = 0; j < 4; ++j) { const int c0 = lane * 8 + 512 * j; f32x4 o0, o1;
#pragma unroll
            for (int q = 0; q < 4; ++q) { o0[q] = v[j * 8 + q] * rstd * gg[2 * j][q] + bb[2 * j][q]; o1[q] = v[j * 8 + 4 + q] * rstd * gg[2 * j + 1][q] + bb[2 * j + 1][q]; }
            if (fout_base) { float* fo = fout_base + (size_t)m * DM + c0; __builtin_nontemporal_store(o0, (GAS f32x4*)fo); __builtin_nontemporal_store(o1, (GAS f32x4*)(fo + 4)); }
            else { v4u w; w.x = pk2(o0[0], o0[1]); w.y = pk2(o0[2], o0[3]); w.z = pk2(o1[0], o1[1]); w.w = pk2(o1[2], o1[3]); xr[64 * j] = w; } }
#pragma unroll
        for (int j = 0; j < 4; ++j) cur[j] = nx[j];
    }
}
template <int NS>
__device__ __forceinline__ void ln_sample(LAS unsigned char* lds, bf16* XBp, const float* g, const float* b, int tid, int vcu, int G, const float* slab, float alpha, float scale) {
    const int lane = tid & 63, wave = tid >> 6, q = wave & 3, rs = wave >> 2, c0 = q * 512 + lane * 8;
    LAS float* ex = (LAS float*)lds;
    const f32x4 g0 = *(const GAS f32x4*)(g + c0), g1 = *(const GAS f32x4*)(g + c0 + 4), b0 = *(const GAS f32x4*)(b + c0), b1 = *(const GAS f32x4*)(b + c0 + 4);
    for (int r2 = vcu; r2 < MS / 2; r2 += G) {
        const int ms = r2 * 2 + rs;
        GAS v4u* xp = (GAS v4u*)(XBp + (size_t)(MP + ms) * DM + c0);
        const v4u xv = *xp;
        const float* pp = slab + (size_t)ms * DM + c0;
        f32x4 t[2 * NS];
#pragma unroll
        for (int ks = 0; ks < NS; ++ks) { t[2 * ks] = *(const GAS f32x4*)(pp + (size_t)ks * 512 * 2048); t[2 * ks + 1] = *(const GAS f32x4*)(pp + (size_t)ks * 512 * 2048 + 4); }
        __builtin_amdgcn_sched_barrier(0);
        f32x4 a0 = (f32x4){0.f, 0.f, 0.f, 0.f}, a1 = a0;
#pragma unroll
        for (int ks = 0; ks < NS; ++ks) { a0 += t[2 * ks]; a1 += t[2 * ks + 1]; }
        float v[8]; float s = 0.f;
#pragma unroll
        for (int i = 0; i < 4; ++i) { v[2 * i] = __uint_as_float(xv[i] << 16); v[2 * i + 1] = __uint_as_float(xv[i] & 0xffff0000u); }
#pragma unroll
        for (int i = 0; i < 4; ++i) { v[i] = v[i] * alpha + a0[i] * scale; v[4 + i] = v[4 + i] * alpha + a1[i] * scale; }
#pragma unroll
        for (int i = 0; i < 8; ++i) s += v[i];
        const float ws1 = wave_sum(s, lane);
        if (lane == 0) ex[rs * 4 + q] = ws1;
        __syncthreads();
        const float mean = (((ex[rs * 4] + ex[rs * 4 + 1]) + ex[rs * 4 + 2]) + ex[rs * 4 + 3]) * (1.f / DM); float s2 = 0.f;
#pragma unroll
        for (int i = 0; i < 8; ++i) { v[i] -= mean; s2 += v[i] * v[i]; }
        const float ws2 = wave_sum(s2, lane);
        if (lane == 0) ex[8 + rs * 4 + q] = ws2;
        __syncthreads();
        const float rstd = 1.f / sqrtf((((ex[8 + rs * 4] + ex[8 + rs * 4 + 1]) + ex[8 + rs * 4 + 2]) + ex[8 + rs * 4 + 3]) * (1.f / DM) + LN_EPS);
        f32x4 o0, o1;
#pragma unroll
        for (int i = 0; i < 4; ++i) { o0[i] = v[i] * rstd * g0[i] + b0[i]; o1[i] = v[4 + i] * rstd * g1[i] + b1[i]; }
        v4u w; w.x = pk2(o0[0], o0[1]); w.y = pk2(o0[2], o0[3]); w.z = pk2(o1[0], o1[1]); w.w = pk2(o1[2], o1[3]);
        *xp = w;
        __syncthreads();
    }
}
__device__ __forceinline__ void conv_item(LAS unsigned char* lds, int tid, int item, int l, const bf16* U, const float* cache_conv, const float* cw, const float* cbias, const float* cg, const float* cbeta, bf16* MIX) {
    asm volatile("" : "+v"(tid));
    const int lane = tid & 63, wid = tid >> 6;
    int b, t0, urow0; const float* hist = nullptr;
    if (item < 1024) { b = item >> 9; t0 = (item & 511) * 32; urow0 = b * 16384; }
    else { const int i2 = item - 1024; b = i2 >> 1; t0 = (i2 & 1) * 32; urow0 = 32768 + b * 64; hist = cache_conv + (size_t)((l * 8 + b) * 30) * 512; }
    { v4u st[8];
#pragma unroll
      for (int q = 0; q < 8; ++q) { const int idx = tid + 512 * q, lr = idx >> 6, ch = idx & 63, t = t0 - 30 + lr; v4u v = (v4u){0u, 0u, 0u, 0u};
        if (idx < 62 * 64) {
          if (t >= 0) v = *(const GAS v4u*)(U + (size_t)(urow0 + t) * 512 + ch * 8);
          else if (hist) { const float* hp = hist + (size_t)(30 + t) * 512 + ch * 8; const f32x4 a = *(const GAS f32x4*)hp, c = *(const GAS f32x4*)(hp + 4);
            v.x = pk2(a.x, a.y); v.y = pk2(a.z, a.w); v.z = pk2(c.x, c.y); v.w = pk2(c.z, c.w); } }
        st[q] = v; }
      __builtin_amdgcn_sched_barrier(0);
#pragma unroll
      for (int q = 0; q < 8; ++q) { const int idx = tid + 512 * q, lr = idx >> 6, ch = idx & 63; if (idx < 62 * 64) *(LAS v4u*)(lds + (size_t)(lr * 512 + ch * 8) * 2) = st[q]; } }
    __syncthreads();
    const int c = tid;
    float w[31];
    { const float* wp = cw + (size_t)l * 31 * 512 + c;
#pragma unroll
      for (int j = 0; j < 31; ++j) { int z_ = 0; asm volatile("" : "+v"(z_)); w[j] = wp[j * 512 + z_]; } }
    float y[32]; const float bias = cbias[l * 512 + c];
#pragma unroll
    for (int i = 0; i < 32; ++i) y[i] = bias;
    const LAS unsigned short* tile = (const LAS unsigned short*)lds;
#pragma unroll
    for (int k = 0; k < 62; ++k) { const float v = __uint_as_float((unsigned)tile[k * 512 + c] << 16);
#pragma unroll
        for (int i = 0; i < 32; ++i) if (k - i >= 0 && k - i <= 30) y[i] += w[k - i] * v; }
    LAS float* yb = (LAS float*)(lds + 65536);
#pragma unroll
    for (int i = 0; i < 32; ++i) yb[i * 512 + c] = y[i];
    __syncthreads();
    float cgv[8], cbv[8];
#pragma unroll
    for (int k8 = 0; k8 < 8; ++k8) { cgv[k8] = cg[l * 512 + lane + 64 * k8]; cbv[k8] = cbeta[l * 512 + lane + 64 * k8]; }
#pragma unroll
    for (int rr = 0; rr < 4; ++rr) { const int i = wid * 4 + rr; float v[8]; float s = 0.f;
#pragma unroll
        for (int k = 0; k < 8; ++k) { v[k] = yb[i * 512 + lane + 64 * k]; s += v[k]; }
        const float mean = wave_sum(s, lane) * (1.f / 512.f); float q = 0.f;
#pragma unroll
        for (int k = 0; k < 8; ++k) { v[k] -= mean; q += v[k] * v[k]; }
        const float rstd = 1.f / sqrtf(wave_sum(q, lane) * (1.f / 512.f) + LN_EPS);
        int z_ = 0; asm volatile("" : "+v"(z_)); bf16* mr = MIX + (size_t)(urow0 + t0 + i) * 2048 + lane + z_;
#pragma unroll
        for (int k = 0; k < 8; ++k) { float z = v[k] * rstd * cgv[k] + cbv[k]; z = z * pg8::sigm(z);
            mr[64 * k] = (bf16)(pk2(z, 0.f) & 0xffffu); } }
    __syncthreads();
}

#define DERIVE_PTRS(WSV, OUTV) \
    unsigned char* ws = (WSV); float* out = (OUTV); \
    gu32* ctl = (gu32*)(ws + WS_CTL); \
    float* TAB = (float*)(ws + WS_TAB); float* CS = (float*)(ws + WS_CS); \
    bf16* WGU = (bf16*)(ws + WS_WGU); bf16* WD = (bf16*)(ws + WS_WD); bf16* WIN = (bf16*)(ws + WS_WIN); bf16* WOUT = (bf16*)(ws + WS_WOUT); \
    bf16* XB = (bf16*)(ws + WS_XB); bf16* KS = (bf16*)(ws + WS_KS); bf16* VS = (bf16*)(ws + WS_VS); bf16* HB = (bf16*)(ws + WS_H); \
    bf16* U = (bf16*)(ws + WS_U); bf16* Q = (bf16*)(ws + WS_Q); bf16* KB = (bf16*)(ws + WS_KB); bf16* VB = (bf16*)(ws + WS_VB); \
    bf16* RQ = (bf16*)(ws + WS_RQ); bf16* RK = (bf16*)(ws + WS_RK); bf16* RV = (bf16*)(ws + WS_RV); bf16* RG = (bf16*)(ws + WS_RG); \
    float* KVT = (float*)(ws + WS_KVT); bf16* SP = (bf16*)(ws + WS_SP); float* ASCR = (float*)(ws + WS_ASCR); \
    bf16* MIXB = (bf16*)out; float* SLAB = (float*)(ws + WS_SLAB);
__device__ __forceinline__ int fresh_tid(int wave_s) { int l_; asm volatile("v_mbcnt_lo_u32_b32 %0, -1, 0\n\tv_mbcnt_hi_u32_b32 %0, -1, %0" : "=v"(l_)); return (wave_s << 6) | l_; }
#define PH_IDS const int tid = fresh_tid(wave_s); const int lane = tid & 63; const int wave = __builtin_amdgcn_readfirstlane(tid >> 6); const int gw = vcu * NWAVES + wave; (void)lane; (void)gw;
#define SPLIT_IDS(NSU) const int nx_ = (G % 8 == 0) ? 8 : 1, cpx_ = G / nx_, xx_ = (int)blockIdx.x % nx_, xr_ = (int)blockIdx.x / nx_, per0_ = ((NSU) + nx_ - 1) / nx_, per_ = per0_ < cpx_ - 1 ? per0_ : cpx_ - 1; \
    const bool gemm_cu_ = xr_ < per_; const int NP_ = per_ * nx_, pidx_ = xx_ * per_ + xr_, NL_ = nx_ * (cpx_ - per_), lnidx_ = xx_ * (cpx_ - per_) + (xr_ - per_);
#ifndef LN_TAIL
#define LN_TAIL 3328
#endif
#ifndef STOP_IT
#define STOP_IT -1
#define STOP_PH -1
#endif
#define STOP_AT(ph) do { if (STOP_IT == it && STOP_PH == (ph)) return; } while (0)
#ifndef H_TILED
#define H_TILED 1
#endif
#ifndef GU_WGM
#define GU_WGM 4
#endif
struct Args { const float* in[20]; float* out; unsigned char* ws; };
__global__ void __launch_bounds__(NWAVES * 64, 2) mk_fwd(Args args) {
    extern __shared__ __attribute__((aligned(16))) unsigned char lds_raw[];
    LAS unsigned char* lds = (LAS unsigned char*)lds_raw;
    volatile LAS unsigned* MISC = (volatile LAS unsigned*)(lds + MISC_OFF);
    const int wave_s = __builtin_amdgcn_readfirstlane((int)threadIdx.x >> 6);
    const int G = gridDim.x; const int vcu = (G % 8 == 0) ? ((int)blockIdx.x % 8) * (G / 8) + (int)blockIdx.x / 8 : (int)blockIdx.x;
    DERIVE_PTRS(args.ws, args.out)
    for (int u = fresh_tid(wave_s); u < (LDS_BYTES - LDSCTL_OFF) / 4; u += NWAVES * 64) ((LAS unsigned*)(lds + LDSCTL_OFF))[u] = 0u;
    __syncthreads();
    XcdBarrier bar = xcd_barrier_post((unsigned*)(ctl + CW_BAR), MISC + 8);
    const int NGW = G * NWAVES;
    const unsigned lds0 = (unsigned)(size_t)lds;

#ifndef REP_P0
#define REP_P0 1
#endif
    for (int rep_ = 0; rep_ < REP_P0; ++rep_) { PH_IDS
        LAS float* scr = (LAS float*)(lds + RING_OFF + wave * 16384);
        constexpr int I_F = 5632, I_IN = 6144, I_OUT = 2048, NITEMS = 12 * I_F + 2 * I_IN + 2 * I_OUT;
        for (int it = gw; it < NITEMS; it += NGW) {
            int r = it;
            if (r < 12 * I_F) { const int mtx = r / I_F, k3 = mtx % 3, li = mtx / 3; r -= mtx * I_F;
                if (k3 == 0) p0_transpose_item(args.in[8] + (size_t)li * DM * DFF, DM, DFF, WGU + (size_t)li * 2 * DFF * DM, 1, scr, r, lane);
                else if (k3 == 1) p0_transpose_item(args.in[9] + (size_t)li * DM * DFF, DM, DFF, WGU + (size_t)li * 2 * DFF * DM, 2, scr, r, lane);
                else p0_transpose_item(args.in[10] + (size_t)li * DFF * DM, DFF, DM, WD + (size_t)li * DM * HP, 0, scr, r, lane, HP);
                continue; }
            r -= 12 * I_F;
            if (r < 2 * I_IN) { const int li = r / I_IN; r -= li * I_IN; p0_transpose_item(args.in[11] + (size_t)li * DM * DIN, DM, DIN, WIN + (size_t)li * DIN * DM, 3, scr, r, lane); continue; }
            r -= 2 * I_IN;
            { const int li = r / I_OUT; r -= li * I_OUT; p0_transpose_item(args.in[12] + (size_t)li * DM * DM, DM, DM, WOUT + (size_t)li * DM * DM, 0, scr, r, lane); }
        }
        for (int m = gw; m < M; m += NGW) {
            const float* src = m < MP ? args.in[0] + (size_t)m * DM : args.in[1] + (size_t)(m - MP) * DM;
            const GAS f32x4* xr = (const GAS f32x4*)src + lane; GAS v2u* o8 = (GAS v2u*)(XB + (size_t)m * DM) + lane;
            f32x4 v8[8];
#pragma unroll
            for (int j = 0; j < 8; ++j) v8[j] = xr[64 * j];
            __builtin_amdgcn_sched_barrier(0);
#pragma unroll
            for (int j = 0; j < 8; ++j) { v2u w; w.x = pk2(v8[j].x, v8[j].y); w.y = pk2(v8[j].z, v8[j].w); o8[64 * j] = w; }
        }
        for (int r = gw; r < 65536; r += NGW) {
            const int which = r >> 15, rr = r & 32767, lb = rr >> 11, t = rr & 2047;
            const GAS f32x4* xr = (const GAS f32x4*)(args.in[3 + which] + (size_t)rr * 1024) + lane;
            GAS v2u* o8 = (GAS v2u*)((which ? VS : KS) + ((size_t)lb * 2112 + t) * 1024) + lane;
            f32x4 v4[4];
#pragma unroll
            for (int j = 0; j < 4; ++j) v4[j] = xr[64 * j];
            __builtin_amdgcn_sched_barrier(0);
#pragma unroll
            for (int j = 0; j < 4; ++j) { v2u w; w.x = pk2(v4[j].x, v4[j].y); w.y = pk2(v4[j].z, v4[j].w); o8[64 * j] = w; }
        }
        for (int i = vcu * 512 + tid; i < 16384 * 64; i += G * 512) {
            const int pos = i >> 6, k = i & 63;
            const float p = (float)exp2((double)k * (13.287712379549449 / 64.0)); const float inv = 1.0f / p; const float ang = (float)pos * inv;
            const double a = (double)ang; const double n = rint(a * 0.15915494309189535); const float red = (float)(a - n * 6.283185307179586);
            CS[2 * (size_t)i] = cosf(red); CS[2 * (size_t)i + 1] = sinf(red);
        }
        if (blockIdx.x == 0) {
            const float* rb = args.in[19];
            for (int i = tid; i < 8 * 320; i += 512) { const int h = i / 320, rel = (i % 320) - 255, n = rel < 0 ? -rel : rel;
                int bk = n < 8 ? n : 8 + (n >= 12) + (n >= 16) + (n >= 23) + (n >= 32) + (n >= 46) + (n >= 64) + (n >= 91);
                bk += rel > 0 ? 16 : 0;
                TAB[i] = (rb[bk * 8 + h] - rb[15 * 8 + h]) * 1.4426950408889634f; }
            if (tid < 2) { const float* lf = args.in[17] + tid * 256; float a = 0.f, c = 0.f;
                for (int i = 0; i < 64; ++i) { a += lf[i] * lf[64 + i]; c += lf[128 + i] * lf[192 + i]; }
                TAB[2560 + tid] = expf(a) - expf(c) + (tid == 0 ? 0.2f : 0.35550906759096934f); TAB[2562 + tid] = tid == 0 ? 0.8f : 0.64449093240903066f; }
        }
    }
    xcd_barrier(bar, fresh_tid(wave_s));

    for (int it = 0; it < 4; ++it) {
        const int l = it >> 1, j = it & 1;
        size_t zoff; asm volatile("s_mov_b64 %0, 0" : "=s"(zoff));
        unsigned char* ws_l = args.ws + zoff; float* out_l = args.out + zoff;
        DERIVE_PTRS(ws_l, out_l)
        if (it > 0) { PH_IDS SPLIT_IDS(2 * (2 * DFF / 256))
            if (gemm_cu_) { const pg8::Gemm g = pg8::gemm_rowmajor(XB, WGU + (size_t)it * 2 * DFF * DM, M, 2 * DFF, DM, DM); pg8::PanelOrder S; S.init(MP / 256, MS / 256, 2 * DFF, NP_, pidx_, DM);
                pg8::EpiGU E{HB, HP, H_TILED};
                pg8::gemm_phase<pg8::EpiGU, pg8::PanelOrder, true, true>(lds + RING_OFF, g, S, E, fresh_tid(wave_s)); }
            const int pi = j == 0 ? (l - 1) * 3 + 2 : l * 3 + 1; const float* gp = args.in[6] + (size_t)pi * DM; const float* bp = args.in[7] + (size_t)pi * DM;
            if (gemm_cu_) { const int tid2 = fresh_tid(wave_s);
                ln_pass(XB, (float*)nullptr, gp, bp, tid2 & 63, pidx_ * NWAVES + __builtin_amdgcn_readfirstlane(tid2 >> 6), NP_ * NWAVES, SLAB, 0, ALPHA, 0.f, MP, MP - LN_TAIL); }
            else ln_pass(XB, (float*)nullptr, gp, bp, lane, lnidx_ * NWAVES + wave, NL_ * NWAVES, SLAB, 0, ALPHA, 0.f, MP - LN_TAIL);
        }
        if (it > 0) xcd_barrier(bar, fresh_tid(wave_s));
#ifndef REP_GU
#define REP_GU 1
#endif
        for (int rep_ = 0; rep_ < REP_GU; ++rep_)
        { const int Mg = it == 0 ? M : MP; const pg8::Gemm g = pg8::gemm_rowmajor(XB, WGU + (size_t)it * 2 * DFF * DM, Mg, 2 * DFF, DM, DM); pg8::StaticOrder S; S.init(Mg, 2 * DFF, G, (int)blockIdx.x, DM); S.wgm = GU_WGM;
          pg8::EpiGU E{HB, HP, H_TILED};
          pg8::gemm_phase<pg8::EpiGU, pg8::StaticOrder, true, true>(lds + RING_OFF, g, S, E, fresh_tid(wave_s)); }
        STOP_AT(2);
        xcd_barrier(bar, fresh_tid(wave_s));
#ifndef REP_DOWN
#define REP_DOWN 1
#endif
        for (int rep_ = 0; rep_ < REP_DOWN; ++rep_)
        { const pg8::Gemm g = H_TILED ? pg8::gemm_atiled(HB, WD + (size_t)it * DM * HP, M, DM, DFF, HP) : pg8::gemm_rowmajor(HB, WD + (size_t)it * DM * HP, M, DM, DFF, HP); pg8::TailSplitOrder S; S.init(MP, M, DM, G, (int)blockIdx.x, DFF, 11); S.rev = true;
          pg8::EpiResB E{XB, rep_ + 1 < REP_DOWN ? 1.0f : ALPHA, rep_ + 1 < REP_DOWN ? 0.0f : 0.5f, SLAB};
          pg8::gemm_phase<pg8::EpiResB, pg8::TailSplitOrder, true, true>(lds + RING_OFF, g, S, E, fresh_tid(wave_s)); }
        STOP_AT(3);
        xcd_barrier(bar, fresh_tid(wave_s));
        { PH_IDS const float* gp = args.in[6] + (size_t)(l * 3 + 2 * j) * DM; const float* bp = args.in[7] + (size_t)(l * 3 + 2 * j) * DM;
          if (it == 3) ln_pass(XB, out, gp, bp, lane, gw, NGW, SLAB, 11, ALPHA, 0.5f, M);
          else ln_sample<11>(lds + RING_OFF, XB, gp, bp, tid, vcu, G, SLAB, ALPHA, 0.5f); }
        if (it == 3) break;
        STOP_AT(4);
        xcd_barrier(bar, fresh_tid(wave_s));
        if (j == 0) {
            { PH_IDS SPLIT_IDS(2 * (DIN / 256))
              if (gemm_cu_) { const pg8::Gemm g = pg8::gemm_rowmajor(XB, WIN + (size_t)l * DIN * DM, M, DIN, DM, DM); pg8::PanelOrder S; S.init(MP / 256, MS / 256, DIN, NP_, pidx_, DM);
                  pg8::EpiIn E{l, out, U, Q, KB, KS, RQ, RV, CS};
                  pg8::gemm_phase<pg8::EpiIn, pg8::PanelOrder, true, true>(lds + RING_OFF, g, S, E, fresh_tid(wave_s)); }
              else { const float* gp = args.in[6] + (size_t)(l * 3) * DM; const float* bp = args.in[7] + (size_t)(l * 3) * DM;
                  ln_pass(XB, (float*)nullptr, gp, bp, lane, lnidx_ * NWAVES + wave, NL_ * NWAVES, SLAB, 0, ALPHA, 0.f, MP); }
            }
            xcd_barrier(bar, fresh_tid(wave_s));
#ifndef REP_IN
#define REP_IN 1
#endif
            for (int rep_ = 0; rep_ < REP_IN; ++rep_)
            { const pg8::Gemm g = pg8::gemm_rowmajor(XB, WIN + (size_t)l * DIN * DM, MP, DIN, DM, DM); pg8::StaticOrder S; S.init(MP, DIN, G, (int)blockIdx.x, DM);
              pg8::EpiIn E{l, out, U, Q, KB, KS, RQ, RV, CS};
              pg8::gemm_phase<pg8::EpiIn, pg8::StaticOrder, true, true>(lds + RING_OFF, g, S, E, fresh_tid(wave_s)); }
            STOP_AT(5);
            xcd_barrier(bar, fresh_tid(wave_s));
#ifndef REP_M1
#define REP_M1 1
#endif
            for (int rep_ = 0; rep_ < REP_M1; ++rep_) { PH_IDS
                const float* subg = args.in[18] + l * 128;
                float* scr = ASCR + (size_t)blockIdx.x * 32768;
#ifndef SKIP_ATTN
#define SKIP_ATTN 0
#endif
#ifndef SKIP_CONV
#define SKIP_CONV 0
#endif
#ifndef SKIP_RET
#define SKIP_RET 0
#endif
                if (!SKIP_ATTN) for (int p = vcu; p < 512; p += G) { const int bh = p >> 5, s = p & 31, b = bh >> 3, h = bh & 7;
                    for (int k = 0; k < 2; ++k) { const int qb = k == 0 ? 63 - s : s;
                        mx::attn_unit((mx::lds_ptr)lds, lds0, fresh_tid(wave_s), Q, KB + (size_t)b * 16384 * 1024, VB + (size_t)b * 16384 * 1024, b * 16384 + 256 * qb, 256 * qb, 4 * qb + 4, 8, h, TAB, l, subg, scr, MIXB); } }
                for (;;) {
                    __syncthreads(); if (tid == 0) MISC[0] = __hip_atomic_fetch_add(ctl + CW_Q + 64 * l, 1u, RLX_AGENT); __syncthreads();
                    const int item = (int)MISC[0];
                    if (item >= 64 + 544 + 1040) break;
                    if (item < 64) { const int b = item >> 3, h = item & 7; const size_t so = (size_t)((l * 8 + b) * 2112) * 1024;
                        mx::attn_unit((mx::lds_ptr)lds, lds0, fresh_tid(wave_s), Q, KS + so, VS + so, MP + 64 * b, 2048, 33, 2, h, TAB, l, subg, scr, MIXB); }
                    else if (item < 608) { const int u = item - 64; int row0, h, nt;
                        if (u < 512) { row0 = (u >> 8) * 16384 + ((u >> 2) & 63) * 256; h = u & 3; nt = 4; } else { const int s = u - 512; row0 = MP + (s >> 2) * 64; h = s & 3; nt = 1; }
                        mx::ret_kv_unit((mx::lds_ptr)lds, lds0, fresh_tid(wave_s), RK + (size_t)row0 * 512 + h * 128, RV + (size_t)row0 * 512 + h * 128, nt, KVT + (size_t)u * 16384); }
                    else if (!SKIP_CONV) conv_item(lds, fresh_tid(wave_s), item - 608, l, U, args.in[2], args.in[13], args.in[14], args.in[15], args.in[16], MIXB);
                }
            }
            STOP_AT(6);
            xcd_barrier(bar, fresh_tid(wave_s));
#ifndef REP_M23
#define REP_M23 1
#endif
            for (int rep23_ = 0; rep23_ < REP_M23; ++rep23_) {
            { PH_IDS
            for (int i = vcu; i < 256 + 1024; i += G) {
                const bool pr = i < 256; const int jj = pr ? i : i - 256, chain = jj >> 5, slab = jj & 31, idx = slab * 512 + tid, b = chain >> 2, h = chain & 3;
                const int e = idx >> 7, d = idx & 127, dnat = (d >> 1) + 64 * (d & 1);
                const float lg = h == 0 ? -0.04580368961312479f : h == 1 ? -0.02272007650008353f : h == 2 ? -0.011315313227834146f : -0.005646563141142063f;
                if (pr) { const float gL = __builtin_amdgcn_exp2f(256.f * lg); float S = 0.f;
                    for (int n0 = 0; n0 < 64; n0 += 8) { float kv8[8];
#pragma unroll
                        for (int j = 0; j < 8; ++j) kv8[j] = KVT[(size_t)((b * 64 + n0 + j) * 4 + h) * 16384 + idx];
                        __builtin_amdgcn_sched_barrier(0);
#pragma unroll
                        for (int j = 0; j < 8; ++j) { const size_t uo = (size_t)((b * 64 + n0 + j) * 4 + h) * 16384 + idx; SP[uo] = (bf16)(pk2(S, 0.f) & 0xffffu); S = gL * (S + kv8[j]); } }
                    out[pg8::O_RETP + ((size_t)((l * 2 + b) * 4 + h) * 128 + dnat) * 128 + e] = S; }
                else { const float gL = __builtin_amdgcn_exp2f(64.f * lg); const size_t uo = (size_t)(512 + b * 4 + h) * 16384 + idx; const size_t so = ((size_t)((l * 8 + b) * 4 + h) * 128 + dnat) * 128 + e;
                    const float S0 = args.in[5][so]; SP[uo] = (bf16)(pk2(S0, 0.f) & 0xffffu); out[pg8::O_RETS + so] = gL * (S0 + KVT[uo]); }
            } }
#ifdef DUMP_KVT
            xcd_barrier(bar, fresh_tid(wave_s));
            for (size_t i = (size_t)blockIdx.x * 512 + fresh_tid(wave_s); i < (size_t)544 * 16384; i += (size_t)G * 512) { out[pg8::O_KP + i] = KVT[i]; out[pg8::O_VP + i] = __uint_as_float((unsigned)SP[i] << 16); }
#endif
            STOP_AT(7);
            xcd_barrier(bar, fresh_tid(wave_s));
            { PH_IDS
            if (!SKIP_RET) for (int u = vcu; u < 544; u += G) { int row0, h, nt, na;
                if (u < 512) { row0 = (u >> 8) * 16384 + ((u >> 2) & 63) * 256; h = u & 3; nt = 4; na = 8; } else { const int s = u - 512; row0 = MP + (s >> 2) * 64; h = s & 3; nt = 1; na = 2; }
                const size_t ro = (size_t)row0 * 512 + h * 128;
                mx::ret_out_unit((mx::lds_ptr)lds, lds0, fresh_tid(wave_s), RQ + ro, RK + ro, RV + ro, RG + ro, SP + (size_t)u * 16384, nt, na, MIXB + (size_t)row0 * 2048 + 1536 + h * 128); } }
#ifdef DUMP_MIX
            xcd_barrier(bar, fresh_tid(wave_s));
            for (size_t i = (size_t)blockIdx.x * 512 + fresh_tid(wave_s); i < (size_t)M * 2048; i += (size_t)G * 512) out[pg8::O_KP + i] = __uint_as_float((unsigned)MIXB[i] << 16);
#endif
            STOP_AT(8);
            xcd_barrier(bar, fresh_tid(wave_s));
            }
            { const pg8::Gemm g = pg8::gemm_rowmajor(MIXB, WOUT + (size_t)l * DM * DM, M, DM, DM, DM); pg8::TailSplitOrder S; S.init(MP, M, DM, G, (int)blockIdx.x, DM, 4);
              pg8::EpiResB E{XB, ALPHA, 1.0f, SLAB};
              pg8::gemm_phase<pg8::EpiResB, pg8::TailSplitOrder, true, true>(lds + RING_OFF, g, S, E, fresh_tid(wave_s)); }
            STOP_AT(9);
            xcd_barrier(bar, fresh_tid(wave_s));
            { PH_IDS const float* gp = args.in[6] + (size_t)(l * 3 + 1) * DM; const float* bp = args.in[7] + (size_t)(l * 3 + 1) * DM;
              ln_sample<4>(lds + RING_OFF, XB, gp, bp, tid, vcu, G, SLAB, ALPHA, 1.0f); }
            xcd_barrier(bar, fresh_tid(wave_s));
        }
    }
}

extern "C" void kernel_launch(void* const* d_in, const int* in_sizes, int n_in, void* d_out, int out_size, void* d_ws, size_t ws_size, hipStream_t stream) {
    static int grid = 0;
    if (grid == 0) {
        if (n_in != 20 || in_sizes[0] != MP * DM || (size_t)out_size != pg8::O_END || ws_size < WS_END) {
            fprintf(stderr, "kernel_launch: unexpected problem sizes (n_in %d, in0 %d, out %d, ws %zu; need ws >= %zu); nothing launched\n", n_in, n_in > 0 ? in_sizes[0] : -1, out_size, ws_size, (size_t)WS_END); grid = -1; return; }
        int dev = 0, cus = 0;
        if (hipGetDevice(&dev) != hipSuccess || hipDeviceGetAttribute(&cus, hipDeviceAttributeMultiprocessorCount, dev) != hipSuccess) { grid = -1; return; }
        if (hipFuncSetAttribute((const void*)mk_fwd, hipFuncAttributeMaxDynamicSharedMemorySize, LDS_BYTES) != hipSuccess) { fprintf(stderr, "kernel_launch: hipFuncSetAttribute failed\n"); grid = -1; return; }
        int per_cu = 0;
        if (hipOccupancyMaxActiveBlocksPerMultiprocessor(&per_cu, (const void*)mk_fwd, NWAVES * 64, LDS_BYTES) != hipSuccess || per_cu < 1) fprintf(stderr, "kernel_launch: occupancy query reports %d\n", per_cu);
        (void)hipGetLastError();
        grid = cus;
    }
    if (grid < 0) return;
    if (hipMemsetAsync((char*)d_ws + WS_CTL, 0, CTL_ZERO_BYTES, stream) != hipSuccess) return;
    Args a{};
    for (int i = 0; i < 20; ++i) a.in[i] = (const float*)d_in[i];
    a.out = (float*)d_out; a.ws = (unsigned char*)d_ws;
    hipLaunchKernelGGL(mk_fwd, dim3(grid), dim3(NWAVES * 64), LDS_BYTES, stream, a);
}
```
